# Optimizing an MI355X kernel written in HIP

```python
import jax, jax.numpy as jnp
from jax import lax
import numpy as np

D_MODEL = 1024
BATCH = 16
SEQ = 2048
DEPTH = 1

ATTN_HEADS = 16
ATTN_KV_HEADS = 4
ATTN_HEAD_DIM = 64
ATTN_WIDTH = ATTN_HEADS * ATTN_HEAD_DIM
KV_WIDTH = ATTN_KV_HEADS * ATTN_HEAD_DIM
WINDOW = 128
ATTN_BLOCK = 128
ROPE_THETA = 10000.0
REC_HEADS = 8
REC_KEY_DIM = 128
REC_VAL_DIM = 128
REC_KEY_WIDTH = REC_HEADS * REC_KEY_DIM
REC_WIDTH = REC_HEADS * REC_VAL_DIM
REC_CHUNK = 64
EPS = 1e-6
D_MIX = ATTN_WIDTH + REC_WIDTH

IN_SPLITS = (ATTN_WIDTH, KV_WIDTH, KV_WIDTH, ATTN_WIDTH,
             REC_KEY_WIDTH, REC_KEY_WIDTH, REC_WIDTH, REC_WIDTH)
IN_WIDTH = sum(IN_SPLITS)

kernel_name = "hymba_swa_sink_hgrn2_adaln"


def rms_norm(x, w):
    xf = x.astype(jnp.float32)
    y = xf * lax.rsqrt(jnp.mean(xf * xf, axis=-1, keepdims=True) + EPS)
    return (y * w.astype(jnp.float32)).astype(x.dtype)


def rope(x, positions):
    hd = x.shape[-1]
    inv_freq = ROPE_THETA ** (-jnp.arange(0, hd, 2, dtype=jnp.float32) / hd)
    ang = positions.astype(jnp.float32)[..., None] * inv_freq
    cos = jnp.cos(ang)[:, :, None, :]
    sin = jnp.sin(ang)[:, :, None, :]
    xf = x.astype(jnp.float32)
    x1, x2 = jnp.split(xf, 2, axis=-1)
    out = jnp.concatenate([x1 * cos - x2 * sin, x2 * cos + x1 * sin], axis=-1)
    return out.astype(x.dtype)


def sliding_window_attention(q, k, v, sinks):
    B, S, Hq, hd = q.shape
    Hkv = k.shape[2]
    G = Hq // Hkv
    nb = S // ATTN_BLOCK
    qb = q.reshape(B, nb, ATTN_BLOCK, Hkv, G, hd)
    kb = k.reshape(B, nb, ATTN_BLOCK, Hkv, hd)
    vb = v.reshape(B, nb, ATTN_BLOCK, Hkv, hd)

    def with_prev(t):
        prev = jnp.pad(t[:, :-1], ((0, 0), (1, 0), (0, 0), (0, 0), (0, 0)))
        return jnp.concatenate([prev, t], axis=2)

    kk, vv = with_prev(kb), with_prev(vb)
    s = jnp.einsum('bnqhgd,bnkhd->bnhgqk', qb, kk,
                   preferred_element_type=jnp.float32) * (hd ** -0.5)
    qi = jnp.arange(ATTN_BLOCK)[:, None]
    kj = jnp.arange(2 * ATTN_BLOCK)[None, :]
    dist = ATTN_BLOCK + qi - kj
    band = (dist >= 0) & (dist < WINDOW)
    blk = jnp.arange(nb)[:, None, None]
    mask = band[None] & ((blk > 0) | (kj >= ATTN_BLOCK)[None])
    s = jnp.where(mask[None, :, None, None], s, -jnp.inf)
    sink = sinks.astype(jnp.float32).reshape(Hkv, G)[None, None, :, :, None, None]
    m = jnp.maximum(jnp.max(s, axis=-1, keepdims=True), sink)
    p = jnp.exp(s - m)
    denom = jnp.sum(p, axis=-1, keepdims=True) + jnp.exp(sink - m)
    o = jnp.einsum('bnhgqk,bnkhd->bnqhgd', (p / denom).astype(v.dtype), vv)
    return o.reshape(B, S, Hq * hd)


def hgrn2_chunkwise(q, f, i):
    B, S, H, dk = q.shape
    dv = i.shape[-1]
    C = REC_CHUNK
    nc = S // C
    k = (1.0 - f).reshape(B, nc, C, H, dk)
    logf = jnp.log(f).reshape(B, nc, C, H, dk)
    q = q.reshape(B, nc, C, H, dk)
    v = i.reshape(B, nc, C, H, dv)
    b = jnp.cumsum(logf, axis=2)
    b_last = b[:, :, -1]
    q_dec = q * jnp.exp(b)
    k_inv = k * jnp.exp(-b)
    k_out = k * jnp.exp(b_last[:, :, None] - b)
    causal = jnp.tril(jnp.ones((C, C), dtype=bool))
    a = jnp.einsum('bnthk,bnshk->bnhts', q_dec, k_inv)
    a = jnp.where(causal, a, 0.0)
    o_intra = jnp.einsum('bnhts,bnshv->bnthv', a, v)
    u = jnp.einsum('bnshk,bnshv->bnhkv', k_out, v)
    decay = jnp.exp(b_last)

    def step(state, xs):
        d, u_c = xs
        return d[..., None] * state + u_c, state

    s0 = jnp.zeros((B, H, dk, dv), jnp.float32)
    _, s_before = lax.scan(step, s0, (jnp.moveaxis(decay, 1, 0), jnp.moveaxis(u, 1, 0)))
    s_before = jnp.moveaxis(s_before, 0, 1)
    o_inter = jnp.einsum('bnthk,bnhkv->bnthv', q_dec, s_before)
    return (o_intra + o_inter).reshape(B, S, H, dv)


def hybrid_layer(x, c_act, positions, lb, norm_w, w_ada, b_ada, w_in,
                 q_norm_w, k_norm_w, sinks, rec_norm_w, w_out):
    B, S, _ = x.shape
    mod = c_act @ w_ada + b_ada
    shift, scale, gate = jnp.split(mod, 3, axis=-1)
    h = rms_norm(x, norm_w) * (1.0 + scale[:, None]) + shift[:, None]
    proj = h @ w_in
    offsets = [int(o) for o in np.cumsum(IN_SPLITS)[:-1]]
    aq, ak, av, ag, rq, rf, ri, rg = jnp.split(proj, offsets, axis=-1)

    aq = rope(rms_norm(aq.reshape(B, S, ATTN_HEADS, ATTN_HEAD_DIM), q_norm_w), positions)
    ak = rope(rms_norm(ak.reshape(B, S, ATTN_KV_HEADS, ATTN_HEAD_DIM), k_norm_w), positions)
    av = av.reshape(B, S, ATTN_KV_HEADS, ATTN_HEAD_DIM)
    attn = sliding_window_attention(aq, ak, av, sinks) * jax.nn.silu(ag)

    f = lb + (1.0 - lb) * jax.nn.sigmoid(rf.astype(jnp.float32))
    rec = hgrn2_chunkwise(rq.astype(jnp.float32).reshape(B, S, REC_HEADS, REC_KEY_DIM),
                          f.reshape(B, S, REC_HEADS, REC_KEY_DIM),
                          ri.astype(jnp.float32).reshape(B, S, REC_HEADS, REC_VAL_DIM))
    rec = rms_norm(rec, rec_norm_w).reshape(B, S, REC_WIDTH).astype(x.dtype)
    rec = rec * jax.nn.silu(rg)

    mixed = jnp.concatenate([attn, rec], axis=-1) @ w_out
    return x + gate[:, None] * mixed


def setup_inputs(seed: int = 0) -> dict:
    key = jax.random.key(seed)
    ks = jax.random.split(key, 16)
    f32 = jnp.float32
    x = jax.random.normal(ks[0], (BATCH, SEQ, D_MODEL), f32)
    c = jax.random.normal(ks[1], (BATCH, D_MODEL), f32)
    positions = jnp.broadcast_to(jnp.arange(SEQ, dtype=jnp.int32), (BATCH, SEQ))
    norm_w = 1.0 + 0.02 * jax.random.normal(ks[2], (DEPTH, D_MODEL), f32)
    w_ada = jax.random.normal(ks[3], (DEPTH, D_MODEL, 3 * D_MODEL), f32) * D_MODEL ** -0.5
    b_ada = 0.02 * jax.random.normal(ks[4], (DEPTH, 3 * D_MODEL), f32)
    w_in = jax.random.normal(ks[5], (DEPTH, D_MODEL, IN_WIDTH), f32) * D_MODEL ** -0.5
    q_norm_w = 1.0 + 0.02 * jax.random.normal(ks[6], (DEPTH, ATTN_HEAD_DIM), f32)
    k_norm_w = 1.0 + 0.02 * jax.random.normal(ks[7], (DEPTH, ATTN_HEAD_DIM), f32)
    sinks = 0.5 * jax.random.normal(ks[8], (DEPTH, ATTN_HEADS), f32)
    rec_norm_w = 1.0 + 0.02 * jax.random.normal(ks[9], (DEPTH, REC_VAL_DIM), f32)
    lower_bounds = 0.1 * jax.random.normal(ks[10], (DEPTH + 1, REC_KEY_WIDTH), f32)
    w_out = jax.random.normal(ks[11], (DEPTH, D_MIX, D_MODEL), f32) * D_MIX ** -0.5
    return {"x": x, "c": c, "positions": positions, "norm_w": norm_w,
            "w_ada": w_ada, "b_ada": b_ada, "w_in": w_in, "q_norm_w": q_norm_w,
            "k_norm_w": k_norm_w, "sinks": sinks, "rec_norm_w": rec_norm_w,
            "lower_bounds": lower_bounds, "w_out": w_out}


def reference(x, c, positions, norm_w, w_ada, b_ada, w_in, q_norm_w, k_norm_w,
              sinks, rec_norm_w, lower_bounds, w_out):
    c_act = jax.nn.silu(c)
    lb_all = jnp.cumsum(jax.nn.softmax(lower_bounds.astype(jnp.float32), axis=0), axis=0)
    h = x
    for l in range(DEPTH):
        h = hybrid_layer(h, c_act, positions, lb_all[l], norm_w[l], w_ada[l], b_ada[l],
                         w_in[l], q_norm_w[l], k_norm_w[l], sinks[l], rec_norm_w[l],
                         w_out[l])
    return h
```

```cpp
#include <hip/hip_runtime.h>
#include <hip/hip_cooperative_groups.h>
#include <cstdio>
#include <cstdint>
namespace cg = cooperative_groups;

#ifndef ONE_LAUNCH
#define ONE_LAUNCH 1
#endif

#define REP_PREP 1
#define REP_NORM 1
#define REP_G1 1
#define REP_G2 1
#define REP_A 1
#define REP_M 1
#define DI __device__ __forceinline__
typedef unsigned short bf16_t;
typedef short bf16x8 __attribute__((ext_vector_type(8)));
typedef float f32x4 __attribute__((ext_vector_type(4)));
typedef float f32x2 __attribute__((ext_vector_type(2)));
typedef float f32x16 __attribute__((ext_vector_type(16)));
typedef unsigned u32x4 __attribute__((ext_vector_type(4)));
typedef unsigned u32x2 __attribute__((ext_vector_type(2)));
typedef short s16x4 __attribute__((ext_vector_type(4)));
typedef __bf16 bf16x2_t __attribute__((ext_vector_type(2)));

constexpr int D_MODEL = 1024, BATCH = 16, SEQ = 2048, NTOK = BATCH * SEQ, IN_W = 6656, D_MIX = 2048;
constexpr int OFF_AQ = 0, OFF_AK = 1024, OFF_AV = 1280, OFF_AG = 1536, OFF_RQ = 2560, OFF_RF = 3584, OFF_RI = 4608, OFF_RG = 5632;
constexpr size_t PB_AQ = 0, PB_AK = PB_AQ + (size_t)NTOK * 1024, PB_AV = PB_AK + (size_t)NTOK * 256, PB_AG = PB_AV + (size_t)NTOK * 256,
                 PB_RQ = PB_AG + (size_t)NTOK * 1024, PB_RF = PB_RQ + (size_t)NTOK * 1024, PB_RI = PB_RF + (size_t)NTOK * 1024, PB_RG = PB_RI + (size_t)NTOK * 1024;
constexpr float EPS = 1e-6f;
constexpr int NTHREADS = 512;
constexpr int LDS_BYTES = 131072 + 256;

constexpr size_t MiB = 1024 * 1024;
constexpr size_t WS_CTRL = 0, WS_XBAR = 2048, WS_MOD = 16384, WS_ROPE = 1 * MiB, WS_WTIN = 9 * MiB, WS_WTOUT = 22 * MiB, WS_H = 26 * MiB, WS_PROJ = 90 * MiB, WS_DL = 506 * MiB,
                 WS_END = WS_DL + 2 * MiB;

struct Params {
  const float* x; const float* c; const int* pos; const float* norm_w; const float* w_ada; const float* b_ada;
  const float* w_in; const float* q_norm_w; const float* k_norm_w; const float* sinks; const float* rec_norm_w;
  const float* lower_bounds; const float* w_out; float* out; char* ws; int st_a; int st_m;
};

DI int opaque_tid() { int t = threadIdx.x; asm volatile("" : "+v"(t)); return t; }
DI unsigned pk_bf16(float lo, float hi) { f32x2 v = {lo, hi}; bf16x2_t b = __builtin_convertvector(v, bf16x2_t); return __builtin_bit_cast(unsigned, b); }
DI float bf_lo(unsigned u) { return __uint_as_float(u << 16); }
DI float bf_hi(unsigned u) { return __uint_as_float(u & 0xffff0000u); }
DI bf16x8 pack8(float a0, float a1, float a2, float a3, float a4, float a5, float a6, float a7) {
  u32x4 w = {pk_bf16(a0, a1), pk_bf16(a2, a3), pk_bf16(a4, a5), pk_bf16(a6, a7)}; return __builtin_bit_cast(bf16x8, w);
}
DI float fast_exp(float x) { return __builtin_amdgcn_exp2f(x * 1.4426950408889634f); }
DI float fast_rcp(float x) { return __builtin_amdgcn_rcpf(x); }
DI float silu(float x) { return x * fast_rcp(1.f + fast_exp(-x)); }
#define MFMA16(a, b, c) __builtin_amdgcn_mfma_f32_16x16x32_bf16((a), (b), (c), 0, 0, 0)
#define MFMA32(a, b, c) __builtin_amdgcn_mfma_f32_32x32x16_bf16((a), (b), (c), 0, 0, 0)

constexpr int CW_WORK = 0, CW_BAR1 = 64, CW_BAR2 = 128, CW_MOD = 192, CW_NORM = 320, CW_TR = 384;
#define XB_TMO      128
#define XB_XCNT(j)  (256  + 64 * (j))
#define XB_XSUB(j)  (1280 + 64 * (j))
#define XB_XGEN(j)  (2304 + 64 * (j))
#define XB_TOP      3328
#define XB_TOPGEN   3392
#define XCD_BAR_WORDS 3456
#define XB_SPIN_CAP (1u << 22)
#define LAS __attribute__((address_space(3)))
DI unsigned xb_ld(unsigned* p) { return __hip_atomic_load(p, __ATOMIC_RELAXED, __HIP_MEMORY_SCOPE_AGENT); }
DI unsigned xb_add(unsigned* p, unsigned v) { return __hip_atomic_fetch_add(p, v, __ATOMIC_RELAXED, __HIP_MEMORY_SCOPE_AGENT); }
DI unsigned xb_xcc_id() { return (unsigned)__builtin_amdgcn_s_getreg((3 << 11) | 20) & 0xFu; }
#define XB_SPIN(cond, bar) do { unsigned _sp = 0; while (cond) { __builtin_amdgcn_s_sleep(1); \
    if ((++_sp & 255u) == 0u) { if (xb_ld(&(bar)[XB_TMO])) break; if (_sp > XB_SPIN_CAP) { atomicAdd(&(bar)[XB_TMO], 1u); break; } } } } while (0)
struct XcdBarrier { unsigned* bar; unsigned x; volatile LAS unsigned* st; };
DI XcdBarrier xcd_barrier_post(unsigned* bar, volatile LAS unsigned* st) {
  XcdBarrier b; b.bar = bar; b.x = xb_xcc_id(); b.st = st;
  if (threadIdx.x == 0) (void)xb_add(&bar[XB_XCNT(b.x)], 1u);
  return b;
}
DI void xcd_barrier_complete(unsigned* bar, unsigned x, unsigned& nloc, unsigned& nx) {
  const unsigned G = gridDim.x;
  unsigned sum, cnt, mine, sp = 0u;
  for (;;) {
    sum = 0u; cnt = 0u; mine = 0u;
#pragma unroll
    for (unsigned j = 0; j < 16; ++j) { const unsigned c = xb_ld(&bar[XB_XCNT(j)]); sum += c; cnt += (c > 0u) ? 1u : 0u; mine = (j == x) ? c : mine; }
    if (sum == G) break;
    __builtin_amdgcn_s_sleep(1);
    if ((++sp & 255u) == 0u) { if (xb_ld(&bar[XB_TMO])) break; if (sp > XB_SPIN_CAP) { atomicAdd(&bar[XB_TMO], 1u); break; } }
  }
  nloc = mine > 0u ? mine : 1u; nx = cnt > 0u ? cnt : 1u;
}
DI void xcd_barrier(const XcdBarrier& b) {
  asm volatile("s_waitcnt vmcnt(0)" ::: "memory");
  __syncthreads();
  if (threadIdx.x == 0) {
    unsigned* bar = b.bar;
    __builtin_amdgcn_s_waitcnt(0);
    unsigned nloc = b.st[0], nx = b.st[1];
    if (nloc == 0u) { xcd_barrier_complete(bar, b.x, nloc, nx); b.st[0] = nloc; b.st[1] = nx; }
    const unsigned old = xb_add(&bar[XB_XSUB(b.x)], 1u);
    const unsigned gen = old / nloc;
    if (old + 1u == (gen + 1u) * nloc) {
      __builtin_amdgcn_fence(__ATOMIC_RELEASE, "agent");
      asm volatile("s_waitcnt vmcnt(0)" ::: "memory");
      const unsigned og = xb_add(&bar[XB_TOP], 1u);
      const unsigned tg = og / nx;
      if (og + 1u == (tg + 1u) * nx) xb_add(&bar[XB_TOPGEN], 1u);
      else XB_SPIN(xb_ld(&bar[XB_TOPGEN]) == tg, bar);
      __builtin_amdgcn_fence(__ATOMIC_ACQUIRE, "agent");
      xb_add(&bar[XB_XGEN(b.x)], 1u);
      asm volatile("s_waitcnt vmcnt(0)" ::: "memory");
    } else {
      XB_SPIN(xb_ld(&bar[XB_XGEN(b.x)]) == gen, bar);
      __builtin_amdgcn_fence(__ATOMIC_ACQUIRE, "agent");
      asm volatile("s_waitcnt vmcnt(0)" ::: "memory");
    }
  }
  __syncthreads();
}

DI void transpose_tile4(const float* __restrict__ W, int ldw, bf16_t* __restrict__ Wt, int ldt, int k0, int n0, float* tile, int tid) {
  f32x4 v[8];
#pragma unroll
  for (int pass = 0; pass < 8; ++pass) {
    const int r = (tid >> 4) + 32 * pass, c4 = (tid & 15) * 4;
    v[pass] = *(const f32x4*)(W + (size_t)(k0 + r) * ldw + n0 + c4);
  }
#pragma unroll
  for (int pass = 0; pass < 8; ++pass) {
    const int r = (tid >> 4) + 32 * pass, c4 = (tid & 15) * 4;
    tile[r * 65 + c4 + 0] = v[pass][0]; tile[r * 65 + c4 + 1] = v[pass][1]; tile[r * 65 + c4 + 2] = v[pass][2]; tile[r * 65 + c4 + 3] = v[pass][3];
  }
  __syncthreads();
#pragma unroll
  for (int pass = 0; pass < 4; ++pass) {
    const int idx = tid + 512 * pass, nl = idx >> 5, kseg = (idx & 31) * 8;
    float x[8];
#pragma unroll
    for (int j = 0; j < 8; ++j) x[j] = tile[(kseg + j) * 65 + nl];
    const int c = nl & 31, rho = 16 * ((c >> 2) & 1) + 4 * (c >> 3) + (c & 3), nrow = n0 + (nl & 32) + rho;
    u32x4 w = {pk_bf16(x[0], x[1]), pk_bf16(x[2], x[3]), pk_bf16(x[4], x[5]), pk_bf16(x[6], x[7])};
    *(u32x4*)(Wt + (size_t)nrow * ldt + k0 + kseg) = w;
  }
  __syncthreads();
}

DI void phase_prep(const Params& p, char* smem) {
  const int tid = opaque_tid();
  float* rope = (float*)(p.ws + WS_ROPE);
  for (int i = blockIdx.x * NTHREADS + tid; i < NTOK * 32; i += gridDim.x * NTHREADS) {
    const int tok = i >> 5, f = i & 31;
    const float inv = exp2f(-(float)f * (13.287712379549449f / 32.0f));
    const float ang = (float)p.pos[tok] * inv;
    double t = (double)ang * 0.15915494309189535; t -= rint(t);
    const float r = (float)t;
    rope[(size_t)tok * 64 + f] = __builtin_amdgcn_cosf(r);
    rope[(size_t)tok * 64 + 32 + f] = __builtin_amdgcn_sinf(r);
  }
  float* mod = (float*)(p.ws + WS_MOD);
  bf16_t* wtin = (bf16_t*)(p.ws + WS_WTIN);
  bf16_t* wtout = (bf16_t*)(p.ws + WS_WTOUT);
  constexpr int J_MOD = 192, J_WIN = 4 * 104, J_WOUT = 8 * 16;
  for (int job = blockIdx.x; job < J_MOD; job += gridDim.x) {
      float* cact = (float*)smem;
      float* red = (float*)(smem + 65536);
      for (int i = tid; i < 16 * 256; i += NTHREADS) { const int b = i >> 8, k = (job / 48) * 256 + (i & 255); const float v = p.c[b * 1024 + k]; cact[b * 1024 + k] = silu(v); }
      __syncthreads();
      const int n = tid & 63, ks = tid >> 6, n0 = (job % 48) * 64, ksp = job / 48;
      float acc[16];
#pragma unroll
      for (int b = 0; b < 16; ++b) acc[b] = 0.f;
#pragma unroll 1
      for (int k = ksp * 256 + ks * 32; k < ksp * 256 + ks * 32 + 32; k += 16) {
        float w[16];
#pragma unroll
        for (int u = 0; u < 16; ++u) w[u] = p.w_ada[(size_t)(k + u) * 3072 + n0 + n];
#pragma unroll
        for (int u = 0; u < 16; ++u)
#pragma unroll
          for (int b = 0; b < 16; ++b) acc[b] += cact[b * 1024 + k + u] * w[u];
      }
#pragma unroll
      for (int b = 0; b < 16; ++b) red[(ks * 16 + b) * 64 + n] = acc[b];
      __syncthreads();
      for (int o = tid; o < 1024; o += NTHREADS) {
        const int b = o >> 6, nn = o & 63; float sacc = (ksp == 0) ? p.b_ada[n0 + nn] : 0.f;
#pragma unroll
        for (int k2 = 0; k2 < 8; ++k2) sacc += red[(k2 * 16 + b) * 64 + nn];
        mod[(ksp * 16 + b) * 3072 + n0 + nn] = sacc;
      }
      asm volatile("s_waitcnt vmcnt(0)" ::: "memory");
      __syncthreads();
      if (tid == 0) __hip_atomic_fetch_add((unsigned*)(p.ws + WS_CTRL) + CW_MOD, 1u, __ATOMIC_RELEASE, __HIP_MEMORY_SCOPE_AGENT);
  }
}
DI void prep_transpose_job(const Params& p, char* smem, int j, int tid) {
  constexpr int J_WIN = 4 * 104;
  bf16_t* wtin = (bf16_t*)(p.ws + WS_WTIN);
  bf16_t* wtout = (bf16_t*)(p.ws + WS_WTOUT);
  if (j < J_WIN) { const int kt = j & 3, nt = j >> 2; transpose_tile4(p.w_in, IN_W, wtin, D_MODEL, kt * 256, nt * 64, (float*)smem, tid); }
  else { const int j2 = j - J_WIN, kt = j2 & 7, nt = j2 >> 3; transpose_tile4(p.w_out, D_MODEL, wtout, D_MIX, kt * 256, nt * 64, (float*)smem, tid); }
}

DI void phase_norm(const Params& p, char* smem) {
  const int tid = opaque_tid(), lane = tid & 63, wave = tid >> 6;
  const float* mod = (const float*)(p.ws + WS_MOD);
  bf16_t* H = (bf16_t*)(p.ws + WS_H);
  float* sc1 = (float*)(smem + 69632);
  float* shv = (float*)(smem + 69632 + 4096);
  int* s_item = (int*)(smem + 131072);
  unsigned* nctr = (unsigned*)(p.ws + WS_CTRL) + CW_NORM;
  unsigned* tctr = (unsigned*)(p.ws + WS_CTRL) + CW_TR;
  int bprev = -1;
  bool tr_left = true, nm_left = true, mod_ok = false;
  for (int step = 0; tr_left || nm_left; ++step) {
    const bool do_tr = tr_left && ((step % 3) == 0 || !nm_left);
    if (tid == 0) *s_item = do_tr ? (int)atomicAdd(tctr, 1u) : (int)atomicAdd(nctr, 1u);
    __syncthreads();
    const int g = *s_item;
    __syncthreads();
    if (do_tr) {
      if (g >= 4 * 104 + 8 * 16) tr_left = false; else prep_transpose_job(p, smem, g, tid);
      continue;
    }
    if (g >= NTOK / 64) { nm_left = false; continue; }
    if (!mod_ok) {
      if (tid == 0) { const unsigned* mc = (const unsigned*)(p.ws + WS_CTRL) + CW_MOD; while (__hip_atomic_load(mc, __ATOMIC_ACQUIRE, __HIP_MEMORY_SCOPE_AGENT) < 192u) __builtin_amdgcn_s_sleep(1); }
      __syncthreads();
      mod_ok = true;
    }
    const int b = g >> 5;
    if (b != bprev) {
      for (int col = tid; col < 1024; col += NTHREADS) {
        float sh = 0.f, sc = 0.f;
#pragma unroll
        for (int k2 = 0; k2 < 4; ++k2) { sh += mod[(k2 * 16 + b) * 3072 + col]; sc += mod[(k2 * 16 + b) * 3072 + 1024 + col]; }
        sc1[col] = p.norm_w[col] * (1.f + sc); shv[col] = sh;
      }
      bprev = b;
      __syncthreads();
    }
#pragma unroll 1
    for (int it = 0; it < 4; ++it) {
      const int row0 = g * 64 + wave * 8 + it * 2;
      f32x4 v[2][4]; float ss[2] = {0.f, 0.f};
#pragma unroll
      for (int rr = 0; rr < 2; ++rr) {
        const f32x4* xr = (const f32x4*)(p.x + (size_t)(row0 + rr) * D_MODEL);
#pragma unroll
        for (int i = 0; i < 4; ++i) v[rr][i] = xr[lane + 64 * i];
      }
#pragma unroll
      for (int rr = 0; rr < 2; ++rr) {
#pragma unroll
        for (int i = 0; i < 4; ++i) ss[rr] += v[rr][i][0] * v[rr][i][0] + v[rr][i][1] * v[rr][i][1] + v[rr][i][2] * v[rr][i][2] + v[rr][i][3] * v[rr][i][3];
#pragma unroll
        for (int o = 32; o >= 1; o >>= 1) ss[rr] += __shfl_xor(ss[rr], o);
        ss[rr] = rsqrtf(ss[rr] * (1.0f / D_MODEL) + EPS);
      }
#pragma unroll
      for (int i = 0; i < 4; ++i) {
        const int col = (lane + 64 * i) * 4;
        const f32x4 a = *(const f32x4*)(sc1 + col), sh = *(const f32x4*)(shv + col);
#pragma unroll
        for (int rr = 0; rr < 2; ++rr) {
          float h[4];
#pragma unroll
          for (int j = 0; j < 4; ++j) h[j] = v[rr][i][j] * ss[rr] * a[j] + sh[j];
          u32x2 w = {pk_bf16(h[0], h[1]), pk_bf16(h[2], h[3])};
          *(u32x2*)(H + (size_t)(row0 + rr) * D_MODEL + col) = w;
        }
      }
    }
  }
}

constexpr int BM = 256, BK = 64, HALF = 128, NXCD = 8, WGM = 8, HT = HALF * BK;
DI int lds_byte(int r, int c) { const int st = (r >> 4) * 2 + (c >> 5), rr = r & 15, cc = c & 31, ob = rr * 64 + cc * 2; return st * 1024 + (ob ^ (((ob >> 9) & 1) << 5)); }
DI void stage_rc(int b, int& R, int& C) { const int st = b / 1024, sb = b % 1024, swz = sb ^ (((sb >> 9) & 1) << 5); R = (st >> 1) * 16 + swz / 64; C = (st & 1) * 32 + (swz % 64) / 2; }

struct EpiProj {
  bf16_t* O;
  DI void operator()(const f32x4 (&acc)[2][2][4][2], int brow, int bcol, int wr, int wc, int fr, int fq) const {
    const bool gate_tile = (bcol >= OFF_AG && bcol < OFF_AG + 1024) || (bcol >= OFF_RG);
    size_t sbase; int sld, scol;
    if (bcol < OFF_AK) { sbase = PB_AQ; sld = 1024; scol = bcol - OFF_AQ; }
    else if (bcol < OFF_AV) { sbase = PB_AK; sld = 256; scol = bcol - OFF_AK; }
    else if (bcol < OFF_AG) { sbase = PB_AV; sld = 256; scol = bcol - OFF_AV; }
    else if (bcol < OFF_RQ) { sbase = PB_AG; sld = 1024; scol = bcol - OFF_AG; }
    else if (bcol < OFF_RF) { sbase = PB_RQ; sld = 1024; scol = bcol - OFF_RQ; }
    else if (bcol < OFF_RI) { sbase = PB_RF; sld = 1024; scol = bcol - OFF_RF; }
    else if (bcol < OFF_RG) { sbase = PB_RI; sld = 1024; scol = bcol - OFF_RI; }
    else { sbase = PB_RG; sld = 1024; scol = bcol - OFF_RG; }
#pragma unroll
    for (int ai = 0; ai < 2; ++ai)
#pragma unroll
      for (int m = 0; m < 4; ++m) {
        const int row = brow + ai * HALF + wr * 64 + m * 16 + fr;
        bf16_t* rp = O + sbase + (size_t)row * sld + scol + wc * 32 + 8 * fq;
#pragma unroll
        for (int bj = 0; bj < 2; ++bj) {
          f32x4 a0 = acc[ai][bj][m][0], a1 = acc[ai][bj][m][1];
          if (gate_tile) {
#pragma unroll
            for (int j = 0; j < 4; ++j) { a0[j] = silu(a0[j]); a1[j] = silu(a1[j]); }
          }
          u32x4 w = {pk_bf16(a0[0], a0[1]), pk_bf16(a0[2], a0[3]), pk_bf16(a1[0], a1[1]), pk_bf16(a1[2], a1[3])};
          *(u32x4*)(rp + bj * HALF) = w;
        }
      }
  }
};
struct EpiOut {
  float* O; const float* X; const float* mod;
  DI void operator()(const f32x4 (&acc)[2][2][4][2], int brow, int bcol, int wr, int wc, int fr, int fq) const {
    const int b = brow >> 11;
    f32x4 g[2][2];
    {
      f32x4 gp[2][4][2];
#pragma unroll
      for (int bj = 0; bj < 2; ++bj)
#pragma unroll
        for (int k2 = 0; k2 < 4; ++k2) {
          const float* gq = mod + (k2 * 16 + b) * 3072 + 2048 + bcol + bj * HALF + wc * 32 + 8 * fq;
          gp[bj][k2][0] = *(const f32x4*)gq; gp[bj][k2][1] = *(const f32x4*)(gq + 4);
        }
#pragma unroll
      for (int bj = 0; bj < 2; ++bj) { g[bj][0] = (gp[bj][0][0] + gp[bj][1][0]) + (gp[bj][2][0] + gp[bj][3][0]); g[bj][1] = (gp[bj][0][1] + gp[bj][1][1]) + (gp[bj][2][1] + gp[bj][3][1]); }
    }
    f32x4 xb[2][4][2];
    auto ldb = [&](int q, f32x4 (&x)[4][2]) __attribute__((always_inline)) {
      const int bj = q >> 1, ai = q & 1, col = bcol + bj * HALF + wc * 32 + 8 * fq;
#pragma unroll
      for (int m = 0; m < 4; ++m) {
        const size_t o = (size_t)(brow + ai * HALF + wr * 64 + m * 16 + fr) * D_MODEL + col;
        x[m][0] = *(const f32x4*)(X + o); x[m][1] = *(const f32x4*)(X + o + 4);
      }
    };
    ldb(0, xb[0]);
#pragma unroll
    for (int q = 0; q < 4; ++q) {
      if (q + 1 < 4) ldb(q + 1, xb[(q + 1) & 1]);
      const int bj = q >> 1, ai = q & 1, col = bcol + bj * HALF + wc * 32 + 8 * fq;
#pragma unroll
      for (int m = 0; m < 4; ++m) {
        const size_t o = (size_t)(brow + ai * HALF + wr * 64 + m * 16 + fr) * D_MODEL + col;
        *(f32x4*)(O + o) = xb[q & 1][m][0] + g[bj][0] * acc[ai][bj][m][0];
        *(f32x4*)(O + o + 4) = xb[q & 1][m][1] + g[bj][1] * acc[ai][bj][m][1];
      }
    }
  }
};

template <int lda, int split_kt, int gap, int M, int N, int K, class Epi>
DI void gemm_phase(LAS unsigned char* lds, const bf16_t* __restrict__ A, const bf16_t* __restrict__ Bt, const Epi& epi) {
#define SA(b, h) (((b) * 2 + (h)) * (HT * 2))
#define SB(b, h) ((4 + (b) * 2 + (h)) * (HT * 2))
#define STAGE_A(P, br, kt) do { const char* _g = (const char*)(A + (size_t)(br) * lda + (kt) * BK + ((kt) >= split_kt ? gap : 0)); \
    _Pragma("unroll") for (int _i = 0; _i < 2; ++_i) { \
      __builtin_amdgcn_global_load_lds((const unsigned*)(_g + aoff[_i]), (LAS unsigned*)(lds + (P) + ldsw + _i * 8192), 16, 0, 0); } } while (0)
#define STAGE_B(P, br, kt) do { const char* _g = (const char*)(Bt + (size_t)(br) * K + (kt) * BK); \
    _Pragma("unroll") for (int _i = 0; _i < 2; ++_i) { \
      __builtin_amdgcn_global_load_lds((const unsigned*)(_g + boff[_i]), (LAS unsigned*)(lds + (P) + ldsw + _i * 8192), 16, 0, 0); } } while (0)
#define LDA(dst, b, h) _Pragma("unroll") for (int m = 0; m < 4; ++m) _Pragma("unroll") for (int k = 0; k < 2; ++k) \
    dst[m][k] = *(const LAS bf16x8*)(lds + SA(b, h) + ra + m * 2048 + k * 1024)
#define LDB(dst, b, h) _Pragma("unroll") for (int n = 0; n < 2; ++n) _Pragma("unroll") for (int k = 0; k < 2; ++k) \
    dst[n][k] = *(const LAS bf16x8*)(lds + SB(b, h) + rb + n * 2048 + k * 1024)
#define MMA(ai, bj, At, Bf) do { __builtin_amdgcn_s_setprio(1); \
    _Pragma("unroll") for (int m = 0; m < 4; ++m) _Pragma("unroll") for (int n = 0; n < 2; ++n) _Pragma("unroll") for (int k = 0; k < 2; ++k) \
      acc[ai][bj][m][n] = __builtin_amdgcn_mfma_f32_16x16x32_bf16(Bf[n][k], At[m][k], acc[ai][bj][m][n], 0, 0, 0); \
    __builtin_amdgcn_s_setprio(0); } while (0)
#define WAIT_V(n) asm volatile("s_waitcnt vmcnt(" #n ")" ::: "memory")
#define WAIT_L(n) asm volatile("s_waitcnt lgkmcnt(" #n ")" ::: "memory")
#define BAR __builtin_amdgcn_s_barrier()
#define SCHED __builtin_amdgcn_sched_barrier(0)
  const int nM = M / BM, nN = N / BM, nwg = nM * nN;
  const int gtid = opaque_tid();
  const int wid = __builtin_amdgcn_readfirstlane(gtid >> 6), lane = gtid & 63, wr = wid >> 2, wc = wid & 3, fr = lane & 15, fq = lane >> 4;
  constexpr int nt = K / BK;
  const unsigned ldsw = (unsigned)wid * 1024u;
  const int ra = lds_byte(wr * 64 + fr, fq * 8), rb = lds_byte(wc * 32 + fr, fq * 8);
  unsigned aoff[2], boff[2];
#pragma unroll
  for (int i = 0; i < 2; ++i) { int r_, c_; stage_rc(gtid * 16 + i * 8192, r_, c_); aoff[i] = (unsigned)(r_ * lda + c_) * 2u; boff[i] = (unsigned)(r_ * K + c_) * 2u; }
  auto decode = [&](int L, int& brow_, int& bcol_) __attribute__((always_inline)) {
    int wgid = L;
    { const int q = nwg / NXCD, r = nwg % NXCD, xcd = wgid % NXCD, off = wgid / NXCD; wgid = (xcd < r ? xcd * (q + 1) : r * (q + 1) + (xcd - r) * q) + off; }
    const int nig = WGM * nN, gid = wgid / nig, fm = gid * WGM, gsz = min(nM - fm, WGM);
    const int pm = fm + ((wgid % nig) % gsz), pn = (wgid % nig) / gsz; brow_ = pm * BM; bcol_ = pn * BM;
  };
  int L = blockIdx.x;
  if (L < nwg) {
    int brow, bcol; decode(L, brow, bcol);
    f32x4 acc[2][2][4][2];
#pragma unroll
    for (int a = 0; a < 2; ++a)
#pragma unroll
      for (int b = 0; b < 2; ++b)
#pragma unroll
        for (int m = 0; m < 4; ++m)
#pragma unroll
          for (int n = 0; n < 2; ++n) acc[a][b][m][n] = (f32x4){0.f, 0.f, 0.f, 0.f};
    bf16x8 At[4][2], B0[2][2], B1[2][2];
    STAGE_B(SB(0, 0), bcol, 0); STAGE_A(SA(0, 0), brow, 0);
    STAGE_B(SB(0, 1), bcol + HALF, 0); STAGE_A(SA(0, 1), brow + HALF, 0);
    if (wr == 1) BAR;
    WAIT_V(4); BAR;
    STAGE_B(SB(1, 0), bcol, 1); STAGE_A(SA(1, 0), brow, 1); STAGE_B(SB(1, 1), bcol + HALF, 1);
    WAIT_V(6); BAR;
#pragma unroll 1
    for (;;) {
      const int Ln = L + gridDim.x;
      int nrow = brow, ncol = bcol;
      if (Ln < nwg) decode(Ln, nrow, ncol);
#pragma unroll 1
      for (int t = 0; t < nt; t += 2) {
        const bool last = (t == nt - 2);
        const int r2 = last ? nrow : brow, c2 = last ? ncol : bcol, k2 = last ? 0 : t + 2, k3 = last ? 1 : t + 3;
        LDB(B0, 0, 0); SCHED; LDA(At, 0, 0); STAGE_A(SA(1, 1), brow + HALF, t + 1);
        WAIT_L(8); BAR; WAIT_L(0); MMA(0, 0, At, B0); BAR; SCHED;
        LDB(B1, 0, 1); STAGE_B(SB(0, 0), c2, k2);
        BAR; WAIT_L(0); MMA(0, 1, At, B1); BAR;
        LDA(At, 0, 1); STAGE_A(SA(0, 0), r2, k2);
        BAR; WAIT_L(0); MMA(1, 0, At, B0); BAR; SCHED;
        STAGE_B(SB(0, 1), c2 + HALF, k2);
        WAIT_V(6); BAR; MMA(1, 1, At, B1); BAR;
        LDB(B0, 1, 0); SCHED; LDA(At, 1, 0); STAGE_A(SA(0, 1), r2 + HALF, k2);
        WAIT_L(8); BAR; WAIT_L(0); MMA(0, 0, At, B0); BAR; SCHED;
        LDB(B1, 1, 1); STAGE_B(SB(1, 0), c2, k3);
        BAR; WAIT_L(0); MMA(0, 1, At, B1); BAR;
        LDA(At, 1, 1); STAGE_A(SA(1, 0), r2, k3);
        BAR; WAIT_L(0); MMA(1, 0, At, B0); BAR; SCHED;
        STAGE_B(SB(1, 1), c2 + HALF, k3);
        WAIT_V(6); BAR; MMA(1, 1, At, B1); BAR;
      }
      epi(acc, brow, bcol, wr, wc, fr, fq);
#pragma unroll
      for (int a = 0; a < 2; ++a)
#pragma unroll
        for (int b = 0; b < 2; ++b)
#pragma unroll
          for (int m = 0; m < 4; ++m)
#pragma unroll
            for (int n = 0; n < 2; ++n) acc[a][b][m][n] = (f32x4){0.f, 0.f, 0.f, 0.f};
      if (Ln >= nwg) break;
      L = Ln; brow = nrow; bcol = ncol;
    }
    WAIT_V(0);
    if (wr == 0) BAR;
  }
  __syncthreads();
#undef SA
#undef SB
}

DI void attn_unit(const Params& p, char* smem, int unit) {
  const int kvh = unit & 3, nb = (unit >> 2) & 15, b = unit >> 6;
  bf16_t* proj = (bf16_t*)(p.ws + WS_PROJ);
  const float* rope = (const float*)(p.ws + WS_ROPE);
  bf16_t* Ks = (bf16_t*)smem;
  bf16_t* Vr = (bf16_t*)(smem + 36864);
  const int tid = opaque_tid(), lane = tid & 63, wave = tid >> 6;
  {
    const int key = tid >> 1, half = tid & 1;
    const int tokl = nb * 128 - 128 + key;
    u32x4 o0 = {0, 0, 0, 0}, o1 = o0, o2 = o0, o3 = o0;
    u32x4 v0 = o0, v1 = o0, v2 = o0, v3 = o0;
    if (tokl >= 0) {
      const size_t tok = (size_t)b * SEQ + tokl;
      const bf16_t* kp = proj + PB_AK + tok * 256 + kvh * 64 + 16 * half;
      const u32x4 r0 = *(const u32x4*)kp, r1 = *(const u32x4*)(kp + 8), r2 = *(const u32x4*)(kp + 32), r3 = *(const u32x4*)(kp + 40);
      const bf16_t* vp = proj + PB_AV + tok * 256 + kvh * 64 + 32 * half;
      v0 = *(const u32x4*)vp; v1 = *(const u32x4*)(vp + 8); v2 = *(const u32x4*)(vp + 16); v3 = *(const u32x4*)(vp + 24);
      float x1[16], x2[16];
#pragma unroll
      for (int i = 0; i < 4; ++i) { x1[2 * i] = bf_lo(r0[i]); x1[2 * i + 1] = bf_hi(r0[i]); x1[8 + 2 * i] = bf_lo(r1[i]); x1[8 + 2 * i + 1] = bf_hi(r1[i]);
                                    x2[2 * i] = bf_lo(r2[i]); x2[2 * i + 1] = bf_hi(r2[i]); x2[8 + 2 * i] = bf_lo(r3[i]); x2[8 + 2 * i + 1] = bf_hi(r3[i]); }
      float ss = 0.f;
#pragma unroll
      for (int j = 0; j < 16; ++j) ss += x1[j] * x1[j] + x2[j] * x2[j];
      ss += __shfl_xor(ss, 1);
      const float rstd = rsqrtf(ss * (1.0f / 64.0f) + EPS);
      const float* cs = rope + tok * 64 + 16 * half;
      const float* kw = p.k_norm_w + 16 * half;
      float y1[16], y2[16];
#pragma unroll
      for (int j = 0; j < 16; ++j) {
        const float a1 = x1[j] * rstd * kw[j], a2 = x2[j] * rstd * kw[32 + j], c = cs[j], s = cs[32 + j];
        y1[j] = a1 * c - a2 * s; y2[j] = a2 * c + a1 * s;
      }
      o0 = (u32x4){pk_bf16(y1[0], y1[1]), pk_bf16(y1[2], y1[3]), pk_bf16(y1[4], y1[5]), pk_bf16(y1[6], y1[7])};
      o1 = (u32x4){pk_bf16(y1[8], y1[9]), pk_bf16(y1[10], y1[11]), pk_bf16(y1[12], y1[13]), pk_bf16(y1[14], y1[15])};
      o2 = (u32x4){pk_bf16(y2[0], y2[1]), pk_bf16(y2[2], y2[3]), pk_bf16(y2[4], y2[5]), pk_bf16(y2[6], y2[7])};
      o3 = (u32x4){pk_bf16(y2[8], y2[9]), pk_bf16(y2[10], y2[11]), pk_bf16(y2[12], y2[13]), pk_bf16(y2[14], y2[15])};
    }
    bf16_t* kd = Ks + key * 72 + 16 * half;
    *(u32x4*)kd = o0; *(u32x4*)(kd + 8) = o1; *(u32x4*)(kd + 32) = o2; *(u32x4*)(kd + 40) = o3;
    bf16_t* vd = Vr + key * 96 + 32 * half;
    *(u32x4*)vd = v0; *(u32x4*)(vd + 8) = v1; *(u32x4*)(vd + 16) = v2; *(u32x4*)(vd + 24) = v3;
  }
  __syncthreads();
  const int r = lane & 31, h = lane >> 5;
  const bf16_t* vtb = Vr + (((lane >> 5) * 4 + ((lane & 15) >> 2)) * 96 + 16 * ((lane >> 4) & 1) + 4 * (lane & 3));
  constexpr float LOG2E = 1.4426950408889634f;
#pragma unroll 1
  for (int it = 0; it < 2; ++it) {
    const int item = wave * 2 + it, g = item >> 2, qs = item & 3;
    const int head = kvh * 4 + g;
    const size_t tok = (size_t)b * SEQ + nb * 128 + qs * 32 + r;
    bf16x8 qf[4];
    u32x4 gr[4];
    bf16_t* gbase = proj + PB_AG + ((size_t)b * SEQ + nb * 128 + qs * 32 + (lane >> 3)) * 1024 + head * 64 + (lane & 7) * 8;
#pragma unroll
    for (int i = 0; i < 4; ++i) gr[i] = *(const u32x4*)(gbase + (size_t)(8 * i) * 1024);
    {
      const u32x4* qp = (const u32x4*)(proj + PB_AQ + tok * 1024 + head * 64 + 8 * h);
      float xq[4][8]; float ss = 0.f;
#pragma unroll
      for (int s = 0; s < 4; ++s) { const u32x4 rr = qp[2 * s];
#pragma unroll
        for (int i = 0; i < 4; ++i) { xq[s][2 * i] = bf_lo(rr[i]); xq[s][2 * i + 1] = bf_hi(rr[i]); } }
#pragma unroll
      for (int s = 0; s < 4; ++s)
#pragma unroll
        for (int j = 0; j < 8; ++j) ss += xq[s][j] * xq[s][j];
      ss += __shfl_xor(ss, 32);
      const float rstd = rsqrtf(ss * (1.0f / 64.0f) + EPS) * (0.125f * LOG2E);
      const float* cs = rope + tok * 64 + 8 * h;
      const float* qw = p.q_norm_w + 8 * h;
#pragma unroll
      for (int s = 0; s < 2; ++s) {
        float ya[8], yb[8];
#pragma unroll
        for (int j = 0; j < 8; ++j) {
          const float a1 = xq[s][j] * rstd * qw[16 * s + j], a2 = xq[s + 2][j] * rstd * qw[32 + 16 * s + j], c = cs[16 * s + j], sn = cs[32 + 16 * s + j];
          ya[j] = a1 * c - a2 * sn; yb[j] = a2 * c + a1 * sn;
        }
        qf[s] = pack8(ya[0], ya[1], ya[2], ya[3], ya[4], ya[5], ya[6], ya[7]);
        qf[s + 2] = pack8(yb[0], yb[1], yb[2], yb[3], yb[4], yb[5], yb[6], yb[7]);
      }
    }
    f32x16 sacc[5];
#pragma unroll
    for (int kt = 0; kt < 5; ++kt) {
#pragma unroll
      for (int i = 0; i < 16; ++i) sacc[kt][i] = 0.f;
#pragma unroll
      for (int s = 0; s < 4; ++s) {
        const bf16x8 a = *(const bf16x8*)(Ks + (qs * 32 + kt * 32 + r) * 72 + 16 * s + 8 * h);
        sacc[kt] = MFMA32(a, qf[s], sacc[kt]);
      }
    }
    const float sinkv = p.sinks[head] * LOG2E;
    float m = -INFINITY;
#pragma unroll
    for (int kt = 0; kt < 5; ++kt) {
      const bool tile_ok = (nb > 0) || (qs * 32 + kt * 32 >= 128);
#pragma unroll
      for (int i = 0; i < 16; ++i) {
        const int cr = (i & 3) + 8 * (i >> 2) + 4 * h;
        bool ok = tile_ok;
        if (kt == 0) ok = ok && (cr > r);
        if (kt == 4) ok = ok && (cr <= r);
        const float v = ok ? sacc[kt][i] : -INFINITY;
        sacc[kt][i] = v; m = fmaxf(m, v);
      }
    }
    m = fmaxf(m, __shfl_xor(m, 32)); m = fmaxf(m, sinkv);
    float l = 0.f;
#pragma unroll
    for (int kt = 0; kt < 5; ++kt)
#pragma unroll
      for (int i = 0; i < 16; ++i) { const float pv = __builtin_amdgcn_exp2f(sacc[kt][i] - m); sacc[kt][i] = pv; l += pv; }
    l += __shfl_xor(l, 32); l += __builtin_amdgcn_exp2f(sinkv - m);
    f32x16 oacc[2];
#pragma unroll
    for (int i = 0; i < 16; ++i) { oacc[0][i] = 0.f; oacc[1][i] = 0.f; }
#pragma unroll
    for (int kt = 0; kt < 5; ++kt)
#pragma unroll
      for (int s = 0; s < 2; ++s) {
        const bf16x8 pb = pack8(sacc[kt][8 * s], sacc[kt][8 * s + 1], sacc[kt][8 * s + 2], sacc[kt][8 * s + 3], sacc[kt][8 * s + 4], sacc[kt][8 * s + 5], sacc[kt][8 * s + 6], sacc[kt][8 * s + 7]);
#pragma unroll
        for (int ht = 0; ht < 2; ++ht) {
          const bf16_t* vp = vtb + (qs * 32 + kt * 32 + 16 * s) * 96 + ht * 32;
          const s16x4 lo = __builtin_amdgcn_ds_read_tr16_b64_v4i16((LAS s16x4*)vp), hi = __builtin_amdgcn_ds_read_tr16_b64_v4i16((LAS s16x4*)(vp + 8 * 96));
          const bf16x8 av = __builtin_shufflevector(lo, hi, 0, 1, 2, 3, 4, 5, 6, 7);
          oacc[ht] = MFMA32(av, pb, oacc[ht]);
        }
      }
    const float inv = fast_rcp(l);
    bf16_t* Os = (bf16_t*)(smem + 86016) + wave * (32 * 72);
#pragma unroll
    for (int ht = 0; ht < 2; ++ht)
#pragma unroll
      for (int g4 = 0; g4 < 4; ++g4) {
        const u32x2 w = {pk_bf16(oacc[ht][4 * g4] * inv, oacc[ht][4 * g4 + 1] * inv), pk_bf16(oacc[ht][4 * g4 + 2] * inv, oacc[ht][4 * g4 + 3] * inv)};
        *(u32x2*)(Os + r * 72 + ht * 32 + 8 * g4 + 4 * h) = w;
      }
    __builtin_amdgcn_wave_barrier();
    asm volatile("s_waitcnt lgkmcnt(0)" ::: "memory");
#pragma unroll
    for (int i = 0; i < 4; ++i) {
      const u32x4 ov = *(const u32x4*)(Os + ((lane >> 3) + 8 * i) * 72 + (lane & 7) * 8);
      const u32x4 gv = gr[i];
      u32x4 w;
#pragma unroll
      for (int j = 0; j < 4; ++j) w[j] = pk_bf16(bf_lo(ov[j]) * bf_lo(gv[j]), bf_hi(ov[j]) * bf_hi(gv[j]));
      if (p.st_m) *(u32x4*)(gbase + (size_t)(8 * i) * 1024) = w;
    }
    __builtin_amdgcn_wave_barrier();
  }
  __syncthreads();
}

struct HgrnRegs { unsigned rq[8], rf[8]; };
DI void hgrn_chunk_load(HgrnRegs& R, const bf16_t* proj, int u, int seg, int kp) {
  const int hh = u & 7, c = (u >> 3) & 31, b = u >> 8;
  const size_t tok0 = (size_t)b * SEQ + c * 64;
#pragma unroll
  for (int j = 0; j < 8; ++j) {
    const bf16_t* base = proj + (tok0 + 8 * seg + j) * 1024 + hh * 128 + 2 * kp;
    R.rq[j] = *(const unsigned*)(base + PB_RQ); R.rf[j] = *(const unsigned*)(base + PB_RF);
  }
}
DI void phase_hgrn_chunk(const Params& p, char* smem) {
  bf16_t* proj = (bf16_t*)(p.ws + WS_PROJ);
  bf16_t* Hb = (bf16_t*)(p.ws + WS_H);
  float* DL = (float*)(p.ws + WS_DL);
  bf16_t* QD = (bf16_t*)smem;
  bf16_t* KI = (bf16_t*)(smem + 17408);
  bf16_t* KoT = (bf16_t*)(smem + 34816);
  bf16_t* VT = (bf16_t*)(smem + 53248);
  bf16_t* Am = (bf16_t*)(smem + 71680);
  f32x4* segp = (f32x4*)(smem + 80896);
  float* Ob = (float*)(smem + 89600);
  const int tid = opaque_tid(), lane = tid & 63, wave = tid >> 6;
  const int kp = lane, seg = wave;
  const int c16 = lane & 15, q4 = lane >> 4;
  const int ft = tid >> 3, fv = (tid & 7) * 16;
  HgrnRegs R;
  if ((int)blockIdx.x < 4096) hgrn_chunk_load(R, proj, blockIdx.x, seg, kp);
#pragma unroll 1
  for (int u = blockIdx.x; u < 4096; u += gridDim.x) {
    const int hh = u & 7, c = (u >> 3) & 31, b = u >> 8;
    const size_t tok0 = (size_t)b * SEQ + c * 64;
    float lb0, lb1;
    {
      const f32x2 l0 = *(const f32x2*)(p.lower_bounds + hh * 128 + 2 * kp), l1 = *(const f32x2*)(p.lower_bounds + 1024 + hh * 128 + 2 * kp);
      lb0 = fast_rcp(1.f + fast_exp(l1[0] - l0[0])); lb1 = fast_rcp(1.f + fast_exp(l1[1] - l0[1]));
    }
    const f32x2 lbv = {lb0, lb1}, olb = {1.f - lb0, 1.f - lb1};
    f32x2 Ev[8], Iv[8], Kv[8];
    {
      f32x2 P = {1.f, 1.f}, Q = {1.f, 1.f};
#pragma unroll
      for (int j = 0; j < 8; ++j) {
        const float x0 = __builtin_amdgcn_fmed3f(bf_lo(R.rf[j]), -30.f, 30.f), x1 = __builtin_amdgcn_fmed3f(bf_hi(R.rf[j]), -30.f, 30.f);
        const f32x2 e = {__builtin_amdgcn_exp2f(x0 * -1.4426950408889634f), __builtin_amdgcn_exp2f(x1 * -1.4426950408889634f)};
        const f32x2 a1 = e + 1.f, a2 = lbv * e + 1.f, pr = a1 * a2;
        const f32x2 w = {fast_rcp(pr[0]), fast_rcp(pr[1])};
        const f32x2 r = w * a2;
        Kv[j] = olb * e * r;
        P = P * (a2 * r); Q = Q * (a1 * a1 * w);
        Ev[j] = P; Iv[j] = Q;
      }
      segp[seg * 64 + kp] = (f32x4){P[0], P[1], Q[0], Q[1]};
    }
    __syncthreads();
    {
      f32x2 pre = {1.f, 1.f}, pin = {1.f, 1.f}, tot = {1.f, 1.f};
#pragma unroll
      for (int s2 = 0; s2 < 8; ++s2) {
        const f32x4 v = segp[s2 * 64 + kp];
        const f32x2 vp = {v[0], v[1]}, vq = {v[2], v[3]};
        if (s2 < seg) { pre = pre * vp; pin = pin * vq; }
        tot = tot * vp;
      }
      f32x2 ko[8];
#pragma unroll
      for (int j = 0; j < 8; ++j) {
        const f32x2 Ea = pre * Ev[j], ia = pin * Iv[j];
        const f32x2 qv = {bf_lo(R.rq[j]), bf_hi(R.rq[j])};
        const f32x2 qd2 = qv * Ea, ki = Kv[j] * ia;
        ko[j] = ki * tot;
        const unsigned qd = pk_bf16(qd2[0], qd2[1]);
        *(unsigned*)(QD + (8 * seg + j) * 136 + 2 * kp) = qd;
        if (p.st_a) *(unsigned*)(proj + PB_RQ + (tok0 + 8 * seg + j) * 1024 + hh * 128 + 2 * kp) = qd;
        *(unsigned*)(KI + (8 * seg + j) * 136 + 2 * kp) = pk_bf16(ki[0], ki[1]);
      }
      *(bf16x8*)(KoT + (2 * kp) * 72 + 8 * seg) = pack8(ko[0][0], ko[1][0], ko[2][0], ko[3][0], ko[4][0], ko[5][0], ko[6][0], ko[7][0]);
      *(bf16x8*)(KoT + (2 * kp + 1) * 72 + 8 * seg) = pack8(ko[0][1], ko[1][1], ko[2][1], ko[3][1], ko[4][1], ko[5][1], ko[6][1], ko[7][1]);
      if (seg == 0 && p.st_a) { *(f32x2*)(DL + (size_t)u * 128 + 2 * kp) = tot; }
    }
    if (u + (int)gridDim.x < 4096) hgrn_chunk_load(R, proj, u + gridDim.x, seg, kp);
    __syncthreads();
    {
      const int ti = wave >> 1;
#pragma unroll
      for (int uu = 0; uu < 2; ++uu) {
        const int si = 2 * (wave & 1) + uu;
        f32x4 acc = {0.f, 0.f, 0.f, 0.f};
        if (si <= ti) {
#pragma unroll
          for (int ks = 0; ks < 4; ++ks) {
            const bf16x8 a = *(const bf16x8*)(QD + (16 * ti + c16) * 136 + 32 * ks + 8 * q4);
            const bf16x8 bb = *(const bf16x8*)(KI + (16 * si + c16) * 136 + 32 * ks + 8 * q4);
            acc = MFMA16(a, bb, acc);
          }
        }
#pragma unroll
        for (int j = 0; j < 4; ++j) {
          const int t = 16 * ti + 4 * q4 + j, s = 16 * si + c16;
          const float v = (s <= t) ? acc[j] : 0.f;
          Am[t * 72 + s] = (bf16_t)(pk_bf16(v, 0.f) & 0xffffu);
        }
      }
    }
    __syncthreads();
    {
#pragma unroll
      for (int i = 0; i < 2; ++i) {
        const int idx = tid + 512 * i, k = idx >> 3, t8 = (idx & 7) * 8;
        const u32x4 w = *(const u32x4*)(KoT + k * 72 + t8);
        if (p.st_a) *(u32x4*)(proj + PB_RF + (tok0 + (k >> 1)) * 1024 + hh * 128 + (k & 1) * 64 + t8) = w;
      }
      const int t = tid >> 3, s8 = (tid & 7) * 8;
      const u32x4 w = *(const u32x4*)(Am + t * 72 + s8);
      if (p.st_a) *(u32x4*)(Hb + ((size_t)u * 64 + t) * 64 + s8) = w;
    }
  }
  __syncthreads();
}

struct ScanRegs { u32x4 qd[2]; u32x4 ko[2]; u32x4 am; unsigned rv[8]; };
DI void hgrn_scan_load(ScanRegs& R, const Params& p, int b, int hh, int c, int tid) {
  const bf16_t* proj = (const bf16_t*)(p.ws + WS_PROJ);
  const bf16_t* Hb = (const bf16_t*)(p.ws + WS_H);
  const int lane = tid & 63, wave = tid >> 6;
  const size_t tok0 = (size_t)b * SEQ + c * 64;
  const size_t u = (size_t)(b * 32 + c) * 8 + hh;
#pragma unroll
  for (int i = 0; i < 2; ++i) {
    const int idx = tid + 512 * i;
    R.qd[i] = *(const u32x4*)(proj + PB_RQ + (tok0 + (idx >> 4)) * 1024 + hh * 128 + (idx & 15) * 8);
    const int k = idx >> 3, t8 = (idx & 7) * 8;
    R.ko[i] = *(const u32x4*)(proj + PB_RF + (tok0 + (k >> 1)) * 1024 + hh * 128 + (k & 1) * 64 + t8);
  }
  R.am = *(const u32x4*)(Hb + (u * 64 + (tid >> 3)) * 64 + (tid & 7) * 8);
#pragma unroll
  for (int j = 0; j < 8; ++j) R.rv[j] = *(const unsigned*)(proj + PB_RI + (tok0 + 8 * wave + j) * 1024 + hh * 128 + 2 * lane);
}
DI void hgrn_scan_unit(const Params& p, char* smem, int unit) {
  const int hh = unit & 7, b = unit >> 3;
  bf16_t* proj = (bf16_t*)(p.ws + WS_PROJ);
  bf16_t* QD = (bf16_t*)smem;
  bf16_t* KoT = (bf16_t*)(smem + 17408);
  bf16_t* VT = (bf16_t*)(smem + 35840);
  bf16_t* Am = (bf16_t*)(smem + 54272);
  float* dla = (float*)(smem + 97792);
  float* Ob = (float*)(smem + 64000);
  const int tid = opaque_tid(), lane = tid & 63, wave = tid >> 6;
  const int c16 = lane & 15, q4 = lane >> 4;
  const int ft = tid >> 3, fv = (tid & 7) * 16;
  const int vcol = 16 * wave + c16;
  f32x4 S[8];
#pragma unroll
  for (int i = 0; i < 8; ++i) S[i] = (f32x4){0.f, 0.f, 0.f, 0.f};
  ScanRegs R0, R1;
  hgrn_scan_load(R0, p, b, hh, 0, tid);
  hgrn_scan_load(R1, p, b, hh, 1, tid);
  {
    const float* DL = (const float*)(p.ws + WS_DL);
#pragma unroll
    for (int i = 0; i < 2; ++i) { const int idx = tid + 512 * i, c = idx >> 5, k4 = (idx & 31) * 4; *(f32x4*)(dla + c * 128 + k4) = *(const f32x4*)(DL + ((size_t)(b * 32 + c) * 8 + hh) * 128 + k4); }
  }
  auto body = [&](const int c, ScanRegs& C) __attribute__((always_inline)) {
    const size_t tok0 = (size_t)b * SEQ + c * 64;
#pragma unroll
    for (int i = 0; i < 2; ++i) {
      const int idx = tid + 512 * i;
      *(u32x4*)(QD + (idx >> 4) * 136 + (idx & 15) * 8) = C.qd[i];
      *(u32x4*)(KoT + (idx >> 3) * 72 + (idx & 7) * 8) = C.ko[i];
    }
    *(u32x4*)(Am + (tid >> 3) * 72 + (tid & 7) * 8) = C.am;
    {
      u32x4 wl, wh;
#pragma unroll
      for (int i = 0; i < 4; ++i) { wl[i] = (C.rv[2 * i] & 0xffffu) | (C.rv[2 * i + 1] << 16); wh[i] = (C.rv[2 * i] >> 16) | (C.rv[2 * i + 1] & 0xffff0000u); }
      *(u32x4*)(VT + (2 * lane) * 72 + 8 * wave) = wl;
      *(u32x4*)(VT + (2 * lane + 1) * 72 + 8 * wave) = wh;
    }
    if (c + 2 < 32) hgrn_scan_load(C, p, b, hh, c + 2, tid);
    const float* dl = dla + c * 128;
    u32x4 rg[2];
    __syncthreads();
    {
      bf16x8 bv[2];
#pragma unroll
      for (int ks = 0; ks < 2; ++ks) bv[ks] = *(const bf16x8*)(VT + vcol * 72 + 32 * ks + 8 * q4);
#pragma unroll
      for (int th = 0; th < 2; ++th) {
        f32x4 o[2];
#pragma unroll
        for (int i = 0; i < 2; ++i) o[i] = (f32x4){0.f, 0.f, 0.f, 0.f};
#pragma unroll
        for (int kq = 0; kq < 4; ++kq) {
          const bf16x8 sf = pack8(S[2 * kq][0], S[2 * kq][1], S[2 * kq][2], S[2 * kq][3], S[2 * kq + 1][0], S[2 * kq + 1][1], S[2 * kq + 1][2], S[2 * kq + 1][3]);
#pragma unroll
          for (int t2 = 0; t2 < 2; ++t2) {
            const int ti = 2 * th + t2;
            const bf16_t* ap = QD + (16 * ti + c16) * 136 + 32 * kq + 4 * q4;
            const u32x2 lo = *(const u32x2*)ap, hi = *(const u32x2*)(ap + 16);
            const u32x4 av = {lo[0], lo[1], hi[0], hi[1]};
            o[t2] = MFMA16(__builtin_bit_cast(bf16x8, av), sf, o[t2]);
          }
        }
#pragma unroll
        for (int t2 = 0; t2 < 2; ++t2)
#pragma unroll
          for (int ks = 0; ks < 2; ++ks) {
            const bf16x8 a = *(const bf16x8*)(Am + (16 * (2 * th + t2) + c16) * 72 + 32 * ks + 8 * q4);
            o[t2] = MFMA16(a, bv[ks], o[t2]);
          }
#pragma unroll
        for (int t2 = 0; t2 < 2; ++t2)
#pragma unroll
          for (int j = 0; j < 4; ++j) Ob[(16 * (2 * th + t2) + 4 * q4 + j) * 132 + vcol] = o[t2][j];
        __builtin_amdgcn_sched_barrier(0);
      }
      {
        const bf16_t* gq = proj + PB_RG + (tok0 + ft) * 1024 + hh * 128 + fv;
        rg[0] = *(const u32x4*)gq; rg[1] = *(const u32x4*)(gq + 8);
      }
#pragma unroll
      for (int kt = 0; kt < 8; ++kt) {
        const f32x4 d = *(const f32x4*)(dl + 16 * kt + 4 * q4);
        S[kt] = S[kt] * d;
#pragma unroll
        for (int ks = 0; ks < 2; ++ks) {
          const bf16x8 a = *(const bf16x8*)(KoT + (16 * kt + c16) * 72 + 32 * ks + 8 * q4);
          S[kt] = MFMA16(a, bv[ks], S[kt]);
        }
        if (kt & 1) __builtin_amdgcn_sched_barrier(0);
      }
    }
    __syncthreads();
    {
      f32x4 ov[4]; float ss = 0.f;
#pragma unroll
      for (int i = 0; i < 4; ++i) { ov[i] = *(const f32x4*)(Ob + ft * 132 + fv + 4 * i); ss += ov[i][0] * ov[i][0] + ov[i][1] * ov[i][1] + ov[i][2] * ov[i][2] + ov[i][3] * ov[i][3]; }
      ss += __shfl_xor(ss, 1); ss += __shfl_xor(ss, 2); ss += __shfl_xor(ss, 4);
      const float rstd = rsqrtf(ss * (1.0f / 128.0f) + EPS);
      float y[16];
#pragma unroll
      for (int i = 0; i < 4; ++i) {
        const f32x4 w = *(const f32x4*)(p.rec_norm_w + fv + 4 * i);
        const unsigned ga = (i < 2) ? rg[0][2 * i] : rg[1][2 * (i - 2)], gb = (i < 2) ? rg[0][2 * i + 1] : rg[1][2 * (i - 2) + 1];
        y[4 * i + 0] = ov[i][0] * rstd * w[0] * bf_lo(ga);
        y[4 * i + 1] = ov[i][1] * rstd * w[1] * bf_hi(ga);
        y[4 * i + 2] = ov[i][2] * rstd * w[2] * bf_lo(gb);
        y[4 * i + 3] = ov[i][3] * rstd * w[3] * bf_hi(gb);
      }
      bf16_t* gp = proj + PB_RG + (tok0 + ft) * 1024 + hh * 128 + fv;
      if (p.st_m) {
      *(bf16x8*)gp = pack8(y[0], y[1], y[2], y[3], y[4], y[5], y[6], y[7]);
      *(bf16x8*)(gp + 8) = pack8(y[8], y[9], y[10], y[11], y[12], y[13], y[14], y[15]);
      }
    }
  };
#pragma unroll 1
  for (int c = 0; c < 32; c += 2) { body(c, R0); body(c + 1, R1); }
  __syncthreads();
}

DI void phase_mix(const Params& p, char* smem) {
  int* s_item = (int*)(smem + 131072);
  unsigned* ctr = (unsigned*)(p.ws + WS_CTRL) + CW_WORK;
  while (true) {
    if (threadIdx.x == 0) *s_item = (int)atomicAdd(ctr, 1u);
    __syncthreads();
    const int item = *s_item;
    __syncthreads();
    if (item >= 128 + 1024) break;
    if (item < 128) hgrn_scan_unit(p, smem, item); else attn_unit(p, smem, item - 128);
  }
}

DI void phase_gemm1(const Params& p, char* smem) {
  EpiProj e{(bf16_t*)(p.ws + WS_PROJ)};
  gemm_phase<D_MODEL, (1 << 30), 0, NTOK, IN_W, D_MODEL>((LAS unsigned char*)smem, (const bf16_t*)(p.ws + WS_H), (const bf16_t*)(p.ws + WS_WTIN), e);
}
DI void phase_gemm2(const Params& p, char* smem) {
  EpiOut e{p.out, p.x, (const float*)(p.ws + WS_MOD)};
  gemm_phase<1024, 16, (int)(PB_RG - PB_AG) - 1024, NTOK, D_MODEL, D_MIX>((LAS unsigned char*)smem, (const bf16_t*)(p.ws + WS_PROJ) + PB_AG, (const bf16_t*)(p.ws + WS_WTOUT), e);
}

extern __shared__ __attribute__((aligned(16))) char dyn_smem[];

#if ONE_LAUNCH
__global__ void __launch_bounds__(NTHREADS, 2) hymba_fwd(Params p) {
  cg::grid_group grid = cg::this_grid();
  volatile LAS unsigned* st = (volatile LAS unsigned*)((LAS unsigned char*)dyn_smem + 131072 + 16);
  if (threadIdx.x == 0) { st[0] = 0u; st[1] = 0u; }
  __syncthreads();
  const XcdBarrier xb = xcd_barrier_post((unsigned*)(p.ws + WS_XBAR), st);
  phase_prep(p, dyn_smem);
  phase_norm(p, dyn_smem);
  if (p.ws == nullptr) grid.sync();
  xcd_barrier(xb);
  phase_gemm1(p, dyn_smem);
  xcd_barrier(xb);
  phase_hgrn_chunk(p, dyn_smem);
  xcd_barrier(xb);
  phase_mix(p, dyn_smem);
  xcd_barrier(xb);
  phase_gemm2(p, dyn_smem);
}
#else
__global__ void __launch_bounds__(NTHREADS, 2) k_prep(Params p) { phase_prep(p, dyn_smem); }
__global__ void __launch_bounds__(NTHREADS, 2) k_norm(Params p) { phase_norm(p, dyn_smem); }
__global__ void __launch_bounds__(NTHREADS, 2) k_gemm1(Params p) { phase_gemm1(p, dyn_smem); }
__global__ void __launch_bounds__(NTHREADS, 2) k_hgrna(Params p) { phase_hgrn_chunk(p, dyn_smem); }
__global__ void __launch_bounds__(NTHREADS, 2) k_mix(Params p) { phase_mix(p, dyn_smem); }
__global__ void __launch_bounds__(NTHREADS, 2) k_gemm2(Params p) { phase_gemm2(p, dyn_smem); }
#endif

extern "C" void kernel_launch(void* const* d_in, const int* in_sizes, int n_in, void* d_out, int out_size, void* d_ws, size_t ws_size, hipStream_t stream) {
  static int grid = 0;
  if (grid == 0) {
    if (n_in != 13 || ws_size < WS_END) { fprintf(stderr, "kernel_launch: unexpected n_in %d or workspace %zu < %zu\n", n_in, ws_size, (size_t)WS_END); grid = -1; return; }
    int dev = 0, cus = 0, per_cu = 0;
    hipGetDevice(&dev);
    hipDeviceGetAttribute(&cus, hipDeviceAttributeMultiprocessorCount, dev);
#if ONE_LAUNCH
    if (hipFuncSetAttribute((const void*)hymba_fwd, hipFuncAttributeMaxDynamicSharedMemorySize, LDS_BYTES) != hipSuccess) { fprintf(stderr, "hipFuncSetAttribute failed\n"); grid = -1; return; }
    hipOccupancyMaxActiveBlocksPerMultiprocessor(&per_cu, (const void*)hymba_fwd, NTHREADS, LDS_BYTES);
    if (per_cu < 1) { fprintf(stderr, "occupancy query says %d blocks per CU\n", per_cu); per_cu = 1; }
    grid = cus * per_cu;
#else
    hipFuncSetAttribute((const void*)k_prep, hipFuncAttributeMaxDynamicSharedMemorySize, LDS_BYTES);
    hipFuncSetAttribute((const void*)k_gemm1, hipFuncAttributeMaxDynamicSharedMemorySize, LDS_BYTES);
    hipFuncSetAttribute((const void*)k_mix, hipFuncAttributeMaxDynamicSharedMemorySize, LDS_BYTES);
    hipFuncSetAttribute((const void*)k_hgrna, hipFuncAttributeMaxDynamicSharedMemorySize, LDS_BYTES);
    hipFuncSetAttribute((const void*)k_gemm2, hipFuncAttributeMaxDynamicSharedMemorySize, LDS_BYTES);
    (void)per_cu;
    grid = cus;
#endif
    (void)hipGetLastError();
  }
  if (grid < 0) return;
  (void)hipMemsetAsync((char*)d_ws + WS_CTRL, 0, 16384, stream);
  Params p{};
  p.x = (const float*)d_in[0]; p.c = (const float*)d_in[1]; p.pos = (const int*)d_in[2]; p.norm_w = (const float*)d_in[3];
  p.w_ada = (const float*)d_in[4]; p.b_ada = (const float*)d_in[5]; p.w_in = (const float*)d_in[6]; p.q_norm_w = (const float*)d_in[7];
  p.k_norm_w = (const float*)d_in[8]; p.sinks = (const float*)d_in[9]; p.rec_norm_w = (const float*)d_in[10];
  p.lower_bounds = (const float*)d_in[11]; p.w_out = (const float*)d_in[12]; p.out = (float*)d_out; p.ws = (char*)d_ws; p.st_a = 1; p.st_m = 1;
#if ONE_LAUNCH
  void* args[] = {&p};
  hipError_t e = hipLaunchCooperativeKernel((const void*)hymba_fwd, dim3(grid), dim3(NTHREADS), args, LDS_BYTES, stream);
  if (e != hipSuccess) fprintf(stderr, "cooperative launch failed: %s (grid %d)\n", hipGetErrorString(e), grid);
#else
  for (int r = 0; r < REP_PREP; ++r) hipLaunchKernelGGL(k_prep, dim3(grid), dim3(NTHREADS), LDS_BYTES, stream, p);
  for (int r = 0; r < REP_NORM; ++r) hipLaunchKernelGGL(k_norm, dim3(grid), dim3(NTHREADS), 16384, stream, p);
  for (int r = 0; r < REP_G1; ++r) hipLaunchKernelGGL(k_gemm1, dim3(grid), dim3(NTHREADS), LDS_BYTES, stream, p);
  for (int r = 0; r < REP_A; ++r) { p.st_a = (r == REP_A - 1); hipLaunchKernelGGL(k_hgrna, dim3(grid), dim3(NTHREADS), LDS_BYTES, stream, p); }
  for (int r = 0; r < REP_M; ++r) { p.st_m = (r == REP_M - 1); (void)hipMemsetAsync((char*)d_ws + WS_CTRL, 0, 16384, stream); hipLaunchKernelGGL(k_mix, dim3(grid), dim3(NTHREADS), LDS_BYTES, stream, p); }
  for (int r = 0; r < REP_G2; ++r) hipLaunchKernelGGL(k_gemm2, dim3(grid), dim3(NTHREADS), LDS_BYTES, stream, p);
#endif
}
```

```cpp
#include <hip/hip_runtime.h>
#include <hip/hip_cooperative_groups.h>
#include <cstdio>
#include <cstdint>
namespace cg = cooperative_groups;

#ifndef ONE_LAUNCH
#define ONE_LAUNCH 1
#endif

#define REP_PREP 1
#define REP_NORM 1
#define REP_G1 1
#define REP_G2 1
#define REP_A 1
#define REP_M 1
#define DI __device__ __forceinline__
typedef unsigned short bf16_t;
typedef short bf16x8 __attribute__((ext_vector_type(8)));
typedef float f32x4 __attribute__((ext_vector_type(4)));
typedef float f32x2 __attribute__((ext_vector_type(2)));
typedef float f32x16 __attribute__((ext_vector_type(16)));
typedef unsigned u32x4 __attribute__((ext_vector_type(4)));
typedef unsigned u32x2 __attribute__((ext_vector_type(2)));
typedef __bf16 bf16x2_t __attribute__((ext_vector_type(2)));

constexpr int D_MODEL = 1024, BATCH = 16, SEQ = 2048, NTOK = BATCH * SEQ, IN_W = 6656, D_MIX = 2048;
constexpr int OFF_AQ = 0, OFF_AK = 1024, OFF_AV = 1280, OFF_AG = 1536, OFF_RQ = 2560, OFF_RF = 3584, OFF_RI = 4608, OFF_RG = 5632;
constexpr size_t PB_AQ = 0, PB_AK = PB_AQ + (size_t)NTOK * 1024, PB_AV = PB_AK + (size_t)NTOK * 256, PB_AG = PB_AV + (size_t)NTOK * 256,
                 PB_RQ = PB_AG + (size_t)NTOK * 1024, PB_RF = PB_RQ + (size_t)NTOK * 1024, PB_RI = PB_RF + (size_t)NTOK * 1024, PB_RG = PB_RI + (size_t)NTOK * 1024;
constexpr float EPS = 1e-6f;
constexpr int NTHREADS = 512;
constexpr int LDS_BYTES = 131072 + 256;

constexpr size_t MiB = 1024 * 1024;
constexpr size_t WS_CTRL = 0, WS_XBAR = 2048, WS_MOD = 16384, WS_ROPE = 1 * MiB, WS_WTIN = 9 * MiB, WS_WTOUT = 22 * MiB, WS_H = 26 * MiB, WS_PROJ = 90 * MiB, WS_DL = 506 * MiB,
                 WS_END = WS_DL + 2 * MiB;

struct Params {
  const float* x; const float* c; const int* pos; const float* norm_w; const float* w_ada; const float* b_ada;
  const float* w_in; const float* q_norm_w; const float* k_norm_w; const float* sinks; const float* rec_norm_w;
  const float* lower_bounds; const float* w_out; float* out; char* ws; int st_a; int st_m;
};

DI int opaque_tid() { int t = threadIdx.x; asm volatile("" : "+v"(t)); return t; }
DI unsigned pk_bf16(float lo, float hi) { f32x2 v = {lo, hi}; bf16x2_t b = __builtin_convertvector(v, bf16x2_t); return __builtin_bit_cast(unsigned, b); }
DI float bf_lo(unsigned u) { return __uint_as_float(u << 16); }
DI float bf_hi(unsigned u) { return __uint_as_float(u & 0xffff0000u); }
DI bf16x8 pack8(float a0, float a1, float a2, float a3, float a4, float a5, float a6, float a7) {
  u32x4 w = {pk_bf16(a0, a1), pk_bf16(a2, a3), pk_bf16(a4, a5), pk_bf16(a6, a7)}; return __builtin_bit_cast(bf16x8, w);
}
DI float fast_exp(float x) { return __builtin_amdgcn_exp2f(x * 1.4426950408889634f); }
DI float fast_rcp(float x) { return __builtin_amdgcn_rcpf(x); }
DI float silu(float x) { return x * fast_rcp(1.f + fast_exp(-x)); }
#define MFMA16(a, b, c) __builtin_amdgcn_mfma_f32_16x16x32_bf16((a), (b), (c), 0, 0, 0)
#define MFMA32(a, b, c) __builtin_amdgcn_mfma_f32_32x32x16_bf16((a), (b), (c), 0, 0, 0)

constexpr int CW_WORK = 0, CW_BAR1 = 64, CW_BAR2 = 128, CW_MOD = 192, CW_NORM = 320, CW_TR = 384;
#define XB_TMO      128
#define XB_XCNT(j)  (256  + 64 * (j))
#define XB_XSUB(j)  (1280 + 64 * (j))
#define XB_XGEN(j)  (2304 + 64 * (j))
#define XB_TOP      3328
#define XB_TOPGEN   3392
#define XCD_BAR_WORDS 3456
#define XB_SPIN_CAP (1u << 22)
#define LAS __attribute__((address_space(3)))
DI unsigned xb_ld(unsigned* p) { return __hip_atomic_load(p, __ATOMIC_RELAXED, __HIP_MEMORY_SCOPE_AGENT); }
DI unsigned xb_add(unsigned* p, unsigned v) { return __hip_atomic_fetch_add(p, v, __ATOMIC_RELAXED, __HIP_MEMORY_SCOPE_AGENT); }
DI unsigned xb_xcc_id() { return (unsigned)__builtin_amdgcn_s_getreg((3 << 11) | 20) & 0xFu; }
#define XB_SPIN(cond, bar) do { unsigned _sp = 0; while (cond) { __builtin_amdgcn_s_sleep(1); \
    if ((++_sp & 255u) == 0u) { if (xb_ld(&(bar)[XB_TMO])) break; if (_sp > XB_SPIN_CAP) { atomicAdd(&(bar)[XB_TMO], 1u); break; } } } } while (0)
struct XcdBarrier { unsigned* bar; unsigned x; volatile LAS unsigned* st; };
DI XcdBarrier xcd_barrier_post(unsigned* bar, volatile LAS unsigned* st) {
  XcdBarrier b; b.bar = bar; b.x = xb_xcc_id(); b.st = st;
  if (threadIdx.x == 0) (void)xb_add(&bar[XB_XCNT(b.x)], 1u);
  return b;
}
DI void xcd_barrier_complete(unsigned* bar, unsigned x, unsigned& nloc, unsigned& nx) {
  const unsigned G = gridDim.x;
  unsigned sum, cnt, mine, sp = 0u;
  for (;;) {
    sum = 0u; cnt = 0u; mine = 0u;
#pragma unroll
    for (unsigned j = 0; j < 16; ++j) { const unsigned c = xb_ld(&bar[XB_XCNT(j)]); sum += c; cnt += (c > 0u) ? 1u : 0u; mine = (j == x) ? c : mine; }
    if (sum == G) break;
    __builtin_amdgcn_s_sleep(1);
    if ((++sp & 255u) == 0u) { if (xb_ld(&bar[XB_TMO])) break; if (sp > XB_SPIN_CAP) { atomicAdd(&bar[XB_TMO], 1u); break; } }
  }
  nloc = mine > 0u ? mine : 1u; nx = cnt > 0u ? cnt : 1u;
}
DI void xcd_barrier(const XcdBarrier& b) {
  asm volatile("s_waitcnt vmcnt(0)" ::: "memory");
  __syncthreads();
  if (threadIdx.x == 0) {
    unsigned* bar = b.bar;
    __builtin_amdgcn_s_waitcnt(0);
    unsigned nloc = b.st[0], nx = b.st[1];
    if (nloc == 0u) { xcd_barrier_complete(bar, b.x, nloc, nx); b.st[0] = nloc; b.st[1] = nx; }
    const unsigned old = xb_add(&bar[XB_XSUB(b.x)], 1u);
    const unsigned gen = old / nloc;
    if (old + 1u == (gen + 1u) * nloc) {
      __builtin_amdgcn_fence(__ATOMIC_RELEASE, "agent");
      asm volatile("s_waitcnt vmcnt(0)" ::: "memory");
      const unsigned og = xb_add(&bar[XB_TOP], 1u);
      const unsigned tg = og / nx;
      if (og + 1u == (tg + 1u) * nx) xb_add(&bar[XB_TOPGEN], 1u);
      else XB_SPIN(xb_ld(&bar[XB_TOPGEN]) == tg, bar);
      __builtin_amdgcn_fence(__ATOMIC_ACQUIRE, "agent");
      xb_add(&bar[XB_XGEN(b.x)], 1u);
      asm volatile("s_waitcnt vmcnt(0)" ::: "memory");
    } else {
      XB_SPIN(xb_ld(&bar[XB_XGEN(b.x)]) == gen, bar);
      __builtin_amdgcn_fence(__ATOMIC_ACQUIRE, "agent");
      asm volatile("s_waitcnt vmcnt(0)" ::: "memory");
    }
  }
  __syncthreads();
}

DI void transpose_tile4(const float* __restrict__ W, int ldw, bf16_t* __restrict__ Wt, int ldt, int k0, int n0, float* tile, int tid) {
  f32x4 v[8];
#pragma unroll
  for (int pass = 0; pass < 8; ++pass) {
    const int r = (tid >> 4) + 32 * pass, c4 = (tid & 15) * 4;
    v[pass] = *(const f32x4*)(W + (size_t)(k0 + r) * ldw + n0 + c4);
  }
#pragma unroll
  for (int pass = 0; pass < 8; ++pass) {
    const int r = (tid >> 4) + 32 * pass, c4 = (tid & 15) * 4;
    tile[r * 65 + c4 + 0] = v[pass][0]; tile[r * 65 + c4 + 1] = v[pass][1]; tile[r * 65 + c4 + 2] = v[pass][2]; tile[r * 65 + c4 + 3] = v[pass][3];
  }
  __syncthreads();
#pragma unroll
  for (int pass = 0; pass < 4; ++pass) {
    const int idx = tid + 512 * pass, nl = idx >> 5, kseg = (idx & 31) * 8;
    float x[8];
#pragma unroll
    for (int j = 0; j < 8; ++j) x[j] = tile[(kseg + j) * 65 + nl];
    const int c = nl & 31, rho = 16 * ((c >> 2) & 1) + 4 * (c >> 3) + (c & 3), nrow = n0 + (nl & 32) + rho;
    u32x4 w = {pk_bf16(x[0], x[1]), pk_bf16(x[2], x[3]), pk_bf16(x[4], x[5]), pk_bf16(x[6], x[7])};
    *(u32x4*)(Wt + (size_t)nrow * ldt + k0 + kseg) = w;
  }
  __syncthreads();
}

DI void phase_prep(const Params& p, char* smem) {
  const int tid = opaque_tid();
  float* rope = (float*)(p.ws + WS_ROPE);
  for (int i = blockIdx.x * NTHREADS + tid; i < NTOK * 32; i += gridDim.x * NTHREADS) {
    const int tok = i >> 5, f = i & 31;
    const float inv = exp2f(-(float)f * (13.287712379549449f / 32.0f));
    const float ang = (float)p.pos[tok] * inv;
    double t = (double)ang * 0.15915494309189535; t -= rint(t);
    const float r = (float)t;
    rope[(size_t)tok * 64 + f] = __builtin_amdgcn_cosf(r);
    rope[(size_t)tok * 64 + 32 + f] = __builtin_amdgcn_sinf(r);
  }
  float* mod = (float*)(p.ws + WS_MOD);
  bf16_t* wtin = (bf16_t*)(p.ws + WS_WTIN);
  bf16_t* wtout = (bf16_t*)(p.ws + WS_WTOUT);
  constexpr int J_MOD = 192, J_WIN = 4 * 104, J_WOUT = 8 * 16;
  for (int job = blockIdx.x; job < J_MOD; job += gridDim.x) {
      float* cact = (float*)smem;
      float* red = (float*)(smem + 65536);
      for (int i = tid; i < 16 * 256; i += NTHREADS) { const int b = i >> 8, k = (job / 48) * 256 + (i & 255); const float v = p.c[b * 1024 + k]; cact[b * 1024 + k] = silu(v); }
      __syncthreads();
      const int n = tid & 63, ks = tid >> 6, n0 = (job % 48) * 64, ksp = job / 48;
      float acc[16];
#pragma unroll
      for (int b = 0; b < 16; ++b) acc[b] = 0.f;
#pragma unroll 1
      for (int k = ksp * 256 + ks * 32; k < ksp * 256 + ks * 32 + 32; k += 16) {
        float w[16];
#pragma unroll
        for (int u = 0; u < 16; ++u) w[u] = p.w_ada[(size_t)(k + u) * 3072 + n0 + n];
#pragma unroll
        for (int u = 0; u < 16; ++u)
#pragma unroll
          for (int b = 0; b < 16; ++b) acc[b] += cact[b * 1024 + k + u] * w[u];
      }
#pragma unroll
      for (int b = 0; b < 16; ++b) red[(ks * 16 + b) * 64 + n] = acc[b];
      __syncthreads();
      for (int o = tid; o < 1024; o += NTHREADS) {
        const int b = o >> 6, nn = o & 63; float sacc = (ksp == 0) ? p.b_ada[n0 + nn] : 0.f;
#pragma unroll
        for (int k2 = 0; k2 < 8; ++k2) sacc += red[(k2 * 16 + b) * 64 + nn];
        mod[(ksp * 16 + b) * 3072 + n0 + nn] = sacc;
      }
      asm volatile("s_waitcnt vmcnt(0)" ::: "memory");
      __syncthreads();
      if (tid == 0) __hip_atomic_fetch_add((unsigned*)(p.ws + WS_CTRL) + CW_MOD, 1u, __ATOMIC_RELEASE, __HIP_MEMORY_SCOPE_AGENT);
  }
}
DI void prep_transpose_job(const Params& p, char* smem, int j, int tid) {
  constexpr int J_WIN = 4 * 104;
  bf16_t* wtin = (bf16_t*)(p.ws + WS_WTIN);
  bf16_t* wtout = (bf16_t*)(p.ws + WS_WTOUT);
  if (j < J_WIN) { const int kt = j & 3, nt = j >> 2; transpose_tile4(p.w_in, IN_W, wtin, D_MODEL, kt * 256, nt * 64, (float*)smem, tid); }
  else { const int j2 = j - J_WIN, kt = j2 & 7, nt = j2 >> 3; transpose_tile4(p.w_out, D_MODEL, wtout, D_MIX, kt * 256, nt * 64, (float*)smem, tid); }
}

DI void phase_norm(const Params& p, char* smem) {
  const int tid = opaque_tid(), lane = tid & 63, wave = tid >> 6;
  const float* mod = (const float*)(p.ws + WS_MOD);
  bf16_t* H = (bf16_t*)(p.ws + WS_H);
  float* sc1 = (float*)(smem + 69632);
  float* shv = (float*)(smem + 69632 + 4096);
  int* s_item = (int*)(smem + 131072);
  unsigned* nctr = (unsigned*)(p.ws + WS_CTRL) + CW_NORM;
  unsigned* tctr = (unsigned*)(p.ws + WS_CTRL) + CW_TR;
  int bprev = -1;
  bool tr_left = true, nm_left = true, mod_ok = false;
  for (int step = 0; tr_left || nm_left; ++step) {
    const bool do_tr = tr_left && ((step % 3) == 0 || !nm_left);
    if (tid == 0) *s_item = do_tr ? (int)atomicAdd(tctr, 1u) : (int)atomicAdd(nctr, 1u);
    __syncthreads();
    const int g = *s_item;
    __syncthreads();
    if (do_tr) {
      if (g >= 4 * 104 + 8 * 16) tr_left = false; else prep_transpose_job(p, smem, g, tid);
      continue;
    }
    if (g >= NTOK / 64) { nm_left = false; continue; }
    if (!mod_ok) {
      if (tid == 0) { const unsigned* mc = (const unsigned*)(p.ws + WS_CTRL) + CW_MOD; while (__hip_atomic_load(mc, __ATOMIC_ACQUIRE, __HIP_MEMORY_SCOPE_AGENT) < 192u) __builtin_amdgcn_s_sleep(1); }
      __syncthreads();
      mod_ok = true;
    }
    const int b = g >> 5;
    if (b != bprev) {
      for (int col = tid; col < 1024; col += NTHREADS) {
        float sh = 0.f, sc = 0.f;
#pragma unroll
        for (int k2 = 0; k2 < 4; ++k2) { sh += mod[(k2 * 16 + b) * 3072 + col]; sc += mod[(k2 * 16 + b) * 3072 + 1024 + col]; }
        sc1[col] = p.norm_w[col] * (1.f + sc); shv[col] = sh;
      }
      bprev = b;
      __syncthreads();
    }
#pragma unroll 1
    for (int it = 0; it < 4; ++it) {
      const int row0 = g * 64 + wave * 8 + it * 2;
      f32x4 v[2][4]; float ss[2] = {0.f, 0.f};
#pragma unroll
      for (int rr = 0; rr < 2; ++rr) {
        const f32x4* xr = (const f32x4*)(p.x + (size_t)(row0 + rr) * D_MODEL);
#pragma unroll
        for (int i = 0; i < 4; ++i) v[rr][i] = xr[lane + 64 * i];
      }
#pragma unroll
      for (int rr = 0; rr < 2; ++rr) {
#pragma unroll
        for (int i = 0; i < 4; ++i) ss[rr] += v[rr][i][0] * v[rr][i][0] + v[rr][i][1] * v[rr][i][1] + v[rr][i][2] * v[rr][i][2] + v[rr][i][3] * v[rr][i][3];
#pragma unroll
        for (int o = 32; o >= 1; o >>= 1) ss[rr] += __shfl_xor(ss[rr], o);
        ss[rr] = rsqrtf(ss[rr] * (1.0f / D_MODEL) + EPS);
      }
#pragma unroll
      for (int i = 0; i < 4; ++i) {
        const int col = (lane + 64 * i) * 4;
        const f32x4 a = *(const f32x4*)(sc1 + col), sh = *(const f32x4*)(shv + col);
#pragma unroll
        for (int rr = 0; rr < 2; ++rr) {
          float h[4];
#pragma unroll
          for (int j = 0; j < 4; ++j) h[j] = v[rr][i][j] * ss[rr] * a[j] + sh[j];
          u32x2 w = {pk_bf16(h[0], h[1]), pk_bf16(h[2], h[3])};
          *(u32x2*)(H + (size_t)(row0 + rr) * D_MODEL + col) = w;
        }
      }
    }
  }
}

constexpr int BM = 256, BK = 64, HALF = 128, NXCD = 8, WGM = 8, HT = HALF * BK;
DI int lds_byte(int r, int c) { const int st = (r >> 4) * 2 + (c >> 5), rr = r & 15, cc = c & 31, ob = rr * 64 + cc * 2; return st * 1024 + (ob ^ (((ob >> 9) & 1) << 5)); }
DI void stage_rc(int b, int& R, int& C) { const int st = b / 1024, sb = b % 1024, swz = sb ^ (((sb >> 9) & 1) << 5); R = (st >> 1) * 16 + swz / 64; C = (st & 1) * 32 + (swz % 64) / 2; }

struct EpiProj {
  bf16_t* O;
  DI void operator()(const f32x4 (&acc)[2][2][4][2], int brow, int bcol, int wr, int wc, int fr, int fq) const {
    const bool gate_tile = (bcol >= OFF_AG && bcol < OFF_AG + 1024) || (bcol >= OFF_RG);
    size_t sbase; int sld, scol;
    if (bcol < OFF_AK) { sbase = PB_AQ; sld = 1024; scol = bcol - OFF_AQ; }
    else if (bcol < OFF_AV) { sbase = PB_AK; sld = 256; scol = bcol - OFF_AK; }
    else if (bcol < OFF_AG) { sbase = PB_AV; sld = 256; scol = bcol - OFF_AV; }
    else if (bcol < OFF_RQ) { sbase = PB_AG; sld = 1024; scol = bcol - OFF_AG; }
    else if (bcol < OFF_RF) { sbase = PB_RQ; sld = 1024; scol = bcol - OFF_RQ; }
    else if (bcol < OFF_RI) { sbase = PB_RF; sld = 1024; scol = bcol - OFF_RF; }
    else if (bcol < OFF_RG) { sbase = PB_RI; sld = 1024; scol = bcol - OFF_RI; }
    else { sbase = PB_RG; sld = 1024; scol = bcol - OFF_RG; }
#pragma unroll
    for (int ai = 0; ai < 2; ++ai)
#pragma unroll
      for (int m = 0; m < 4; ++m) {
        const int row = brow + ai * HALF + wr * 64 + m * 16 + fr;
        bf16_t* rp = O + sbase + (size_t)row * sld + scol + wc * 32 + 8 * fq;
#pragma unroll
        for (int bj = 0; bj < 2; ++bj) {
          f32x4 a0 = acc[ai][bj][m][0], a1 = acc[ai][bj][m][1];
          if (gate_tile) {
#pragma unroll
            for (int j = 0; j < 4; ++j) { a0[j] = silu(a0[j]); a1[j] = silu(a1[j]); }
          }
          u32x4 w = {pk_bf16(a0[0], a0[1]), pk_bf16(a0[2], a0[3]), pk_bf16(a1[0], a1[1]), pk_bf16(a1[2], a1[3])};
          __builtin_nontemporal_store(w, (u32x4*)(rp + bj * HALF));
        }
      }
  }
};
struct EpiOut {
  float* O; const float* X; const float* mod;
  DI void operator()(const f32x4 (&acc)[2][2][4][2], int brow, int bcol, int wr, int wc, int fr, int fq) const {
    const int b = brow >> 11;
    f32x4 g[2][2];
    {
      f32x4 gp[2][4][2];
#pragma unroll
      for (int bj = 0; bj < 2; ++bj)
#pragma unroll
        for (int k2 = 0; k2 < 4; ++k2) {
          const float* gq = mod + (k2 * 16 + b) * 3072 + 2048 + bcol + bj * HALF + wc * 32 + 8 * fq;
          gp[bj][k2][0] = *(const f32x4*)gq; gp[bj][k2][1] = *(const f32x4*)(gq + 4);
        }
#pragma unroll
      for (int bj = 0; bj < 2; ++bj) { g[bj][0] = (gp[bj][0][0] + gp[bj][1][0]) + (gp[bj][2][0] + gp[bj][3][0]); g[bj][1] = (gp[bj][0][1] + gp[bj][1][1]) + (gp[bj][2][1] + gp[bj][3][1]); }
    }
    f32x4 xb[2][4][2];
    auto ldb = [&](int q, f32x4 (&x)[4][2]) __attribute__((always_inline)) {
      const int bj = q >> 1, ai = q & 1, col = bcol + bj * HALF + wc * 32 + 8 * fq;
#pragma unroll
      for (int m = 0; m < 4; ++m) {
        const size_t o = (size_t)(brow + ai * HALF + wr * 64 + m * 16 + fr) * D_MODEL + col;
        x[m][0] = *(const f32x4*)(X + o); x[m][1] = *(const f32x4*)(X + o + 4);
      }
    };
    ldb(0, xb[0]);
#pragma unroll
    for (int q = 0; q < 4; ++q) {
      if (q + 1 < 4) ldb(q + 1, xb[(q + 1) & 1]);
      const int bj = q >> 1, ai = q & 1, col = bcol + bj * HALF + wc * 32 + 8 * fq;
#pragma unroll
      for (int m = 0; m < 4; ++m) {
        const size_t o = (size_t)(brow + ai * HALF + wr * 64 + m * 16 + fr) * D_MODEL + col;
        *(f32x4*)(O + o) = xb[q & 1][m][0] + g[bj][0] * acc[ai][bj][m][0];
        *(f32x4*)(O + o + 4) = xb[q & 1][m][1] + g[bj][1] * acc[ai][bj][m][1];
      }
    }
  }
};

template <int lda, int split_kt, int gap, int M, int N, int K, class Epi>
DI void gemm_phase(LAS unsigned char* lds, const bf16_t* __restrict__ A, const bf16_t* __restrict__ Bt, const Epi& epi) {
#define SA(b, h) (((b) * 2 + (h)) * (HT * 2))
#define SB(b, h) ((4 + (b) * 2 + (h)) * (HT * 2))
#define STAGE_A(P, br, kt) do { const char* _g = (const char*)(A + (size_t)(br) * lda + (kt) * BK + ((kt) >= split_kt ? gap : 0)); \
    _Pragma("unroll") for (int _i = 0; _i < 2; ++_i) { \
      __builtin_amdgcn_global_load_lds((const unsigned*)(_g + aoff[_i]), (LAS unsigned*)(lds + (P) + ldsw + _i * 8192), 16, 0, 0); } } while (0)
#define STAGE_B(P, br, kt) do { const char* _g = (const char*)(Bt + (size_t)(br) * K + (kt) * BK); \
    _Pragma("unroll") for (int _i = 0; _i < 2; ++_i) { \
      __builtin_amdgcn_global_load_lds((const unsigned*)(_g + boff[_i]), (LAS unsigned*)(lds + (P) + ldsw + _i * 8192), 16, 0, 0); } } while (0)
#define LDA(dst, b, h) _Pragma("unroll") for (int m = 0; m < 4; ++m) _Pragma("unroll") for (int k = 0; k < 2; ++k) \
    dst[m][k] = *(const LAS bf16x8*)(lds + SA(b, h) + ra + m * 2048 + k * 1024)
#define LDB(dst, b, h) _Pragma("unroll") for (int n = 0; n < 2; ++n) _Pragma("unroll") for (int k = 0; k < 2; ++k) \
    dst[n][k] = *(const LAS bf16x8*)(lds + SB(b, h) + rb + n * 2048 + k * 1024)
#define MMA(ai, bj, At, Bf) do { __builtin_amdgcn_s_setprio(1); \
    _Pragma("unroll") for (int m = 0; m < 4; ++m) _Pragma("unroll") for (int n = 0; n < 2; ++n) _Pragma("unroll") for (int k = 0; k < 2; ++k) \
      acc[ai][bj][m][n] = __builtin_amdgcn_mfma_f32_16x16x32_bf16(Bf[n][k], At[m][k], acc[ai][bj][m][n], 0, 0, 0); \
    __builtin_amdgcn_s_setprio(0); } while (0)
#define WAIT_V(n) asm volatile("s_waitcnt vmcnt(" #n ")" ::: "memory")
#define WAIT_L(n) asm volatile("s_waitcnt lgkmcnt(" #n ")" ::: "memory")
#define BAR __builtin_amdgcn_s_barrier()
#define SCHED __builtin_amdgcn_sched_barrier(0)
  const int nM = M / BM, nN = N / BM, nwg = nM * nN;
  const int gtid = opaque_tid();
  const int wid = __builtin_amdgcn_readfirstlane(gtid >> 6), lane = gtid & 63, wr = wid >> 2, wc = wid & 3, fr = lane & 15, fq = lane >> 4;
  constexpr int nt = K / BK;
  const unsigned ldsw = (unsigned)wid * 1024u;
  const int ra = lds_byte(wr * 64 + fr, fq * 8), rb = lds_byte(wc * 32 + fr, fq * 8);
  unsigned aoff[2], boff[2];
#pragma unroll
  for (int i = 0; i < 2; ++i) { int r_, c_; stage_rc(gtid * 16 + i * 8192, r_, c_); aoff[i] = (unsigned)(r_ * lda + c_) * 2u; boff[i] = (unsigned)(r_ * K + c_) * 2u; }
  auto decode = [&](int L, int& brow_, int& bcol_) __attribute__((always_inline)) {
    int wgid = L;
    { const int q = nwg / NXCD, r = nwg % NXCD, xcd = wgid % NXCD, off = wgid / NXCD; wgid = (xcd < r ? xcd * (q + 1) : r * (q + 1) + (xcd - r) * q) + off; }
    const int nig = WGM * nN, gid = wgid / nig, fm = gid * WGM, gsz = min(nM - fm, WGM);
    const int pm = fm + ((wgid % nig) % gsz), pn = (wgid % nig) / gsz; brow_ = pm * BM; bcol_ = pn * BM;
  };
  int L = blockIdx.x;
  if (L < nwg) {
    int brow, bcol; decode(L, brow, bcol);
    f32x4 acc[2][2][4][2];
#pragma unroll
    for (int a = 0; a < 2; ++a)
#pragma unroll
      for (int b = 0; b < 2; ++b)
#pragma unroll
        for (int m = 0; m < 4; ++m)
#pragma unroll
          for (int n = 0; n < 2; ++n) acc[a][b][m][n] = (f32x4){0.f, 0.f, 0.f, 0.f};
    bf16x8 At[4][2], B0[2][2], B1[2][2];
    STAGE_B(SB(0, 0), bcol, 0); STAGE_A(SA(0, 0), brow, 0);
    STAGE_B(SB(0, 1), bcol + HALF, 0); STAGE_A(SA(0, 1), brow + HALF, 0);
    if (wr == 1) BAR;
    WAIT_V(4); BAR;
    STAGE_B(SB(1, 0), bcol, 1); STAGE_A(SA(1, 0), brow, 1); STAGE_B(SB(1, 1), bcol + HALF, 1);
    WAIT_V(6); BAR;
#pragma unroll 1
    for (;;) {
      const int Ln = L + gridDim.x;
      int nrow = brow, ncol = bcol;
      if (Ln < nwg) decode(Ln, nrow, ncol);
#pragma unroll 1
      for (int t = 0; t < nt; t += 2) {
        const bool last = (t == nt - 2);
        const int r2 = last ? nrow : brow, c2 = last ? ncol : bcol, k2 = last ? 0 : t + 2, k3 = last ? 1 : t + 3;
        LDB(B0, 0, 0); SCHED; LDA(At, 0, 0); STAGE_A(SA(1, 1), brow + HALF, t + 1);
        WAIT_L(8); BAR; WAIT_L(0); MMA(0, 0, At, B0); BAR; SCHED;
        LDB(B1, 0, 1); STAGE_B(SB(0, 0), c2, k2);
        BAR; WAIT_L(0); MMA(0, 1, At, B1); BAR;
        LDA(At, 0, 1); STAGE_A(SA(0, 0), r2, k2);
        BAR; WAIT_L(0); MMA(1, 0, At, B0); BAR; SCHED;
        STAGE_B(SB(0, 1), c2 + HALF, k2);
        WAIT_V(6); BAR; MMA(1, 1, At, B1); BAR;
        LDB(B0, 1, 0); SCHED; LDA(At, 1, 0); STAGE_A(SA(0, 1), r2 + HALF, k2);
        WAIT_L(8); BAR; WAIT_L(0); MMA(0, 0, At, B0); BAR; SCHED;
        LDB(B1, 1, 1); STAGE_B(SB(1, 0), c2, k3);
        BAR; WAIT_L(0); MMA(0, 1, At, B1); BAR;
        LDA(At, 1, 1); STAGE_A(SA(1, 0), r2, k3);
        BAR; WAIT_L(0); MMA(1, 0, At, B0); BAR; SCHED;
        STAGE_B(SB(1, 1), c2 + HALF, k3);
        WAIT_V(6); BAR; MMA(1, 1, At, B1); BAR;
      }
      epi(acc, brow, bcol, wr, wc, fr, fq);
#pragma unroll
      for (int a = 0; a < 2; ++a)
#pragma unroll
        for (int b = 0; b < 2; ++b)
#pragma unroll
          for (int m = 0; m < 4; ++m)
#pragma unroll
            for (int n = 0; n < 2; ++n) acc[a][b][m][n] = (f32x4){0.f, 0.f, 0.f, 0.f};
      if (Ln >= nwg) break;
      L = Ln; brow = nrow; bcol = ncol;
    }
    WAIT_V(0);
    if (wr == 0) BAR;
  }
  __syncthreads();
#undef SA
#undef SB
}

DI void attn_unit(const Params& p, char* smem, int unit) {
  const int kvh = unit & 3, nb = (unit >> 2) & 15, b = unit >> 6;
  bf16_t* proj = (bf16_t*)(p.ws + WS_PROJ);
  const float* rope = (const float*)(p.ws + WS_ROPE);
  bf16_t* Ks = (bf16_t*)smem;
  bf16_t* Vt = (bf16_t*)(smem + 36864);
  const int tid = opaque_tid(), lane = tid & 63, wave = tid >> 6;
  {
    const int key = tid >> 1, half = tid & 1;
    const int tokl = nb * 128 - 128 + key;
    u32x4 o0 = {0, 0, 0, 0}, o1 = o0, o2 = o0, o3 = o0;
    u32x4 v0 = o0, v1 = o0, v2 = o0, v3 = o0;
    if (tokl >= 0) {
      const size_t tok = (size_t)b * SEQ + tokl;
      const bf16_t* kp = proj + PB_AK + tok * 256 + kvh * 64 + 16 * half;
      const u32x4 r0 = *(const u32x4*)kp, r1 = *(const u32x4*)(kp + 8), r2 = *(const u32x4*)(kp + 32), r3 = *(const u32x4*)(kp + 40);
      const bf16_t* vp = proj + PB_AV + tok * 256 + kvh * 64 + 32 * half;
      v0 = *(const u32x4*)vp; v1 = *(const u32x4*)(vp + 8); v2 = *(const u32x4*)(vp + 16); v3 = *(const u32x4*)(vp + 24);
      float x1[16], x2[16];
#pragma unroll
      for (int i = 0; i < 4; ++i) { x1[2 * i] = bf_lo(r0[i]); x1[2 * i + 1] = bf_hi(r0[i]); x1[8 + 2 * i] = bf_lo(r1[i]); x1[8 + 2 * i + 1] = bf_hi(r1[i]);
                                    x2[2 * i] = bf_lo(r2[i]); x2[2 * i + 1] = bf_hi(r2[i]); x2[8 + 2 * i] = bf_lo(r3[i]); x2[8 + 2 * i + 1] = bf_hi(r3[i]); }
      float ss = 0.f;
#pragma unroll
      for (int j = 0; j < 16; ++j) ss += x1[j] * x1[j] + x2[j] * x2[j];
      ss += __shfl_xor(ss, 1);
      const float rstd = rsqrtf(ss * (1.0f / 64.0f) + EPS);
      const float* cs = rope + tok * 64 + 16 * half;
      const float* kw = p.k_norm_w + 16 * half;
      float y1[16], y2[16];
#pragma unroll
      for (int j = 0; j < 16; ++j) {
        const float a1 = x1[j] * rstd * kw[j], a2 = x2[j] * rstd * kw[32 + j], c = cs[j], s = cs[32 + j];
        y1[j] = a1 * c - a2 * s; y2[j] = a2 * c + a1 * s;
      }
      o0 = (u32x4){pk_bf16(y1[0], y1[1]), pk_bf16(y1[2], y1[3]), pk_bf16(y1[4], y1[5]), pk_bf16(y1[6], y1[7])};
      o1 = (u32x4){pk_bf16(y1[8], y1[9]), pk_bf16(y1[10], y1[11]), pk_bf16(y1[12], y1[13]), pk_bf16(y1[14], y1[15])};
      o2 = (u32x4){pk_bf16(y2[0], y2[1]), pk_bf16(y2[2], y2[3]), pk_bf16(y2[4], y2[5]), pk_bf16(y2[6], y2[7])};
      o3 = (u32x4){pk_bf16(y2[8], y2[9]), pk_bf16(y2[10], y2[11]), pk_bf16(y2[12], y2[13]), pk_bf16(y2[14], y2[15])};
    }
    bf16_t* kd = Ks + key * 72 + 16 * half;
    *(u32x4*)kd = o0; *(u32x4*)(kd + 8) = o1; *(u32x4*)(kd + 32) = o2; *(u32x4*)(kd + 40) = o3;
    bf16_t* vd = Vt + (32 * half) * 260 + key;
#pragma unroll
    for (int i = 0; i < 4; ++i) {
      vd[(2 * i) * 260] = (bf16_t)(v0[i] & 0xffffu); vd[(2 * i + 1) * 260] = (bf16_t)(v0[i] >> 16);
      vd[(8 + 2 * i) * 260] = (bf16_t)(v1[i] & 0xffffu); vd[(8 + 2 * i + 1) * 260] = (bf16_t)(v1[i] >> 16);
      vd[(16 + 2 * i) * 260] = (bf16_t)(v2[i] & 0xffffu); vd[(16 + 2 * i + 1) * 260] = (bf16_t)(v2[i] >> 16);
      vd[(24 + 2 * i) * 260] = (bf16_t)(v3[i] & 0xffffu); vd[(24 + 2 * i + 1) * 260] = (bf16_t)(v3[i] >> 16);
    }
  }
  __syncthreads();
  const int r = lane & 31, h = lane >> 5;
  constexpr float LOG2E = 1.4426950408889634f;
#pragma unroll 1
  for (int it = 0; it < 2; ++it) {
    const int item = wave * 2 + it, g = item >> 2, qs = item & 3;
    const int head = kvh * 4 + g;
    const size_t tok = (size_t)b * SEQ + nb * 128 + qs * 32 + r;
    bf16x8 qf[4];
    u32x4 gr[4];
    bf16_t* gbase = proj + PB_AG + ((size_t)b * SEQ + nb * 128 + qs * 32 + (lane >> 3)) * 1024 + head * 64 + (lane & 7) * 8;
#pragma unroll
    for (int i = 0; i < 4; ++i) gr[i] = *(const u32x4*)(gbase + (size_t)(8 * i) * 1024);
    {
      const u32x4* qp = (const u32x4*)(proj + PB_AQ + tok * 1024 + head * 64 + 8 * h);
      float xq[4][8]; float ss = 0.f;
#pragma unroll
      for (int s = 0; s < 4; ++s) { const u32x4 rr = qp[2 * s];
#pragma unroll
        for (int i = 0; i < 4; ++i) { xq[s][2 * i] = bf_lo(rr[i]); xq[s][2 * i + 1] = bf_hi(rr[i]); } }
#pragma unroll
      for (int s = 0; s < 4; ++s)
#pragma unroll
        for (int j = 0; j < 8; ++j) ss += xq[s][j] * xq[s][j];
      ss += __shfl_xor(ss, 32);
      const float rstd = rsqrtf(ss * (1.0f / 64.0f) + EPS) * (0.125f * LOG2E);
      const float* cs = rope + tok * 64 + 8 * h;
      const float* qw = p.q_norm_w + 8 * h;
#pragma unroll
      for (int s = 0; s < 2; ++s) {
        float ya[8], yb[8];
#pragma unroll
        for (int j = 0; j < 8; ++j) {
          const float a1 = xq[s][j] * rstd * qw[16 * s + j], a2 = xq[s + 2][j] * rstd * qw[32 + 16 * s + j], c = cs[16 * s + j], sn = cs[32 + 16 * s + j];
          ya[j] = a1 * c - a2 * sn; yb[j] = a2 * c + a1 * sn;
        }
        qf[s] = pack8(ya[0], ya[1], ya[2], ya[3], ya[4], ya[5], ya[6], ya[7]);
        qf[s + 2] = pack8(yb[0], yb[1], yb[2], yb[3], yb[4], yb[5], yb[6], yb[7]);
      }
    }
    f32x16 sacc[5];
#pragma unroll
    for (int kt = 0; kt < 5; ++kt) {
#pragma unroll
      for (int i = 0; i < 16; ++i) sacc[kt][i] = 0.f;
#pragma unroll
      for (int s = 0; s < 4; ++s) {
        const bf16x8 a = *(const bf16x8*)(Ks + (qs * 32 + kt * 32 + r) * 72 + 16 * s + 8 * h);
        sacc[kt] = MFMA32(a, qf[s], sacc[kt]);
      }
    }
    const float sinkv = p.sinks[head] * LOG2E;
    float m = -INFINITY;
#pragma unroll
    for (int kt = 0; kt < 5; ++kt) {
      const bool tile_ok = (nb > 0) || (qs * 32 + kt * 32 >= 128);
#pragma unroll
      for (int i = 0; i < 16; ++i) {
        const int cr = (i & 3) + 8 * (i >> 2) + 4 * h;
        bool ok = tile_ok;
        if (kt == 0) ok = ok && (cr > r);
        if (kt == 4) ok = ok && (cr <= r);
        const float v = ok ? sacc[kt][i] : -INFINITY;
        sacc[kt][i] = v; m = fmaxf(m, v);
      }
    }
    m = fmaxf(m, __shfl_xor(m, 32)); m = fmaxf(m, sinkv);
    float l = 0.f;
#pragma unroll
    for (int kt = 0; kt < 5; ++kt)
#pragma unroll
      for (int i = 0; i < 16; ++i) { const float pv = __builtin_amdgcn_exp2f(sacc[kt][i] - m); sacc[kt][i] = pv; l += pv; }
    l += __shfl_xor(l, 32); l += __builtin_amdgcn_exp2f(sinkv - m);
    f32x16 oacc[2];
#pragma unroll
    for (int i = 0; i < 16; ++i) { oacc[0][i] = 0.f; oacc[1][i] = 0.f; }
#pragma unroll
    for (int kt = 0; kt < 5; ++kt)
#pragma unroll
      for (int s = 0; s < 2; ++s) {
        const bf16x8 pb = pack8(sacc[kt][8 * s], sacc[kt][8 * s + 1], sacc[kt][8 * s + 2], sacc[kt][8 * s + 3], sacc[kt][8 * s + 4], sacc[kt][8 * s + 5], sacc[kt][8 * s + 6], sacc[kt][8 * s + 7]);
#pragma unroll
        for (int ht = 0; ht < 2; ++ht) {
          const bf16_t* vp = Vt + (ht * 32 + r) * 260 + (qs * 32 + kt * 32 + 16 * s + 4 * h);
          const u32x2 lo = *(const u32x2*)vp, hi = *(const u32x2*)(vp + 8);
          const u32x4 av = {lo[0], lo[1], hi[0], hi[1]};
          oacc[ht] = MFMA32(__builtin_bit_cast(bf16x8, av), pb, oacc[ht]);
        }
      }
    const float inv = fast_rcp(l);
    bf16_t* Os = (bf16_t*)(smem + 70144) + wave * (32 * 72);
#pragma unroll
    for (int ht = 0; ht < 2; ++ht)
#pragma unroll
      for (int g4 = 0; g4 < 4; ++g4) {
        const u32x2 w = {pk_bf16(oacc[ht][4 * g4] * inv, oacc[ht][4 * g4 + 1] * inv), pk_bf16(oacc[ht][4 * g4 + 2] * inv, oacc[ht][4 * g4 + 3] * inv)};
        *(u32x2*)(Os + r * 72 + ht * 32 + 8 * g4 + 4 * h) = w;
      }
    __builtin_amdgcn_wave_barrier();
    asm volatile("s_waitcnt lgkmcnt(0)" ::: "memory");
#pragma unroll
    for (int i = 0; i < 4; ++i) {
      const u32x4 ov = *(const u32x4*)(Os + ((lane >> 3) + 8 * i) * 72 + (lane & 7) * 8);
      const u32x4 gv = gr[i];
      u32x4 w;
#pragma unroll
      for (int j = 0; j < 4; ++j) w[j] = pk_bf16(bf_lo(ov[j]) * bf_lo(gv[j]), bf_hi(ov[j]) * bf_hi(gv[j]));
      if (p.st_m) *(u32x4*)(gbase + (size_t)(8 * i) * 1024) = w;
    }
    __builtin_amdgcn_wave_barrier();
  }
  __syncthreads();
}

struct HgrnRegs { unsigned rq[8], rf[8]; };
DI void hgrn_chunk_load(HgrnRegs& R, const bf16_t* proj, int u, int seg, int kp) {
  const int hh = u & 7, c = (u >> 3) & 31, b = u >> 8;
  const size_t tok0 = (size_t)b * SEQ + c * 64;
#pragma unroll
  for (int j = 0; j < 8; ++j) {
    const bf16_t* base = proj + (tok0 + 8 * seg + j) * 1024 + hh * 128 + 2 * kp;
    R.rq[j] = *(const unsigned*)(base + PB_RQ); R.rf[j] = *(const unsigned*)(base + PB_RF);
  }
}
DI void phase_hgrn_chunk(const Params& p, char* smem) {
  bf16_t* proj = (bf16_t*)(p.ws + WS_PROJ);
  bf16_t* Hb = (bf16_t*)(p.ws + WS_H);
  float* DL = (float*)(p.ws + WS_DL);
  bf16_t* QD = (bf16_t*)smem;
  bf16_t* KI = (bf16_t*)(smem + 17408);
  bf16_t* KoT = (bf16_t*)(smem + 34816);
  bf16_t* VT = (bf16_t*)(smem + 53248);
  bf16_t* Am = (bf16_t*)(smem + 71680);
  f32x4* segp = (f32x4*)(smem + 80896);
  float* Ob = (float*)(smem + 89600);
  const int tid = opaque_tid(), lane = tid & 63, wave = tid >> 6;
  const int kp = lane, seg = wave;
  const int c16 = lane & 15, q4 = lane >> 4;
  const int ft = tid >> 3, fv = (tid & 7) * 16;
  HgrnRegs R;
  if ((int)blockIdx.x < 4096) hgrn_chunk_load(R, proj, blockIdx.x, seg, kp);
#pragma unroll 1
  for (int u = blockIdx.x; u < 4096; u += gridDim.x) {
    const int hh = u & 7, c = (u >> 3) & 31, b = u >> 8;
    const size_t tok0 = (size_t)b * SEQ + c * 64;
    float lb0, lb1;
    {
      const f32x2 l0 = *(const f32x2*)(p.lower_bounds + hh * 128 + 2 * kp), l1 = *(const f32x2*)(p.lower_bounds + 1024 + hh * 128 + 2 * kp);
      lb0 = fast_rcp(1.f + fast_exp(l1[0] - l0[0])); lb1 = fast_rcp(1.f + fast_exp(l1[1] - l0[1]));
    }
    const f32x2 lbv = {lb0, lb1}, olb = {1.f - lb0, 1.f - lb1};
    f32x2 Ev[8], Iv[8], Kv[8];
    {
      f32x2 P = {1.f, 1.f}, Q = {1.f, 1.f};
#pragma unroll
      for (int j = 0; j < 8; ++j) {
        const float x0 = __builtin_amdgcn_fmed3f(bf_lo(R.rf[j]), -30.f, 30.f), x1 = __builtin_amdgcn_fmed3f(bf_hi(R.rf[j]), -30.f, 30.f);
        const f32x2 e = {__builtin_amdgcn_exp2f(x0 * -1.4426950408889634f), __builtin_amdgcn_exp2f(x1 * -1.4426950408889634f)};
        const f32x2 a1 = e + 1.f, a2 = lbv * e + 1.f, pr = a1 * a2;
        const f32x2 w = {fast_rcp(pr[0]), fast_rcp(pr[1])};
        const f32x2 r = w * a2;
        Kv[j] = olb * e * r;
        P = P * (a2 * r); Q = Q * (a1 * a1 * w);
        Ev[j] = P; Iv[j] = Q;
      }
      segp[seg * 64 + kp] = (f32x4){P[0], P[1], Q[0], Q[1]};
    }
    __syncthreads();
    {
      f32x2 pre = {1.f, 1.f}, pin = {1.f, 1.f}, tot = {1.f, 1.f};
#pragma unroll
      for (int s2 = 0; s2 < 8; ++s2) {
        const f32x4 v = segp[s2 * 64 + kp];
        const f32x2 vp = {v[0], v[1]}, vq = {v[2], v[3]};
        if (s2 < seg) { pre = pre * vp; pin = pin * vq; }
        tot = tot * vp;
      }
      f32x2 ko[8];
#pragma unroll
      for (int j = 0; j < 8; ++j) {
        const f32x2 Ea = pre * Ev[j], ia = pin * Iv[j];
        const f32x2 qv = {bf_lo(R.rq[j]), bf_hi(R.rq[j])};
        const f32x2 qd2 = qv * Ea, ki = Kv[j] * ia;
        ko[j] = ki * tot;
        const unsigned qd = pk_bf16(qd2[0], qd2[1]);
        *(unsigned*)(QD + (8 * seg + j) * 136 + 2 * kp) = qd;
        if (p.st_a) *(unsigned*)(proj + PB_RQ + (tok0 + 8 * seg + j) * 1024 + hh * 128 + 2 * kp) = qd;
        *(unsigned*)(KI + (8 * seg + j) * 136 + 2 * kp) = pk_bf16(ki[0], ki[1]);
      }
      *(bf16x8*)(KoT + (2 * kp) * 72 + 8 * seg) = pack8(ko[0][0], ko[1][0], ko[2][0], ko[3][0], ko[4][0], ko[5][0], ko[6][0], ko[7][0]);
      *(bf16x8*)(KoT + (2 * kp + 1) * 72 + 8 * seg) = pack8(ko[0][1], ko[1][1], ko[2][1], ko[3][1], ko[4][1], ko[5][1], ko[6][1], ko[7][1]);
      if (seg == 0 && p.st_a) { *(f32x2*)(DL + (size_t)u * 128 + 2 * kp) = tot; }
    }
    if (u + (int)gridDim.x < 4096) hgrn_chunk_load(R, proj, u + gridDim.x, seg, kp);
    __syncthreads();
    {
      const int ti = wave >> 1;
#pragma unroll
      for (int uu = 0; uu < 2; ++uu) {
        const int si = 2 * (wave & 1) + uu;
        f32x4 acc = {0.f, 0.f, 0.f, 0.f};
        if (si <= ti) {
#pragma unroll
          for (int ks = 0; ks < 4; ++ks) {
            const bf16x8 a = *(const bf16x8*)(QD + (16 * ti + c16) * 136 + 32 * ks + 8 * q4);
            const bf16x8 bb = *(const bf16x8*)(KI + (16 * si + c16) * 136 + 32 * ks + 8 * q4);
            acc = MFMA16(a, bb, acc);
          }
        }
#pragma unroll
        for (int j = 0; j < 4; ++j) {
          const int t = 16 * ti + 4 * q4 + j, s = 16 * si + c16;
          const float v = (s <= t) ? acc[j] : 0.f;
          Am[t * 72 + s] = (bf16_t)(pk_bf16(v, 0.f) & 0xffffu);
        }
      }
    }
    __syncthreads();
    {
#pragma unroll
      for (int i = 0; i < 2; ++i) {
        const int idx = tid + 512 * i, k = idx >> 3, t8 = (idx & 7) * 8;
        const u32x4 w = *(const u32x4*)(KoT + k * 72 + t8);
        if (p.st_a) *(u32x4*)(proj + PB_RF + (tok0 + (k >> 1)) * 1024 + hh * 128 + (k & 1) * 64 + t8) = w;
      }
      const int t = tid >> 3, s8 = (tid & 7) * 8;
      const u32x4 w = *(const u32x4*)(Am + t * 72 + s8);
      if (p.st_a) *(u32x4*)(Hb + ((size_t)u * 64 + t) * 64 + s8) = w;
    }
  }
  __syncthreads();
}

struct ScanRegs { u32x4 qd[2]; u32x4 ko[2]; u32x4 am; unsigned rv[8]; };
DI void hgrn_scan_load(ScanRegs& R, const Params& p, int b, int hh, int c, int tid) {
  const bf16_t* proj = (const bf16_t*)(p.ws + WS_PROJ);
  const bf16_t* Hb = (const bf16_t*)(p.ws + WS_H);
  const int lane = tid & 63, wave = tid >> 6;
  const size_t tok0 = (size_t)b * SEQ + c * 64;
  const size_t u = (size_t)(b * 32 + c) * 8 + hh;
#pragma unroll
  for (int i = 0; i < 2; ++i) {
    const int idx = tid + 512 * i;
    R.qd[i] = *(const u32x4*)(proj + PB_RQ + (tok0 + (idx >> 4)) * 1024 + hh * 128 + (idx & 15) * 8);
    const int k = idx >> 3, t8 = (idx & 7) * 8;
    R.ko[i] = *(const u32x4*)(proj + PB_RF + (tok0 + (k >> 1)) * 1024 + hh * 128 + (k & 1) * 64 + t8);
  }
  R.am = *(const u32x4*)(Hb + (u * 64 + (tid >> 3)) * 64 + (tid & 7) * 8);
#pragma unroll
  for (int j = 0; j < 8; ++j) R.rv[j] = *(const unsigned*)(proj + PB_RI + (tok0 + 8 * wave + j) * 1024 + hh * 128 + 2 * lane);
}
DI void hgrn_scan_unit(const Params& p, char* smem, int unit) {
  const int hh = unit & 7, b = unit >> 3;
  bf16_t* proj = (bf16_t*)(p.ws + WS_PROJ);
  bf16_t* QD = (bf16_t*)smem;
  bf16_t* KoT = (bf16_t*)(smem + 17408);
  bf16_t* VT = (bf16_t*)(smem + 35840);
  bf16_t* Am = (bf16_t*)(smem + 54272);
  float* dla = (float*)(smem + 97792);
  float* Ob = (float*)(smem + 64000);
  const int tid = opaque_tid(), lane = tid & 63, wave = tid >> 6;
  const int c16 = lane & 15, q4 = lane >> 4;
  const int ft = tid >> 3, fv = (tid & 7) * 16;
  const int vcol = 16 * wave + c16;
  f32x4 S[8];
#pragma unroll
  for (int i = 0; i < 8; ++i) S[i] = (f32x4){0.f, 0.f, 0.f, 0.f};
  ScanRegs R0, R1;
  hgrn_scan_load(R0, p, b, hh, 0, tid);
  hgrn_scan_load(R1, p, b, hh, 1, tid);
  {
    const float* DL = (const float*)(p.ws + WS_DL);
#pragma unroll
    for (int i = 0; i < 2; ++i) { const int idx = tid + 512 * i, c = idx >> 5, k4 = (idx & 31) * 4; *(f32x4*)(dla + c * 128 + k4) = *(const f32x4*)(DL + ((size_t)(b * 32 + c) * 8 + hh) * 128 + k4); }
  }
  auto body = [&](const int c, ScanRegs& C) __attribute__((always_inline)) {
    const size_t tok0 = (size_t)b * SEQ + c * 64;
#pragma unroll
    for (int i = 0; i < 2; ++i) {
      const int idx = tid + 512 * i;
      *(u32x4*)(QD + (idx >> 4) * 136 + (idx & 15) * 8) = C.qd[i];
      *(u32x4*)(KoT + (idx >> 3) * 72 + (idx & 7) * 8) = C.ko[i];
    }
    *(u32x4*)(Am + (tid >> 3) * 72 + (tid & 7) * 8) = C.am;
    {
      u32x4 wl, wh;
#pragma unroll
      for (int i = 0; i < 4; ++i) { wl[i] = (C.rv[2 * i] & 0xffffu) | (C.rv[2 * i + 1] << 16); wh[i] = (C.rv[2 * i] >> 16) | (C.rv[2 * i + 1] & 0xffff0000u); }
      *(u32x4*)(VT + (2 * lane) * 72 + 8 * wave) = wl;
      *(u32x4*)(VT + (2 * lane + 1) * 72 + 8 * wave) = wh;
    }
    if (c + 2 < 32) hgrn_scan_load(C, p, b, hh, c + 2, tid);
    const float* dl = dla + c * 128;
    u32x4 rg[2];
    __syncthreads();
    {
      bf16x8 bv[2];
#pragma unroll
      for (int ks = 0; ks < 2; ++ks) bv[ks] = *(const bf16x8*)(VT + vcol * 72 + 32 * ks + 8 * q4);
#pragma unroll
      for (int th = 0; th < 2; ++th) {
        f32x4 o[2];
#pragma unroll
        for (int i = 0; i < 2; ++i) o[i] = (f32x4){0.f, 0.f, 0.f, 0.f};
#pragma unroll
        for (int kq = 0; kq < 4; ++kq) {
          const bf16x8 sf = pack8(S[2 * kq][0], S[2 * kq][1], S[2 * kq][2], S[2 * kq][3], S[2 * kq + 1][0], S[2 * kq + 1][1], S[2 * kq + 1][2], S[2 * kq + 1][3]);
#pragma unroll
          for (int t2 = 0; t2 < 2; ++t2) {
            const int ti = 2 * th + t2;
            const bf16_t* ap = QD + (16 * ti + c16) * 136 + 32 * kq + 4 * q4;
            const u32x2 lo = *(const u32x2*)ap, hi = *(const u32x2*)(ap + 16);
            const u32x4 av = {lo[0], lo[1], hi[0], hi[1]};
            o[t2] = MFMA16(__builtin_bit_cast(bf16x8, av), sf, o[t2]);
          }
        }
#pragma unroll
        for (int t2 = 0; t2 < 2; ++t2)
#pragma unroll
          for (int ks = 0; ks < 2; ++ks) {
            const bf16x8 a = *(const bf16x8*)(Am + (16 * (2 * th + t2) + c16) * 72 + 32 * ks + 8 * q4);
            o[t2] = MFMA16(a, bv[ks], o[t2]);
          }
#pragma unroll
        for (int t2 = 0; t2 < 2; ++t2)
#pragma unroll
          for (int j = 0; j < 4; ++j) Ob[(16 * (2 * th + t2) + 4 * q4 + j) * 132 + vcol] = o[t2][j];
        __builtin_amdgcn_sched_barrier(0);
      }
      {
        const bf16_t* gq = proj + PB_RG + (tok0 + ft) * 1024 + hh * 128 + fv;
        rg[0] = *(const u32x4*)gq; rg[1] = *(const u32x4*)(gq + 8);
      }
#pragma unroll
      for (int kt = 0; kt < 8; ++kt) {
        const f32x4 d = *(const f32x4*)(dl + 16 * kt + 4 * q4);
        S[kt] = S[kt] * d;
#pragma unroll
        for (int ks = 0; ks < 2; ++ks) {
          const bf16x8 a = *(const bf16x8*)(KoT + (16 * kt + c16) * 72 + 32 * ks + 8 * q4);
          S[kt] = MFMA16(a, bv[ks], S[kt]);
        }
        if (kt & 1) __builtin_amdgcn_sched_barrier(0);
      }
    }
    __syncthreads();
    {
      f32x4 ov[4]; float ss = 0.f;
#pragma unroll
      for (int i = 0; i < 4; ++i) { ov[i] = *(const f32x4*)(Ob + ft * 132 + fv + 4 * i); ss += ov[i][0] * ov[i][0] + ov[i][1] * ov[i][1] + ov[i][2] * ov[i][2] + ov[i][3] * ov[i][3]; }
      ss += __shfl_xor(ss, 1); ss += __shfl_xor(ss, 2); ss += __shfl_xor(ss, 4);
      const float rstd = rsqrtf(ss * (1.0f / 128.0f) + EPS);
      float y[16];
#pragma unroll
      for (int i = 0; i < 4; ++i) {
        const f32x4 w = *(const f32x4*)(p.rec_norm_w + fv + 4 * i);
        const unsigned ga = (i < 2) ? rg[0][2 * i] : rg[1][2 * (i - 2)], gb = (i < 2) ? rg[0][2 * i + 1] : rg[1][2 * (i - 2) + 1];
        y[4 * i + 0] = ov[i][0] * rstd * w[0] * bf_lo(ga);
        y[4 * i + 1] = ov[i][1] * rstd * w[1] * bf_hi(ga);
        y[4 * i + 2] = ov[i][2] * rstd * w[2] * bf_lo(gb);
        y[4 * i + 3] = ov[i][3] * rstd * w[3] * bf_hi(gb);
      }
      bf16_t* gp = proj + PB_RG + (tok0 + ft) * 1024 + hh * 128 + fv;
      if (p.st_m) {
      *(bf16x8*)gp = pack8(y[0], y[1], y[2], y[3], y[4], y[5], y[6], y[7]);
      *(bf16x8*)(gp + 8) = pack8(y[8], y[9], y[10], y[11], y[12], y[13], y[14], y[15]);
      }
    }
  };
#pragma unroll 1
  for (int c = 0; c < 32; c += 2) { body(c, R0); body(c + 1, R1); }
  __syncthreads();
}

DI void phase_mix(const Params& p, char* smem) {
  int* s_item = (int*)(smem + 131072);
  unsigned* ctr = (unsigned*)(p.ws + WS_CTRL) + CW_WORK;
  while (true) {
    if (threadIdx.x == 0) *s_item = (int)atomicAdd(ctr, 1u);
    __syncthreads();
    const int item = *s_item;
    __syncthreads();
    if (item >= 128 + 1024) break;
    if (item < 128) hgrn_scan_unit(p, smem, item); else attn_unit(p, smem, item - 128);
  }
}

DI void phase_gemm1(const Params& p, char* smem) {
  EpiProj e{(bf16_t*)(p.ws + WS_PROJ)};
  gemm_phase<D_MODEL, (1 << 30), 0, NTOK, IN_W, D_MODEL>((LAS unsigned char*)smem, (const bf16_t*)(p.ws + WS_H), (const bf16_t*)(p.ws + WS_WTIN), e);
}
DI void phase_gemm2(const Params& p, char* smem) {
  EpiOut e{p.out, p.x, (const float*)(p.ws + WS_MOD)};
  gemm_phase<1024, 16, (int)(PB_RG - PB_AG) - 1024, NTOK, D_MODEL, D_MIX>((LAS unsigned char*)smem, (const bf16_t*)(p.ws + WS_PROJ) + PB_AG, (const bf16_t*)(p.ws + WS_WTOUT), e);
}

extern __shared__ __attribute__((aligned(16))) char dyn_smem[];

#if ONE_LAUNCH
__global__ void __launch_bounds__(NTHREADS, 2) hymba_fwd(Params p) {
  cg::grid_group grid = cg::this_grid();
  volatile LAS unsigned* st = (volatile LAS unsigned*)((LAS unsigned char*)dyn_smem + 131072 + 16);
  if (threadIdx.x == 0) { st[0] = 0u; st[1] = 0u; }
  __syncthreads();
  const XcdBarrier xb = xcd_barrier_post((unsigned*)(p.ws + WS_XBAR), st);
  phase_prep(p, dyn_smem);
  phase_norm(p, dyn_smem);
  if (p.ws == nullptr) grid.sync();
  xcd_barrier(xb);
  phase_gemm1(p, dyn_smem);
  xcd_barrier(xb);
  phase_hgrn_chunk(p, dyn_smem);
  xcd_barrier(xb);
  phase_mix(p, dyn_smem);
  xcd_barrier(xb);
  phase_gemm2(p, dyn_smem);
}
#else
__global__ void __launch_bounds__(NTHREADS, 2) k_prep(Params p) { phase_prep(p, dyn_smem); }
__global__ void __launch_bounds__(NTHREADS, 2) k_norm(Params p) { phase_norm(p, dyn_smem); }
__global__ void __launch_bounds__(NTHREADS, 2) k_gemm1(Params p) { phase_gemm1(p, dyn_smem); }
__global__ void __launch_bounds__(NTHREADS, 2) k_hgrna(Params p) { phase_hgrn_chunk(p, dyn_smem); }
__global__ void __launch_bounds__(NTHREADS, 2) k_mix(Params p) { phase_mix(p, dyn_smem); }
__global__ void __launch_bounds__(NTHREADS, 2) k_gemm2(Params p) { phase_gemm2(p, dyn_smem); }
#endif

extern "C" void kernel_launch(void* const* d_in, const int* in_sizes, int n_in, void* d_out, int out_size, void* d_ws, size_t ws_size, hipStream_t stream) {
  static int grid = 0;
  if (grid == 0) {
    if (n_in != 13 || ws_size < WS_END) { fprintf(stderr, "kernel_launch: unexpected n_in %d or workspace %zu < %zu\n", n_in, ws_size, (size_t)WS_END); grid = -1; return; }
    int dev = 0, cus = 0, per_cu = 0;
    hipGetDevice(&dev);
    hipDeviceGetAttribute(&cus, hipDeviceAttributeMultiprocessorCount, dev);
#if ONE_LAUNCH
    if (hipFuncSetAttribute((const void*)hymba_fwd, hipFuncAttributeMaxDynamicSharedMemorySize, LDS_BYTES) != hipSuccess) { fprintf(stderr, "hipFuncSetAttribute failed\n"); grid = -1; return; }
    hipOccupancyMaxActiveBlocksPerMultiprocessor(&per_cu, (const void*)hymba_fwd, NTHREADS, LDS_BYTES);
    if (per_cu < 1) { fprintf(stderr, "occupancy query says %d blocks per CU\n", per_cu); per_cu = 1; }
    grid = cus * per_cu;
#else
    hipFuncSetAttribute((const void*)k_prep, hipFuncAttributeMaxDynamicSharedMemorySize, LDS_BYTES);
    hipFuncSetAttribute((const void*)k_gemm1, hipFuncAttributeMaxDynamicSharedMemorySize, LDS_BYTES);
    hipFuncSetAttribute((const void*)k_mix, hipFuncAttributeMaxDynamicSharedMemorySize, LDS_BYTES);
    hipFuncSetAttribute((const void*)k_hgrna, hipFuncAttributeMaxDynamicSharedMemorySize, LDS_BYTES);
    hipFuncSetAttribute((const void*)k_gemm2, hipFuncAttributeMaxDynamicSharedMemorySize, LDS_BYTES);
    (void)per_cu;
    grid = cus;
#endif
    (void)hipGetLastError();
  }
  if (grid < 0) return;
  (void)hipMemsetAsync((char*)d_ws + WS_CTRL, 0, 16384, stream);
  Params p{};
  p.x = (const float*)d_in[0]; p.c = (const float*)d_in[1]; p.pos = (const int*)d_in[2]; p.norm_w = (const float*)d_in[3];
  p.w_ada = (const float*)d_in[4]; p.b_ada = (const float*)d_in[5]; p.w_in = (const float*)d_in[6]; p.q_norm_w = (const float*)d_in[7];
  p.k_norm_w = (const float*)d_in[8]; p.sinks = (const float*)d_in[9]; p.rec_norm_w = (const float*)d_in[10];
  p.lower_bounds = (const float*)d_in[11]; p.w_out = (const float*)d_in[12]; p.out = (float*)d_out; p.ws = (char*)d_ws; p.st_a = 1; p.st_m = 1;
#if ONE_LAUNCH
  void* args[] = {&p};
  hipError_t e = hipLaunchCooperativeKernel((const void*)hymba_fwd, dim3(grid), dim3(NTHREADS), args, LDS_BYTES, stream);
  if (e != hipSuccess) fprintf(stderr, "cooperative launch failed: %s (grid %d)\n", hipGetErrorString(e), grid);
#else
  for (int r = 0; r < REP_PREP; ++r) hipLaunchKernelGGL(k_prep, dim3(grid), dim3(NTHREADS), LDS_BYTES, stream, p);
  for (int r = 0; r < REP_NORM; ++r) hipLaunchKernelGGL(k_norm, dim3(grid), dim3(NTHREADS), 16384, stream, p);
  for (int r = 0; r < REP_G1; ++r) hipLaunchKernelGGL(k_gemm1, dim3(grid), dim3(NTHREADS), LDS_BYTES, stream, p);
  for (int r = 0; r < REP_A; ++r) { p.st_a = (r == REP_A - 1); hipLaunchKernelGGL(k_hgrna, dim3(grid), dim3(NTHREADS), LDS_BYTES, stream, p); }
  for (int r = 0; r < REP_M; ++r) { p.st_m = (r == REP_M - 1); (void)hipMemsetAsync((char*)d_ws + WS_CTRL, 0, 16384, stream); hipLaunchKernelGGL(k_mix, dim3(grid), dim3(NTHREADS), LDS_BYTES, stream, p); }
  for (int r = 0; r < REP_G2; ++r) hipLaunchKernelGGL(k_gemm2, dim3(grid), dim3(NTHREADS), LDS_BYTES, stream, p);
#endif
}
```

```cpp
#include <hip/hip_runtime.h>
#include <hip/hip_cooperative_groups.h>
#include <cstdio>
#include <cstdint>
namespace cg = cooperative_groups;

#ifndef ONE_LAUNCH
#define ONE_LAUNCH 1
#endif

#define REP_PREP 1
#define REP_NORM 1
#define REP_G1 1
#define REP_G2 1
#define REP_A 1
#define REP_M 1
#define DI __device__ __forceinline__
typedef unsigned short bf16_t;
typedef short bf16x8 __attribute__((ext_vector_type(8)));
typedef float f32x4 __attribute__((ext_vector_type(4)));
typedef float f32x2 __attribute__((ext_vector_type(2)));
typedef float f32x16 __attribute__((ext_vector_type(16)));
typedef unsigned u32x4 __attribute__((ext_vector_type(4)));
typedef unsigned u32x2 __attribute__((ext_vector_type(2)));
typedef __bf16 bf16x2_t __attribute__((ext_vector_type(2)));

constexpr int D_MODEL = 1024, BATCH = 16, SEQ = 2048, NTOK = BATCH * SEQ, IN_W = 6656, D_MIX = 2048;
constexpr int OFF_AQ = 0, OFF_AK = 1024, OFF_AV = 1280, OFF_AG = 1536, OFF_RQ = 2560, OFF_RF = 3584, OFF_RI = 4608, OFF_RG = 5632;
constexpr size_t PB_AQ = 0, PB_AK = PB_AQ + (size_t)NTOK * 1024, PB_AV = PB_AK + (size_t)NTOK * 256, PB_AG = PB_AV + (size_t)NTOK * 256,
                 PB_RQ = PB_AG + (size_t)NTOK * 1024, PB_RF = PB_RQ + (size_t)NTOK * 1024, PB_RI = PB_RF + (size_t)NTOK * 1024, PB_RG = PB_RI + (size_t)NTOK * 1024;
constexpr float EPS = 1e-6f;
constexpr int NTHREADS = 512;
constexpr int LDS_BYTES = 131072 + 256;

constexpr size_t MiB = 1024 * 1024;
constexpr size_t WS_CTRL = 0, WS_XBAR = 2048, WS_MOD = 16384, WS_ROPE = 1 * MiB, WS_WTIN = 9 * MiB, WS_WTOUT = 22 * MiB, WS_H = 26 * MiB, WS_PROJ = 90 * MiB, WS_DL = 506 * MiB,
                 WS_END = WS_DL + 2 * MiB;

struct Params {
  const float* x; const float* c; const int* pos; const float* norm_w; const float* w_ada; const float* b_ada;
  const float* w_in; const float* q_norm_w; const float* k_norm_w; const float* sinks; const float* rec_norm_w;
  const float* lower_bounds; const float* w_out; float* out; char* ws; int st_a; int st_m;
};

DI int opaque_tid() { int t = threadIdx.x; asm volatile("" : "+v"(t)); return t; }
DI unsigned pk_bf16(float lo, float hi) { f32x2 v = {lo, hi}; bf16x2_t b = __builtin_convertvector(v, bf16x2_t); return __builtin_bit_cast(unsigned, b); }
DI float bf_lo(unsigned u) { return __uint_as_float(u << 16); }
DI float bf_hi(unsigned u) { return __uint_as_float(u & 0xffff0000u); }
DI bf16x8 pack8(float a0, float a1, float a2, float a3, float a4, float a5, float a6, float a7) {
  u32x4 w = {pk_bf16(a0, a1), pk_bf16(a2, a3), pk_bf16(a4, a5), pk_bf16(a6, a7)}; return __builtin_bit_cast(bf16x8, w);
}
DI float fast_exp(float x) { return __builtin_amdgcn_exp2f(x * 1.4426950408889634f); }
DI float fast_rcp(float x) { return __builtin_amdgcn_rcpf(x); }
DI float silu(float x) { return x * fast_rcp(1.f + fast_exp(-x)); }
#define MFMA16(a, b, c) __builtin_amdgcn_mfma_f32_16x16x32_bf16((a), (b), (c), 0, 0, 0)
#define MFMA32(a, b, c) __builtin_amdgcn_mfma_f32_32x32x16_bf16((a), (b), (c), 0, 0, 0)

constexpr int CW_WORK = 0, CW_BAR1 = 64, CW_BAR2 = 128, CW_MOD = 192, CW_NORM = 320, CW_TR = 384;
#define XB_TMO      128
#define XB_XCNT(j)  (256  + 64 * (j))
#define XB_XSUB(j)  (1280 + 64 * (j))
#define XB_XGEN(j)  (2304 + 64 * (j))
#define XB_TOP      3328
#define XB_TOPGEN   3392
#define XCD_BAR_WORDS 3456
#define XB_SPIN_CAP (1u << 22)
#define LAS __attribute__((address_space(3)))
DI unsigned xb_ld(unsigned* p) { return __hip_atomic_load(p, __ATOMIC_RELAXED, __HIP_MEMORY_SCOPE_AGENT); }
DI unsigned xb_add(unsigned* p, unsigned v) { return __hip_atomic_fetch_add(p, v, __ATOMIC_RELAXED, __HIP_MEMORY_SCOPE_AGENT); }
DI unsigned xb_xcc_id() { return (unsigned)__builtin_amdgcn_s_getreg((3 << 11) | 20) & 0xFu; }
#define XB_SPIN(cond, bar) do { unsigned _sp = 0; while (cond) { __builtin_amdgcn_s_sleep(1); \
    if ((++_sp & 255u) == 0u) { if (xb_ld(&(bar)[XB_TMO])) break; if (_sp > XB_SPIN_CAP) { atomicAdd(&(bar)[XB_TMO], 1u); break; } } } } while (0)
struct XcdBarrier { unsigned* bar; unsigned x; volatile LAS unsigned* st; };
DI XcdBarrier xcd_barrier_post(unsigned* bar, volatile LAS unsigned* st) {
  XcdBarrier b; b.bar = bar; b.x = xb_xcc_id(); b.st = st;
  if (threadIdx.x == 0) (void)xb_add(&bar[XB_XCNT(b.x)], 1u);
  return b;
}
DI void xcd_barrier_complete(unsigned* bar, unsigned x, unsigned& nloc, unsigned& nx) {
  const unsigned G = gridDim.x;
  unsigned sum, cnt, mine, sp = 0u;
  for (;;) {
    sum = 0u; cnt = 0u; mine = 0u;
#pragma unroll
    for (unsigned j = 0; j < 16; ++j) { const unsigned c = xb_ld(&bar[XB_XCNT(j)]); sum += c; cnt += (c > 0u) ? 1u : 0u; mine = (j == x) ? c : mine; }
    if (sum == G) break;
    __builtin_amdgcn_s_sleep(1);
    if ((++sp & 255u) == 0u) { if (xb_ld(&bar[XB_TMO])) break; if (sp > XB_SPIN_CAP) { atomicAdd(&bar[XB_TMO], 1u); break; } }
  }
  nloc = mine > 0u ? mine : 1u; nx = cnt > 0u ? cnt : 1u;
}
DI void xcd_barrier(const XcdBarrier& b) {
  asm volatile("s_waitcnt vmcnt(0)" ::: "memory");
  __syncthreads();
  if (threadIdx.x == 0) {
    unsigned* bar = b.bar;
    __builtin_amdgcn_s_waitcnt(0);
    unsigned nloc = b.st[0], nx = b.st[1];
    if (nloc == 0u) { xcd_barrier_complete(bar, b.x, nloc, nx); b.st[0] = nloc; b.st[1] = nx; }
    const unsigned old = xb_add(&bar[XB_XSUB(b.x)], 1u);
    const unsigned gen = old / nloc;
    if (old + 1u == (gen + 1u) * nloc) {
      __builtin_amdgcn_fence(__ATOMIC_RELEASE, "agent");
      asm volatile("s_waitcnt vmcnt(0)" ::: "memory");
      const unsigned og = xb_add(&bar[XB_TOP], 1u);
      const unsigned tg = og / nx;
      if (og + 1u == (tg + 1u) * nx) xb_add(&bar[XB_TOPGEN], 1u);
      else XB_SPIN(xb_ld(&bar[XB_TOPGEN]) == tg, bar);
      __builtin_amdgcn_fence(__ATOMIC_ACQUIRE, "agent");
      xb_add(&bar[XB_XGEN(b.x)], 1u);
      asm volatile("s_waitcnt vmcnt(0)" ::: "memory");
    } else {
      XB_SPIN(xb_ld(&bar[XB_XGEN(b.x)]) == gen, bar);
      __builtin_amdgcn_fence(__ATOMIC_ACQUIRE, "agent");
      asm volatile("s_waitcnt vmcnt(0)" ::: "memory");
    }
  }
  __syncthreads();
}

DI void transpose_tile4(const float* __restrict__ W, int ldw, bf16_t* __restrict__ Wt, int ldt, int k0, int n0, float* tile, int tid) {
  f32x4 v[8];
#pragma unroll
  for (int pass = 0; pass < 8; ++pass) {
    const int r = (tid >> 4) + 32 * pass, c4 = (tid & 15) * 4;
    v[pass] = *(const f32x4*)(W + (size_t)(k0 + r) * ldw + n0 + c4);
  }
#pragma unroll
  for (int pass = 0; pass < 8; ++pass) {
    const int r = (tid >> 4) + 32 * pass, c4 = (tid & 15) * 4;
    tile[r * 65 + c4 + 0] = v[pass][0]; tile[r * 65 + c4 + 1] = v[pass][1]; tile[r * 65 + c4 + 2] = v[pass][2]; tile[r * 65 + c4 + 3] = v[pass][3];
  }
  __syncthreads();
#pragma unroll
  for (int pass = 0; pass < 4; ++pass) {
    const int idx = tid + 512 * pass, nl = idx >> 5, kseg = (idx & 31) * 8;
    float x[8];
#pragma unroll
    for (int j = 0; j < 8; ++j) x[j] = tile[(kseg + j) * 65 + nl];
    const int c = nl & 31, rho = 16 * ((c >> 2) & 1) + 4 * (c >> 3) + (c & 3), nrow = n0 + (nl & 32) + rho;
    u32x4 w = {pk_bf16(x[0], x[1]), pk_bf16(x[2], x[3]), pk_bf16(x[4], x[5]), pk_bf16(x[6], x[7])};
    *(u32x4*)(Wt + (size_t)nrow * ldt + k0 + kseg) = w;
  }
  __syncthreads();
}

DI void phase_prep(const Params& p, char* smem) {
  const int tid = opaque_tid();
  float* rope = (float*)(p.ws + WS_ROPE);
  for (int i = blockIdx.x * NTHREADS + tid; i < NTOK * 32; i += gridDim.x * NTHREADS) {
    const int tok = i >> 5, f = i & 31;
    const float inv = exp2f(-(float)f * (13.287712379549449f / 32.0f));
    const float ang = (float)p.pos[tok] * inv;
    double t = (double)ang * 0.15915494309189535; t -= rint(t);
    const float r = (float)t;
    rope[(size_t)tok * 64 + f] = __builtin_amdgcn_cosf(r);
    rope[(size_t)tok * 64 + 32 + f] = __builtin_amdgcn_sinf(r);
  }
  float* mod = (float*)(p.ws + WS_MOD);
  bf16_t* wtin = (bf16_t*)(p.ws + WS_WTIN);
  bf16_t* wtout = (bf16_t*)(p.ws + WS_WTOUT);
  constexpr int J_MOD = 192, J_WIN = 4 * 104, J_WOUT = 8 * 16;
  for (int job = blockIdx.x; job < J_MOD; job += gridDim.x) {
      float* cact = (float*)smem;
      float* red = (float*)(smem + 65536);
      for (int i = tid; i < 16 * 256; i += NTHREADS) { const int b = i >> 8, k = (job / 48) * 256 + (i & 255); const float v = p.c[b * 1024 + k]; cact[b * 1024 + k] = silu(v); }
      __syncthreads();
      const int n = tid & 63, ks = tid >> 6, n0 = (job % 48) * 64, ksp = job / 48;
      float acc[16];
#pragma unroll
      for (int b = 0; b < 16; ++b) acc[b] = 0.f;
#pragma unroll 1
      for (int k = ksp * 256 + ks * 32; k < ksp * 256 + ks * 32 + 32; k += 16) {
        float w[16];
#pragma unroll
        for (int u = 0; u < 16; ++u) w[u] = p.w_ada[(size_t)(k + u) * 3072 + n0 + n];
#pragma unroll
        for (int u = 0; u < 16; ++u)
#pragma unroll
          for (int b = 0; b < 16; ++b) acc[b] += cact[b * 1024 + k + u] * w[u];
      }
#pragma unroll
      for (int b = 0; b < 16; ++b) red[(ks * 16 + b) * 64 + n] = acc[b];
      __syncthreads();
      for (int o = tid; o < 1024; o += NTHREADS) {
        const int b = o >> 6, nn = o & 63; float sacc = (ksp == 0) ? p.b_ada[n0 + nn] : 0.f;
#pragma unroll
        for (int k2 = 0; k2 < 8; ++k2) sacc += red[(k2 * 16 + b) * 64 + nn];
        mod[(ksp * 16 + b) * 3072 + n0 + nn] = sacc;
      }
      asm volatile("s_waitcnt vmcnt(0)" ::: "memory");
      __syncthreads();
      if (tid == 0) __hip_atomic_fetch_add((unsigned*)(p.ws + WS_CTRL) + CW_MOD, 1u, __ATOMIC_RELEASE, __HIP_MEMORY_SCOPE_AGENT);
  }
}
DI void prep_transpose_job(const Params& p, char* smem, int j, int tid) {
  constexpr int J_WIN = 4 * 104;
  bf16_t* wtin = (bf16_t*)(p.ws + WS_WTIN);
  bf16_t* wtout = (bf16_t*)(p.ws + WS_WTOUT);
  if (j < J_WIN) { const int kt = j & 3, nt = j >> 2; transpose_tile4(p.w_in, IN_W, wtin, D_MODEL, kt * 256, nt * 64, (float*)smem, tid); }
  else { const int j2 = j - J_WIN, kt = j2 & 7, nt = j2 >> 3; transpose_tile4(p.w_out, D_MODEL, wtout, D_MIX, kt * 256, nt * 64, (float*)smem, tid); }
}

DI void phase_norm(const Params& p, char* smem) {
  const int tid = opaque_tid(), lane = tid & 63, wave = tid >> 6;
  const float* mod = (const float*)(p.ws + WS_MOD);
  bf16_t* H = (bf16_t*)(p.ws + WS_H);
  float* sc1 = (float*)(smem + 69632);
  float* shv = (float*)(smem + 69632 + 4096);
  int* s_item = (int*)(smem + 131072);
  unsigned* nctr = (unsigned*)(p.ws + WS_CTRL) + CW_NORM;
  unsigned* tctr = (unsigned*)(p.ws + WS_CTRL) + CW_TR;
  int bprev = -1;
  bool tr_left = true, nm_left = true, mod_ok = false;
  for (int step = 0; tr_left || nm_left; ++step) {
    const bool do_tr = tr_left && ((step % 3) == 0 || !nm_left);
    if (tid == 0) *s_item = do_tr ? (int)atomicAdd(tctr, 1u) : (int)atomicAdd(nctr, 1u);
    __syncthreads();
    const int g = *s_item;
    __syncthreads();
    if (do_tr) {
      if (g >= 4 * 104 + 8 * 16) tr_left = false; else prep_transpose_job(p, smem, g, tid);
      continue;
    }
    if (g >= NTOK / 64) { nm_left = false; continue; }
    if (!mod_ok) {
      if (tid == 0) { const unsigned* mc = (const unsigned*)(p.ws + WS_CTRL) + CW_MOD; while (__hip_atomic_load(mc, __ATOMIC_ACQUIRE, __HIP_MEMORY_SCOPE_AGENT) < 192u) __builtin_amdgcn_s_sleep(1); }
      __syncthreads();
      mod_ok = true;
    }
    const int b = g >> 5;
    if (b != bprev) {
      for (int col = tid; col < 1024; col += NTHREADS) {
        float sh = 0.f, sc = 0.f;
#pragma unroll
        for (int k2 = 0; k2 < 4; ++k2) { sh += mod[(k2 * 16 + b) * 3072 + col]; sc += mod[(k2 * 16 + b) * 3072 + 1024 + col]; }
        sc1[col] = p.norm_w[col] * (1.f + sc); shv[col] = sh;
      }
      bprev = b;
      __syncthreads();
    }
#pragma unroll 1
    for (int it = 0; it < 4; ++it) {
      const int row0 = g * 64 + wave * 8 + it * 2;
      f32x4 v[2][4]; float ss[2] = {0.f, 0.f};
#pragma unroll
      for (int rr = 0; rr < 2; ++rr) {
        const f32x4* xr = (const f32x4*)(p.x + (size_t)(row0 + rr) * D_MODEL);
#pragma unroll
        for (int i = 0; i < 4; ++i) v[rr][i] = __builtin_nontemporal_load(xr + lane + 64 * i);
      }
#pragma unroll
      for (int rr = 0; rr < 2; ++rr) {
#pragma unroll
        for (int i = 0; i < 4; ++i) ss[rr] += v[rr][i][0] * v[rr][i][0] + v[rr][i][1] * v[rr][i][1] + v[rr][i][2] * v[rr][i][2] + v[rr][i][3] * v[rr][i][3];
#pragma unroll
        for (int o = 32; o >= 1; o >>= 1) ss[rr] += __shfl_xor(ss[rr], o);
        ss[rr] = rsqrtf(ss[rr] * (1.0f / D_MODEL) + EPS);
      }
#pragma unroll
      for (int i = 0; i < 4; ++i) {
        const int col = (lane + 64 * i) * 4;
        const f32x4 a = *(const f32x4*)(sc1 + col), sh = *(const f32x4*)(shv + col);
#pragma unroll
        for (int rr = 0; rr < 2; ++rr) {
          float h[4];
#pragma unroll
          for (int j = 0; j < 4; ++j) h[j] = v[rr][i][j] * ss[rr] * a[j] + sh[j];
          u32x2 w = {pk_bf16(h[0], h[1]), pk_bf16(h[2], h[3])};
          *(u32x2*)(H + (size_t)(row0 + rr) * D_MODEL + col) = w;
        }
      }
    }
  }
}

constexpr int BM = 256, BK = 64, HALF = 128, NXCD = 8, WGM = 8, HT = HALF * BK;
DI int lds_byte(int r, int c) { const int st = (r >> 4) * 2 + (c >> 5), rr = r & 15, cc = c & 31, ob = rr * 64 + cc * 2; return st * 1024 + (ob ^ (((ob >> 9) & 1) << 5)); }
DI void stage_rc(int b, int& R, int& C) { const int st = b / 1024, sb = b % 1024, swz = sb ^ (((sb >> 9) & 1) << 5); R = (st >> 1) * 16 + swz / 64; C = (st & 1) * 32 + (swz % 64) / 2; }

struct EpiProj {
  bf16_t* O;
  DI void operator()(const f32x4 (&acc)[2][2][4][2], int brow, int bcol, int wr, int wc, int fr, int fq) const {
    const bool gate_tile = (bcol >= OFF_AG && bcol < OFF_AG + 1024) || (bcol >= OFF_RG);
    size_t sbase; int sld, scol;
    if (bcol < OFF_AK) { sbase = PB_AQ; sld = 1024; scol = bcol - OFF_AQ; }
    else if (bcol < OFF_AV) { sbase = PB_AK; sld = 256; scol = bcol - OFF_AK; }
    else if (bcol < OFF_AG) { sbase = PB_AV; sld = 256; scol = bcol - OFF_AV; }
    else if (bcol < OFF_RQ) { sbase = PB_AG; sld = 1024; scol = bcol - OFF_AG; }
    else if (bcol < OFF_RF) { sbase = PB_RQ; sld = 1024; scol = bcol - OFF_RQ; }
    else if (bcol < OFF_RI) { sbase = PB_RF; sld = 1024; scol = bcol - OFF_RF; }
    else if (bcol < OFF_RG) { sbase = PB_RI; sld = 1024; scol = bcol - OFF_RI; }
    else { sbase = PB_RG; sld = 1024; scol = bcol - OFF_RG; }
#pragma unroll
    for (int ai = 0; ai < 2; ++ai)
#pragma unroll
      for (int m = 0; m < 4; ++m) {
        const int row = brow + ai * HALF + wr * 64 + m * 16 + fr;
        bf16_t* rp = O + sbase + (size_t)row * sld + scol + wc * 32 + 8 * fq;
#pragma unroll
        for (int bj = 0; bj < 2; ++bj) {
          f32x4 a0 = acc[ai][bj][m][0], a1 = acc[ai][bj][m][1];
          if (gate_tile) {
#pragma unroll
            for (int j = 0; j < 4; ++j) { a0[j] = silu(a0[j]); a1[j] = silu(a1[j]); }
          }
          u32x4 w = {pk_bf16(a0[0], a0[1]), pk_bf16(a0[2], a0[3]), pk_bf16(a1[0], a1[1]), pk_bf16(a1[2], a1[3])};
          __builtin_nontemporal_store(w, (u32x4*)(rp + bj * HALF));
        }
      }
  }
};
struct EpiOut {
  float* O; const float* X; const float* mod;
  DI void operator()(const f32x4 (&acc)[2][2][4][2], int brow, int bcol, int wr, int wc, int fr, int fq) const {
    const int b = brow >> 11;
    f32x4 g[2][2];
    {
      f32x4 gp[2][4][2];
#pragma unroll
      for (int bj = 0; bj < 2; ++bj)
#pragma unroll
        for (int k2 = 0; k2 < 4; ++k2) {
          const float* gq = mod + (k2 * 16 + b) * 3072 + 2048 + bcol + bj * HALF + wc * 32 + 8 * fq;
          gp[bj][k2][0] = *(const f32x4*)gq; gp[bj][k2][1] = *(const f32x4*)(gq + 4);
        }
#pragma unroll
      for (int bj = 0; bj < 2; ++bj) { g[bj][0] = (gp[bj][0][0] + gp[bj][1][0]) + (gp[bj][2][0] + gp[bj][3][0]); g[bj][1] = (gp[bj][0][1] + gp[bj][1][1]) + (gp[bj][2][1] + gp[bj][3][1]); }
    }
    f32x4 xb[2][4][2];
    auto ldb = [&](int q, f32x4 (&x)[4][2]) __attribute__((always_inline)) {
      const int bj = q >> 1, ai = q & 1, col = bcol + bj * HALF + wc * 32 + 8 * fq;
#pragma unroll
      for (int m = 0; m < 4; ++m) {
        const size_t o = (size_t)(brow + ai * HALF + wr * 64 + m * 16 + fr) * D_MODEL + col;
        x[m][0] = *(const f32x4*)(X + o); x[m][1] = *(const f32x4*)(X + o + 4);
      }
    };
    ldb(0, xb[0]);
#pragma unroll
    for (int q = 0; q < 4; ++q) {
      if (q + 1 < 4) ldb(q + 1, xb[(q + 1) & 1]);
      const int bj = q >> 1, ai = q & 1, col = bcol + bj * HALF + wc * 32 + 8 * fq;
#pragma unroll
      for (int m = 0; m < 4; ++m) {
        const size_t o = (size_t)(brow + ai * HALF + wr * 64 + m * 16 + fr) * D_MODEL + col;
        *(f32x4*)(O + o) = xb[q & 1][m][0] + g[bj][0] * acc[ai][bj][m][0];
        *(f32x4*)(O + o + 4) = xb[q & 1][m][1] + g[bj][1] * acc[ai][bj][m][1];
      }
    }
  }
};

template <int lda, int split_kt, int gap, int M, int N, int K, class Epi>
DI void gemm_phase(LAS unsigned char* lds, const bf16_t* __restrict__ A, const bf16_t* __restrict__ Bt, const Epi& epi) {
#define SA(b, h) (((b) * 2 + (h)) * (HT * 2))
#define SB(b, h) ((4 + (b) * 2 + (h)) * (HT * 2))
#define STAGE_A(P, br, kt) do { const char* _g = (const char*)(A + (size_t)(br) * lda + (kt) * BK + ((kt) >= split_kt ? gap : 0)); \
    _Pragma("unroll") for (int _i = 0; _i < 2; ++_i) { \
      __builtin_amdgcn_global_load_lds((const unsigned*)(_g + aoff[_i]), (LAS unsigned*)(lds + (P) + ldsw + _i * 8192), 16, 0, 0); } } while (0)
#define STAGE_B(P, br, kt) do { const char* _g = (const char*)(Bt + (size_t)(br) * K + (kt) * BK); \
    _Pragma("unroll") for (int _i = 0; _i < 2; ++_i) { \
      __builtin_amdgcn_global_load_lds((const unsigned*)(_g + boff[_i]), (LAS unsigned*)(lds + (P) + ldsw + _i * 8192), 16, 0, 0); } } while (0)
#define LDA(dst, b, h) _Pragma("unroll") for (int m = 0; m < 4; ++m) _Pragma("unroll") for (int k = 0; k < 2; ++k) \
    dst[m][k] = *(const LAS bf16x8*)(lds + SA(b, h) + ra + m * 2048 + k * 1024)
#define LDB(dst, b, h) _Pragma("unroll") for (int n = 0; n < 2; ++n) _Pragma("unroll") for (int k = 0; k < 2; ++k) \
    dst[n][k] = *(const LAS bf16x8*)(lds + SB(b, h) + rb + n * 2048 + k * 1024)
#define MMA(ai, bj, At, Bf) do { __builtin_amdgcn_s_setprio(1); \
    _Pragma("unroll") for (int m = 0; m < 4; ++m) _Pragma("unroll") for (int n = 0; n < 2; ++n) _Pragma("unroll") for (int k = 0; k < 2; ++k) \
      acc[ai][bj][m][n] = __builtin_amdgcn_mfma_f32_16x16x32_bf16(Bf[n][k], At[m][k], acc[ai][bj][m][n], 0, 0, 0); \
    __builtin_amdgcn_s_setprio(0); } while (0)
#define WAIT_V(n) asm volatile("s_waitcnt vmcnt(" #n ")" ::: "memory")
#define WAIT_L(n) asm volatile("s_waitcnt lgkmcnt(" #n ")" ::: "memory")
#define BAR __builtin_amdgcn_s_barrier()
#define SCHED __builtin_amdgcn_sched_barrier(0)
  const int nM = M / BM, nN = N / BM, nwg = nM * nN;
  const int gtid = opaque_tid();
  const int wid = __builtin_amdgcn_readfirstlane(gtid >> 6), lane = gtid & 63, wr = wid >> 2, wc = wid & 3, fr = lane & 15, fq = lane >> 4;
  constexpr int nt = K / BK;
  const unsigned ldsw = (unsigned)wid * 1024u;
  const int ra = lds_byte(wr * 64 + fr, fq * 8), rb = lds_byte(wc * 32 + fr, fq * 8);
  unsigned aoff[2], boff[2];
#pragma unroll
  for (int i = 0; i < 2; ++i) { int r_, c_; stage_rc(gtid * 16 + i * 8192, r_, c_); aoff[i] = (unsigned)(r_ * lda + c_) * 2u; boff[i] = (unsigned)(r_ * K + c_) * 2u; }
  auto decode = [&](int L, int& brow_, int& bcol_) __attribute__((always_inline)) {
    int wgid = L;
    { const int q = nwg / NXCD, r = nwg % NXCD, xcd = wgid % NXCD, off = wgid / NXCD; wgid = (xcd < r ? xcd * (q + 1) : r * (q + 1) + (xcd - r) * q) + off; }
    const int nig = WGM * nN, gid = wgid / nig, fm = gid * WGM, gsz = min(nM - fm, WGM);
    const int pm = fm + ((wgid % nig) % gsz), pn = (wgid % nig) / gsz; brow_ = pm * BM; bcol_ = pn * BM;
  };
  int L = blockIdx.x;
  if (L < nwg) {
    int brow, bcol; decode(L, brow, bcol);
    f32x4 acc[2][2][4][2];
#pragma unroll
    for (int a = 0; a < 2; ++a)
#pragma unroll
      for (int b = 0; b < 2; ++b)
#pragma unroll
        for (int m = 0; m < 4; ++m)
#pragma unroll
          for (int n = 0; n < 2; ++n) acc[a][b][m][n] = (f32x4){0.f, 0.f, 0.f, 0.f};
    bf16x8 At[4][2], B0[2][2], B1[2][2];
    STAGE_B(SB(0, 0), bcol, 0); STAGE_A(SA(0, 0), brow, 0);
    STAGE_B(SB(0, 1), bcol + HALF, 0); STAGE_A(SA(0, 1), brow + HALF, 0);
    if (wr == 1) BAR;
    WAIT_V(4); BAR;
    STAGE_B(SB(1, 0), bcol, 1); STAGE_A(SA(1, 0), brow, 1); STAGE_B(SB(1, 1), bcol + HALF, 1);
    WAIT_V(6); BAR;
#pragma unroll 1
    for (;;) {
      const int Ln = L + gridDim.x;
      int nrow = brow, ncol = bcol;
      if (Ln < nwg) decode(Ln, nrow, ncol);
#pragma unroll 1
      for (int t = 0; t < nt; t += 2) {
        const bool last = (t == nt - 2);
        const int r2 = last ? nrow : brow, c2 = last ? ncol : bcol, k2 = last ? 0 : t + 2, k3 = last ? 1 : t + 3;
        LDB(B0, 0, 0); SCHED; LDA(At, 0, 0); STAGE_A(SA(1, 1), brow + HALF, t + 1);
        WAIT_L(8); BAR; WAIT_L(0); MMA(0, 0, At, B0); BAR; SCHED;
        LDB(B1, 0, 1); STAGE_B(SB(0, 0), c2, k2);
        BAR; WAIT_L(0); MMA(0, 1, At, B1); BAR;
        LDA(At, 0, 1); STAGE_A(SA(0, 0), r2, k2);
        BAR; WAIT_L(0); MMA(1, 0, At, B0); BAR; SCHED;
        STAGE_B(SB(0, 1), c2 + HALF, k2);
        WAIT_V(6); BAR; MMA(1, 1, At, B1); BAR;
        LDB(B0, 1, 0); SCHED; LDA(At, 1, 0); STAGE_A(SA(0, 1), r2 + HALF, k2);
        WAIT_L(8); BAR; WAIT_L(0); MMA(0, 0, At, B0); BAR; SCHED;
        LDB(B1, 1, 1); STAGE_B(SB(1, 0), c2, k3);
        BAR; WAIT_L(0); MMA(0, 1, At, B1); BAR;
        LDA(At, 1, 1); STAGE_A(SA(1, 0), r2, k3);
        BAR; WAIT_L(0); MMA(1, 0, At, B0); BAR; SCHED;
        STAGE_B(SB(1, 1), c2 + HALF, k3);
        WAIT_V(6); BAR; MMA(1, 1, At, B1); BAR;
      }
      epi(acc, brow, bcol, wr, wc, fr, fq);
#pragma unroll
      for (int a = 0; a < 2; ++a)
#pragma unroll
        for (int b = 0; b < 2; ++b)
#pragma unroll
          for (int m = 0; m < 4; ++m)
#pragma unroll
            for (int n = 0; n < 2; ++n) acc[a][b][m][n] = (f32x4){0.f, 0.f, 0.f, 0.f};
      if (Ln >= nwg) break;
      L = Ln; brow = nrow; bcol = ncol;
    }
    WAIT_V(0);
    if (wr == 0) BAR;
  }
  __syncthreads();
#undef SA
#undef SB
}

DI void attn_unit(const Params& p, char* smem, int unit) {
  const int kvh = unit & 3, nb = (unit >> 2) & 15, b = unit >> 6;
  bf16_t* proj = (bf16_t*)(p.ws + WS_PROJ);
  const float* rope = (const float*)(p.ws + WS_ROPE);
  bf16_t* Ks = (bf16_t*)smem;
  bf16_t* Vt = (bf16_t*)(smem + 36864);
  const int tid = opaque_tid(), lane = tid & 63, wave = tid >> 6;
  {
    const int key = tid >> 1, half = tid & 1;
    const int tokl = nb * 128 - 128 + key;
    u32x4 o0 = {0, 0, 0, 0}, o1 = o0, o2 = o0, o3 = o0;
    u32x4 v0 = o0, v1 = o0, v2 = o0, v3 = o0;
    if (tokl >= 0) {
      const size_t tok = (size_t)b * SEQ + tokl;
      const bf16_t* kp = proj + PB_AK + tok * 256 + kvh * 64 + 16 * half;
      const u32x4 r0 = *(const u32x4*)kp, r1 = *(const u32x4*)(kp + 8), r2 = *(const u32x4*)(kp + 32), r3 = *(const u32x4*)(kp + 40);
      const bf16_t* vp = proj + PB_AV + tok * 256 + kvh * 64 + 32 * half;
      v0 = *(const u32x4*)vp; v1 = *(const u32x4*)(vp + 8); v2 = *(const u32x4*)(vp + 16); v3 = *(const u32x4*)(vp + 24);
      float x1[16], x2[16];
#pragma unroll
      for (int i = 0; i < 4; ++i) { x1[2 * i] = bf_lo(r0[i]); x1[2 * i + 1] = bf_hi(r0[i]); x1[8 + 2 * i] = bf_lo(r1[i]); x1[8 + 2 * i + 1] = bf_hi(r1[i]);
                                    x2[2 * i] = bf_lo(r2[i]); x2[2 * i + 1] = bf_hi(r2[i]); x2[8 + 2 * i] = bf_lo(r3[i]); x2[8 + 2 * i + 1] = bf_hi(r3[i]); }
      float ss = 0.f;
#pragma unroll
      for (int j = 0; j < 16; ++j) ss += x1[j] * x1[j] + x2[j] * x2[j];
      ss += __shfl_xor(ss, 1);
      const float rstd = rsqrtf(ss * (1.0f / 64.0f) + EPS);
      const float* cs = rope + tok * 64 + 16 * half;
      const float* kw = p.k_norm_w + 16 * half;
      float y1[16], y2[16];
#pragma unroll
      for (int j = 0; j < 16; ++j) {
        const float a1 = x1[j] * rstd * kw[j], a2 = x2[j] * rstd * kw[32 + j], c = cs[j], s = cs[32 + j];
        y1[j] = a1 * c - a2 * s; y2[j] = a2 * c + a1 * s;
      }
      o0 = (u32x4){pk_bf16(y1[0], y1[1]), pk_bf16(y1[2], y1[3]), pk_bf16(y1[4], y1[5]), pk_bf16(y1[6], y1[7])};
      o1 = (u32x4){pk_bf16(y1[8], y1[9]), pk_bf16(y1[10], y1[11]), pk_bf16(y1[12], y1[13]), pk_bf16(y1[14], y1[15])};
      o2 = (u32x4){pk_bf16(y2[0], y2[1]), pk_bf16(y2[2], y2[3]), pk_bf16(y2[4], y2[5]), pk_bf16(y2[6], y2[7])};
      o3 = (u32x4){pk_bf16(y2[8], y2[9]), pk_bf16(y2[10], y2[11]), pk_bf16(y2[12], y2[13]), pk_bf16(y2[14], y2[15])};
    }
    bf16_t* kd = Ks + key * 72 + 16 * half;
    *(u32x4*)kd = o0; *(u32x4*)(kd + 8) = o1; *(u32x4*)(kd + 32) = o2; *(u32x4*)(kd + 40) = o3;
    bf16_t* vd = Vt + (32 * half) * 260 + key;
#pragma unroll
    for (int i = 0; i < 4; ++i) {
      vd[(2 * i) * 260] = (bf16_t)(v0[i] & 0xffffu); vd[(2 * i + 1) * 260] = (bf16_t)(v0[i] >> 16);
      vd[(8 + 2 * i) * 260] = (bf16_t)(v1[i] & 0xffffu); vd[(8 + 2 * i + 1) * 260] = (bf16_t)(v1[i] >> 16);
      vd[(16 + 2 * i) * 260] = (bf16_t)(v2[i] & 0xffffu); vd[(16 + 2 * i + 1) * 260] = (bf16_t)(v2[i] >> 16);
      vd[(24 + 2 * i) * 260] = (bf16_t)(v3[i] & 0xffffu); vd[(24 + 2 * i + 1) * 260] = (bf16_t)(v3[i] >> 16);
    }
  }
  __syncthreads();
  const int r = lane & 31, h = lane >> 5;
  constexpr float LOG2E = 1.4426950408889634f;
#pragma unroll 1
  for (int it = 0; it < 2; ++it) {
    const int item = wave * 2 + it, g = item >> 2, qs = item & 3;
    const int head = kvh * 4 + g;
    const size_t tok = (size_t)b * SEQ + nb * 128 + qs * 32 + r;
    bf16x8 qf[4];
    u32x4 gr[4];
    bf16_t* gbase = proj + PB_AG + ((size_t)b * SEQ + nb * 128 + qs * 32 + (lane >> 3)) * 1024 + head * 64 + (lane & 7) * 8;
#pragma unroll
    for (int i = 0; i < 4; ++i) gr[i] = *(const u32x4*)(gbase + (size_t)(8 * i) * 1024);
    {
      const u32x4* qp = (const u32x4*)(proj + PB_AQ + tok * 1024 + head * 64 + 8 * h);
      float xq[4][8]; float ss = 0.f;
#pragma unroll
      for (int s = 0; s < 4; ++s) { const u32x4 rr = qp[2 * s];
#pragma unroll
        for (int i = 0; i < 4; ++i) { xq[s][2 * i] = bf_lo(rr[i]); xq[s][2 * i + 1] = bf_hi(rr[i]); } }
#pragma unroll
      for (int s = 0; s < 4; ++s)
#pragma unroll
        for (int j = 0; j < 8; ++j) ss += xq[s][j] * xq[s][j];
      ss += __shfl_xor(ss, 32);
      const float rstd = rsqrtf(ss * (1.0f / 64.0f) + EPS) * (0.125f * LOG2E);
      const float* cs = rope + tok * 64 + 8 * h;
      const float* qw = p.q_norm_w + 8 * h;
#pragma unroll
      for (int s = 0; s < 2; ++s) {
        float ya[8], yb[8];
#pragma unroll
        for (int j = 0; j < 8; ++j) {
          const float a1 = xq[s][j] * rstd * qw[16 * s + j], a2 = xq[s + 2][j] * rstd * qw[32 + 16 * s + j], c = cs[16 * s + j], sn = cs[32 + 16 * s + j];
          ya[j] = a1 * c - a2 * sn; yb[j] = a2 * c + a1 * sn;
        }
        qf[s] = pack8(ya[0], ya[1], ya[2], ya[3], ya[4], ya[5], ya[6], ya[7]);
        qf[s + 2] = pack8(yb[0], yb[1], yb[2], yb[3], yb[4], yb[5], yb[6], yb[7]);
      }
    }
    f32x16 sacc[5];
#pragma unroll
    for (int kt = 0; kt < 5; ++kt) {
#pragma unroll
      for (int i = 0; i < 16; ++i) sacc[kt][i] = 0.f;
#pragma unroll
      for (int s = 0; s < 4; ++s) {
        const bf16x8 a = *(const bf16x8*)(Ks + (qs * 32 + kt * 32 + r) * 72 + 16 * s + 8 * h);
        sacc[kt] = MFMA32(a, qf[s], sacc[kt]);
      }
    }
    const float sinkv = p.sinks[head] * LOG2E;
    float m = -INFINITY;
#pragma unroll
    for (int kt = 0; kt < 5; ++kt) {
      const bool tile_ok = (nb > 0) || (qs * 32 + kt * 32 >= 128);
#pragma unroll
      for (int i = 0; i < 16; ++i) {
        const int cr = (i & 3) + 8 * (i >> 2) + 4 * h;
        bool ok = tile_ok;
        if (kt == 0) ok = ok && (cr > r);
        if (kt == 4) ok = ok && (cr <= r);
        const float v = ok ? sacc[kt][i] : -INFINITY;
        sacc[kt][i] = v; m = fmaxf(m, v);
      }
    }
    m = fmaxf(m, __shfl_xor(m, 32)); m = fmaxf(m, sinkv);
    float l = 0.f;
#pragma unroll
    for (int kt = 0; kt < 5; ++kt)
#pragma unroll
      for (int i = 0; i < 16; ++i) { const float pv = __builtin_amdgcn_exp2f(sacc[kt][i] - m); sacc[kt][i] = pv; l += pv; }
    l += __shfl_xor(l, 32); l += __builtin_amdgcn_exp2f(sinkv - m);
    f32x16 oacc[2];
#pragma unroll
    for (int i = 0; i < 16; ++i) { oacc[0][i] = 0.f; oacc[1][i] = 0.f; }
#pragma unroll
    for (int kt = 0; kt < 5; ++kt)
#pragma unroll
      for (int s = 0; s < 2; ++s) {
        const bf16x8 pb = pack8(sacc[kt][8 * s], sacc[kt][8 * s + 1], sacc[kt][8 * s + 2], sacc[kt][8 * s + 3], sacc[kt][8 * s + 4], sacc[kt][8 * s + 5], sacc[kt][8 * s + 6], sacc[kt][8 * s + 7]);
#pragma unroll
        for (int ht = 0; ht < 2; ++ht) {
          const bf16_t* vp = Vt + (ht * 32 + r) * 260 + (qs * 32 + kt * 32 + 16 * s + 4 * h);
          const u32x2 lo = *(const u32x2*)vp, hi = *(const u32x2*)(vp + 8);
          const u32x4 av = {lo[0], lo[1], hi[0], hi[1]};
          oacc[ht] = MFMA32(__builtin_bit_cast(bf16x8, av), pb, oacc[ht]);
        }
      }
    const float inv = fast_rcp(l);
    bf16_t* Os = (bf16_t*)(smem + 70144) + wave * (32 * 72);
#pragma unroll
    for (int ht = 0; ht < 2; ++ht)
#pragma unroll
      for (int g4 = 0; g4 < 4; ++g4) {
        const u32x2 w = {pk_bf16(oacc[ht][4 * g4] * inv, oacc[ht][4 * g4 + 1] * inv), pk_bf16(oacc[ht][4 * g4 + 2] * inv, oacc[ht][4 * g4 + 3] * inv)};
        *(u32x2*)(Os + r * 72 + ht * 32 + 8 * g4 + 4 * h) = w;
      }
    __builtin_amdgcn_wave_barrier();
    asm volatile("s_waitcnt lgkmcnt(0)" ::: "memory");
#pragma unroll
    for (int i = 0; i < 4; ++i) {
      const u32x4 ov = *(const u32x4*)(Os + ((lane >> 3) + 8 * i) * 72 + (lane & 7) * 8);
      const u32x4 gv = gr[i];
      u32x4 w;
#pragma unroll
      for (int j = 0; j < 4; ++j) w[j] = pk_bf16(bf_lo(ov[j]) * bf_lo(gv[j]), bf_hi(ov[j]) * bf_hi(gv[j]));
      if (p.st_m) *(u32x4*)(gbase + (size_t)(8 * i) * 1024) = w;
    }
    __builtin_amdgcn_wave_barrier();
  }
  __syncthreads();
}

struct HgrnRegs { unsigned rq[8], rf[8]; };
DI void hgrn_chunk_load(HgrnRegs& R, const bf16_t* proj, int u, int seg, int kp) {
  const int hh = u & 7, c = (u >> 3) & 31, b = u >> 8;
  const size_t tok0 = (size_t)b * SEQ + c * 64;
#pragma unroll
  for (int j = 0; j < 8; ++j) {
    const bf16_t* base = proj + (tok0 + 8 * seg + j) * 1024 + hh * 128 + 2 * kp;
    R.rq[j] = *(const unsigned*)(base + PB_RQ); R.rf[j] = *(const unsigned*)(base + PB_RF);
  }
}
DI void phase_hgrn_chunk(const Params& p, char* smem) {
  bf16_t* proj = (bf16_t*)(p.ws + WS_PROJ);
  bf16_t* Hb = (bf16_t*)(p.ws + WS_H);
  float* DL = (float*)(p.ws + WS_DL);
  bf16_t* QD = (bf16_t*)smem;
  bf16_t* KI = (bf16_t*)(smem + 17408);
  bf16_t* KoT = (bf16_t*)(smem + 34816);
  bf16_t* VT = (bf16_t*)(smem + 53248);
  bf16_t* Am = (bf16_t*)(smem + 71680);
  f32x4* segp = (f32x4*)(smem + 80896);
  float* Ob = (float*)(smem + 89600);
  const int tid = opaque_tid(), lane = tid & 63, wave = tid >> 6;
  const int kp = lane, seg = wave;
  const int c16 = lane & 15, q4 = lane >> 4;
  const int ft = tid >> 3, fv = (tid & 7) * 16;
  HgrnRegs R;
  if ((int)blockIdx.x < 4096) hgrn_chunk_load(R, proj, blockIdx.x, seg, kp);
#pragma unroll 1
  for (int u = blockIdx.x; u < 4096; u += gridDim.x) {
    const int hh = u & 7, c = (u >> 3) & 31, b = u >> 8;
    const size_t tok0 = (size_t)b * SEQ + c * 64;
    float lb0, lb1;
    {
      const f32x2 l0 = *(const f32x2*)(p.lower_bounds + hh * 128 + 2 * kp), l1 = *(const f32x2*)(p.lower_bounds + 1024 + hh * 128 + 2 * kp);
      lb0 = fast_rcp(1.f + fast_exp(l1[0] - l0[0])); lb1 = fast_rcp(1.f + fast_exp(l1[1] - l0[1]));
    }
    const f32x2 lbv = {lb0, lb1}, olb = {1.f - lb0, 1.f - lb1};
    f32x2 Ev[8], Iv[8], Kv[8];
    {
      f32x2 P = {1.f, 1.f}, Q = {1.f, 1.f};
#pragma unroll
      for (int j = 0; j < 8; ++j) {
        const float x0 = __builtin_amdgcn_fmed3f(bf_lo(R.rf[j]), -30.f, 30.f), x1 = __builtin_amdgcn_fmed3f(bf_hi(R.rf[j]), -30.f, 30.f);
        const f32x2 e = {__builtin_amdgcn_exp2f(x0 * -1.4426950408889634f), __builtin_amdgcn_exp2f(x1 * -1.4426950408889634f)};
        const f32x2 a1 = e + 1.f, a2 = lbv * e + 1.f, pr = a1 * a2;
        const f32x2 w = {fast_rcp(pr[0]), fast_rcp(pr[1])};
        const f32x2 r = w * a2;
        Kv[j] = olb * e * r;
        P = P * (a2 * r); Q = Q * (a1 * a1 * w);
        Ev[j] = P; Iv[j] = Q;
      }
      segp[seg * 64 + kp] = (f32x4){P[0], P[1], Q[0], Q[1]};
    }
    __syncthreads();
    {
      f32x2 pre = {1.f, 1.f}, pin = {1.f, 1.f}, tot = {1.f, 1.f};
#pragma unroll
      for (int s2 = 0; s2 < 8; ++s2) {
        const f32x4 v = segp[s2 * 64 + kp];
        const f32x2 vp = {v[0], v[1]}, vq = {v[2], v[3]};
        if (s2 < seg) { pre = pre * vp; pin = pin * vq; }
        tot = tot * vp;
      }
      f32x2 ko[8];
#pragma unroll
      for (int j = 0; j < 8; ++j) {
        const f32x2 Ea = pre * Ev[j], ia = pin * Iv[j];
        const f32x2 qv = {bf_lo(R.rq[j]), bf_hi(R.rq[j])};
        const f32x2 qd2 = qv * Ea, ki = Kv[j] * ia;
        ko[j] = ki * tot;
        const unsigned qd = pk_bf16(qd2[0], qd2[1]);
        *(unsigned*)(QD + (8 * seg + j) * 136 + 2 * kp) = qd;
        if (p.st_a) *(unsigned*)(proj + PB_RQ + (tok0 + 8 * seg + j) * 1024 + hh * 128 + 2 * kp) = qd;
        *(unsigned*)(KI + (8 * seg + j) * 136 + 2 * kp) = pk_bf16(ki[0], ki[1]);
      }
      *(bf16x8*)(KoT + (2 * kp) * 72 + 8 * seg) = pack8(ko[0][0], ko[1][0], ko[2][0], ko[3][0], ko[4][0], ko[5][0], ko[6][0], ko[7][0]);
      *(bf16x8*)(KoT + (2 * kp + 1) * 72 + 8 * seg) = pack8(ko[0][1], ko[1][1], ko[2][1], ko[3][1], ko[4][1], ko[5][1], ko[6][1], ko[7][1]);
      if (seg == 0 && p.st_a) { *(f32x2*)(DL + (size_t)u * 128 + 2 * kp) = tot; }
    }
    if (u + (int)gridDim.x < 4096) hgrn_chunk_load(R, proj, u + gridDim.x, seg, kp);
    __syncthreads();
    {
      const int ti = wave >> 1;
#pragma unroll
      for (int uu = 0; uu < 2; ++uu) {
        const int si = 2 * (wave & 1) + uu;
        f32x4 acc = {0.f, 0.f, 0.f, 0.f};
        if (si <= ti) {
#pragma unroll
          for (int ks = 0; ks < 4; ++ks) {
            const bf16x8 a = *(const bf16x8*)(QD + (16 * ti + c16) * 136 + 32 * ks + 8 * q4);
            const bf16x8 bb = *(const bf16x8*)(KI + (16 * si + c16) * 136 + 32 * ks + 8 * q4);
            acc = MFMA16(a, bb, acc);
          }
        }
#pragma unroll
        for (int j = 0; j < 4; ++j) {
          const int t = 16 * ti + 4 * q4 + j, s = 16 * si + c16;
          const float v = (s <= t) ? acc[j] : 0.f;
          Am[t * 72 + s] = (bf16_t)(pk_bf16(v, 0.f) & 0xffffu);
        }
      }
    }
    __syncthreads();
    {
#pragma unroll
      for (int i = 0; i < 2; ++i) {
        const int idx = tid + 512 * i, k = idx >> 3, t8 = (idx & 7) * 8;
        const u32x4 w = *(const u32x4*)(KoT + k * 72 + t8);
        if (p.st_a) *(u32x4*)(proj + PB_RF + (tok0 + (k >> 1)) * 1024 + hh * 128 + (k & 1) * 64 + t8) = w;
      }
      const int t = tid >> 3, s8 = (tid & 7) * 8;
      const u32x4 w = *(const u32x4*)(Am + t * 72 + s8);
      if (p.st_a) *(u32x4*)(Hb + ((size_t)u * 64 + t) * 64 + s8) = w;
    }
  }
  __syncthreads();
}

struct ScanRegs { u32x4 qd[2]; u32x4 ko[2]; u32x4 am; unsigned rv[8]; };
DI void hgrn_scan_load(ScanRegs& R, const Params& p, int b, int hh, int c, int tid) {
  const bf16_t* proj = (const bf16_t*)(p.ws + WS_PROJ);
  const bf16_t* Hb = (const bf16_t*)(p.ws + WS_H);
  const int lane = tid & 63, wave = tid >> 6;
  const size_t tok0 = (size_t)b * SEQ + c * 64;
  const size_t u = (size_t)(b * 32 + c) * 8 + hh;
#pragma unroll
  for (int i = 0; i < 2; ++i) {
    const int idx = tid + 512 * i;
    R.qd[i] = *(const u32x4*)(proj + PB_RQ + (tok0 + (idx >> 4)) * 1024 + hh * 128 + (idx & 15) * 8);
    const int k = idx >> 3, t8 = (idx & 7) * 8;
    R.ko[i] = *(const u32x4*)(proj + PB_RF + (tok0 + (k >> 1)) * 1024 + hh * 128 + (k & 1) * 64 + t8);
  }
  R.am = *(const u32x4*)(Hb + (u * 64 + (tid >> 3)) * 64 + (tid & 7) * 8);
#pragma unroll
  for (int j = 0; j < 8; ++j) R.rv[j] = *(const unsigned*)(proj + PB_RI + (tok0 + 8 * wave + j) * 1024 + hh * 128 + 2 * lane);
}
DI void hgrn_scan_unit(const Params& p, char* smem, int unit) {
  const int hh = unit & 7, b = unit >> 3;
  bf16_t* proj = (bf16_t*)(p.ws + WS_PROJ);
  bf16_t* QD = (bf16_t*)smem;
  bf16_t* KoT = (bf16_t*)(smem + 17408);
  bf16_t* VT = (bf16_t*)(smem + 35840);
  bf16_t* Am = (bf16_t*)(smem + 54272);
  float* dla = (float*)(smem + 97792);
  float* Ob = (float*)(smem + 64000);
  const int tid = opaque_tid(), lane = tid & 63, wave = tid >> 6;
  const int c16 = lane & 15, q4 = lane >> 4;
  const int ft = tid >> 3, fv = (tid & 7) * 16;
  const int vcol = 16 * wave + c16;
  f32x4 S[8];
#pragma unroll
  for (int i = 0; i < 8; ++i) S[i] = (f32x4){0.f, 0.f, 0.f, 0.f};
  ScanRegs R0, R1;
  hgrn_scan_load(R0, p, b, hh, 0, tid);
  hgrn_scan_load(R1, p, b, hh, 1, tid);
  {
    const float* DL = (const float*)(p.ws + WS_DL);
#pragma unroll
    for (int i = 0; i < 2; ++i) { const int idx = tid + 512 * i, c = idx >> 5, k4 = (idx & 31) * 4; *(f32x4*)(dla + c * 128 + k4) = *(const f32x4*)(DL + ((size_t)(b * 32 + c) * 8 + hh) * 128 + k4); }
  }
  auto body = [&](const int c, ScanRegs& C) __attribute__((always_inline)) {
    const size_t tok0 = (size_t)b * SEQ + c * 64;
#pragma unroll
    for (int i = 0; i < 2; ++i) {
      const int idx = tid + 512 * i;
      *(u32x4*)(QD + (idx >> 4) * 136 + (idx & 15) * 8) = C.qd[i];
      *(u32x4*)(KoT + (idx >> 3) * 72 + (idx & 7) * 8) = C.ko[i];
    }
    *(u32x4*)(Am + (tid >> 3) * 72 + (tid & 7) * 8) = C.am;
    {
      u32x4 wl, wh;
#pragma unroll
      for (int i = 0; i < 4; ++i) { wl[i] = (C.rv[2 * i] & 0xffffu) | (C.rv[2 * i + 1] << 16); wh[i] = (C.rv[2 * i] >> 16) | (C.rv[2 * i + 1] & 0xffff0000u); }
      *(u32x4*)(VT + (2 * lane) * 72 + 8 * wave) = wl;
      *(u32x4*)(VT + (2 * lane + 1) * 72 + 8 * wave) = wh;
    }
    if (c + 2 < 32) hgrn_scan_load(C, p, b, hh, c + 2, tid);
    const float* dl = dla + c * 128;
    u32x4 rg[2];
    __syncthreads();
    {
      bf16x8 bv[2];
#pragma unroll
      for (int ks = 0; ks < 2; ++ks) bv[ks] = *(const bf16x8*)(VT + vcol * 72 + 32 * ks + 8 * q4);
#pragma unroll
      for (int th = 0; th < 2; ++th) {
        f32x4 o[2];
#pragma unroll
        for (int i = 0; i < 2; ++i) o[i] = (f32x4){0.f, 0.f, 0.f, 0.f};
#pragma unroll
        for (int kq = 0; kq < 4; ++kq) {
          const bf16x8 sf = pack8(S[2 * kq][0], S[2 * kq][1], S[2 * kq][2], S[2 * kq][3], S[2 * kq + 1][0], S[2 * kq + 1][1], S[2 * kq + 1][2], S[2 * kq + 1][3]);
#pragma unroll
          for (int t2 = 0; t2 < 2; ++t2) {
            const int ti = 2 * th + t2;
            const bf16_t* ap = QD + (16 * ti + c16) * 136 + 32 * kq + 4 * q4;
            const u32x2 lo = *(const u32x2*)ap, hi = *(const u32x2*)(ap + 16);
            const u32x4 av = {lo[0], lo[1], hi[0], hi[1]};
            o[t2] = MFMA16(__builtin_bit_cast(bf16x8, av), sf, o[t2]);
          }
        }
#pragma unroll
        for (int t2 = 0; t2 < 2; ++t2)
#pragma unroll
          for (int ks = 0; ks < 2; ++ks) {
            const bf16x8 a = *(const bf16x8*)(Am + (16 * (2 * th + t2) + c16) * 72 + 32 * ks + 8 * q4);
            o[t2] = MFMA16(a, bv[ks], o[t2]);
          }
#pragma unroll
        for (int t2 = 0; t2 < 2; ++t2)
#pragma unroll
          for (int j = 0; j < 4; ++j) Ob[(16 * (2 * th + t2) + 4 * q4 + j) * 132 + vcol] = o[t2][j];
        __builtin_amdgcn_sched_barrier(0);
      }
      {
        const bf16_t* gq = proj + PB_RG + (tok0 + ft) * 1024 + hh * 128 + fv;
        rg[0] = *(const u32x4*)gq; rg[1] = *(const u32x4*)(gq + 8);
      }
#pragma unroll
      for (int kt = 0; kt < 8; ++kt) {
        const f32x4 d = *(const f32x4*)(dl + 16 * kt + 4 * q4);
        S[kt] = S[kt] * d;
#pragma unroll
        for (int ks = 0; ks < 2; ++ks) {
          const bf16x8 a = *(const bf16x8*)(KoT + (16 * kt + c16) * 72 + 32 * ks + 8 * q4);
          S[kt] = MFMA16(a, bv[ks], S[kt]);
        }
        if (kt & 1) __builtin_amdgcn_sched_barrier(0);
      }
    }
    __syncthreads();
    {
      f32x4 ov[4]; float ss = 0.f;
#pragma unroll
      for (int i = 0; i < 4; ++i) { ov[i] = *(const f32x4*)(Ob + ft * 132 + fv + 4 * i); ss += ov[i][0] * ov[i][0] + ov[i][1] * ov[i][1] + ov[i][2] * ov[i][2] + ov[i][3] * ov[i][3]; }
      ss += __shfl_xor(ss, 1); ss += __shfl_xor(ss, 2); ss += __shfl_xor(ss, 4);
      const float rstd = rsqrtf(ss * (1.0f / 128.0f) + EPS);
      float y[16];
#pragma unroll
      for (int i = 0; i < 4; ++i) {
        const f32x4 w = *(const f32x4*)(p.rec_norm_w + fv + 4 * i);
        const unsigned ga = (i < 2) ? rg[0][2 * i] : rg[1][2 * (i - 2)], gb = (i < 2) ? rg[0][2 * i + 1] : rg[1][2 * (i - 2) + 1];
        y[4 * i + 0] = ov[i][0] * rstd * w[0] * bf_lo(ga);
        y[4 * i + 1] = ov[i][1] * rstd * w[1] * bf_hi(ga);
        y[4 * i + 2] = ov[i][2] * rstd * w[2] * bf_lo(gb);
        y[4 * i + 3] = ov[i][3] * rstd * w[3] * bf_hi(gb);
      }
      bf16_t* gp = proj + PB_RG + (tok0 + ft) * 1024 + hh * 128 + fv;
      if (p.st_m) {
      *(bf16x8*)gp = pack8(y[0], y[1], y[2], y[3], y[4], y[5], y[6], y[7]);
      *(bf16x8*)(gp + 8) = pack8(y[8], y[9], y[10], y[11], y[12], y[13], y[14], y[15]);
      }
    }
  };
#pragma unroll 1
  for (int c = 0; c < 32; c += 2) { body(c, R0); body(c + 1, R1); }
  __syncthreads();
}

DI void phase_mix(const Params& p, char* smem) {
  int* s_item = (int*)(smem + 131072);
  unsigned* ctr = (unsigned*)(p.ws + WS_CTRL) + CW_WORK;
  while (true) {
    if (threadIdx.x == 0) *s_item = (int)atomicAdd(ctr, 1u);
    __syncthreads();
    const int item = *s_item;
    __syncthreads();
    if (item >= 128 + 1024) break;
    if (item < 128) hgrn_scan_unit(p, smem, item); else attn_unit(p, smem, item - 128);
  }
}

DI void phase_gemm1(const Params& p, char* smem) {
  EpiProj e{(bf16_t*)(p.ws + WS_PROJ)};
  gemm_phase<D_MODEL, (1 << 30), 0, NTOK, IN_W, D_MODEL>((LAS unsigned char*)smem, (const bf16_t*)(p.ws + WS_H), (const bf16_t*)(p.ws + WS_WTIN), e);
}
DI void phase_gemm2(const Params& p, char* smem) {
  EpiOut e{p.out, p.x, (const float*)(p.ws + WS_MOD)};
  gemm_phase<1024, 16, (int)(PB_RG - PB_AG) - 1024, NTOK, D_MODEL, D_MIX>((LAS unsigned char*)smem, (const bf16_t*)(p.ws + WS_PROJ) + PB_AG, (const bf16_t*)(p.ws + WS_WTOUT), e);
}

extern __shared__ __attribute__((aligned(16))) char dyn_smem[];

#if ONE_LAUNCH
__global__ void __launch_bounds__(NTHREADS, 2) hymba_fwd(Params p) {
  cg::grid_group grid = cg::this_grid();
  volatile LAS unsigned* st = (volatile LAS unsigned*)((LAS unsigned char*)dyn_smem + 131072 + 16);
  if (threadIdx.x == 0) { st[0] = 0u; st[1] = 0u; }
  __syncthreads();
  const XcdBarrier xb = xcd_barrier_post((unsigned*)(p.ws + WS_XBAR), st);
  phase_prep(p, dyn_smem);
  phase_norm(p, dyn_smem);
  if (p.ws == nullptr) grid.sync();
  xcd_barrier(xb);
  phase_gemm1(p, dyn_smem);
  xcd_barrier(xb);
  phase_hgrn_chunk(p, dyn_smem);
  xcd_barrier(xb);
  phase_mix(p, dyn_smem);
  xcd_barrier(xb);
  phase_gemm2(p, dyn_smem);
}
#else
__global__ void __launch_bounds__(NTHREADS, 2) k_prep(Params p) { phase_prep(p, dyn_smem); }
__global__ void __launch_bounds__(NTHREADS, 2) k_norm(Params p) { phase_norm(p, dyn_smem); }
__global__ void __launch_bounds__(NTHREADS, 2) k_gemm1(Params p) { phase_gemm1(p, dyn_smem); }
__global__ void __launch_bounds__(NTHREADS, 2) k_hgrna(Params p) { phase_hgrn_chunk(p, dyn_smem); }
__global__ void __launch_bounds__(NTHREADS, 2) k_mix(Params p) { phase_mix(p, dyn_smem); }
__global__ void __launch_bounds__(NTHREADS, 2) k_gemm2(Params p) { phase_gemm2(p, dyn_smem); }
#endif

extern "C" void kernel_launch(void* const* d_in, const int* in_sizes, int n_in, void* d_out, int out_size, void* d_ws, size_t ws_size, hipStream_t stream) {
  static int grid = 0;
  if (grid == 0) {
    if (n_in != 13 || ws_size < WS_END) { fprintf(stderr, "kernel_launch: unexpected n_in %d or workspace %zu < %zu\n", n_in, ws_size, (size_t)WS_END); grid = -1; return; }
    int dev = 0, cus = 0, per_cu = 0;
    hipGetDevice(&dev);
    hipDeviceGetAttribute(&cus, hipDeviceAttributeMultiprocessorCount, dev);
#if ONE_LAUNCH
    if (hipFuncSetAttribute((const void*)hymba_fwd, hipFuncAttributeMaxDynamicSharedMemorySize, LDS_BYTES) != hipSuccess) { fprintf(stderr, "hipFuncSetAttribute failed\n"); grid = -1; return; }
    hipOccupancyMaxActiveBlocksPerMultiprocessor(&per_cu, (const void*)hymba_fwd, NTHREADS, LDS_BYTES);
    if (per_cu < 1) { fprintf(stderr, "occupancy query says %d blocks per CU\n", per_cu); per_cu = 1; }
    grid = cus * per_cu;
#else
    hipFuncSetAttribute((const void*)k_prep, hipFuncAttributeMaxDynamicSharedMemorySize, LDS_BYTES);
    hipFuncSetAttribute((const void*)k_gemm1, hipFuncAttributeMaxDynamicSharedMemorySize, LDS_BYTES);
    hipFuncSetAttribute((const void*)k_mix, hipFuncAttributeMaxDynamicSharedMemorySize, LDS_BYTES);
    hipFuncSetAttribute((const void*)k_hgrna, hipFuncAttributeMaxDynamicSharedMemorySize, LDS_BYTES);
    hipFuncSetAttribute((const void*)k_gemm2, hipFuncAttributeMaxDynamicSharedMemorySize, LDS_BYTES);
    (void)per_cu;
    grid = cus;
#endif
    (void)hipGetLastError();
  }
  if (grid < 0) return;
  (void)hipMemsetAsync((char*)d_ws + WS_CTRL, 0, 16384, stream);
  Params p{};
  p.x = (const float*)d_in[0]; p.c = (const float*)d_in[1]; p.pos = (const int*)d_in[2]; p.norm_w = (const float*)d_in[3];
  p.w_ada = (const float*)d_in[4]; p.b_ada = (const float*)d_in[5]; p.w_in = (const float*)d_in[6]; p.q_norm_w = (const float*)d_in[7];
  p.k_norm_w = (const float*)d_in[8]; p.sinks = (const float*)d_in[9]; p.rec_norm_w = (const float*)d_in[10];
  p.lower_bounds = (const float*)d_in[11]; p.w_out = (const float*)d_in[12]; p.out = (float*)d_out; p.ws = (char*)d_ws; p.st_a = 1; p.st_m = 1;
#if ONE_LAUNCH
  void* args[] = {&p};
  hipError_t e = hipLaunchCooperativeKernel((const void*)hymba_fwd, dim3(grid), dim3(NTHREADS), args, LDS_BYTES, stream);
  if (e != hipSuccess) fprintf(stderr, "cooperative launch failed: %s (grid %d)\n", hipGetErrorString(e), grid);
#else
  for (int r = 0; r < REP_PREP; ++r) hipLaunchKernelGGL(k_prep, dim3(grid), dim3(NTHREADS), LDS_BYTES, stream, p);
  for (int r = 0; r < REP_NORM; ++r) hipLaunchKernelGGL(k_norm, dim3(grid), dim3(NTHREADS), 16384, stream, p);
  for (int r = 0; r < REP_G1; ++r) hipLaunchKernelGGL(k_gemm1, dim3(grid), dim3(NTHREADS), LDS_BYTES, stream, p);
  for (int r = 0; r < REP_A; ++r) { p.st_a = (r == REP_A - 1); hipLaunchKernelGGL(k_hgrna, dim3(grid), dim3(NTHREADS), LDS_BYTES, stream, p); }
  for (int r = 0; r < REP_M; ++r) { p.st_m = (r == REP_M - 1); (void)hipMemsetAsync((char*)d_ws + WS_CTRL, 0, 16384, stream); hipLaunchKernelGGL(k_mix, dim3(grid), dim3(NTHREADS), LDS_BYTES, stream, p); }
  for (int r = 0; r < REP_G2; ++r) hipLaunchKernelGGL(k_gemm2, dim3(grid), dim3(NTHREADS), LDS_BYTES, stream, p);
#endif
}
```

```cpp
#include <hip/hip_runtime.h>
#include <hip/hip_cooperative_groups.h>
#include <cstdio>
#include <cstdint>
namespace cg = cooperative_groups;

#ifndef ONE_LAUNCH
#define ONE_LAUNCH 1
#endif

#define REP_PREP 1
#define REP_NORM 1
#define REP_G1 1
#define REP_G2 1
#define REP_A 1
#define REP_M 1
#define DI __device__ __forceinline__
typedef unsigned short bf16_t;
typedef short bf16x8 __attribute__((ext_vector_type(8)));
typedef float f32x4 __attribute__((ext_vector_type(4)));
typedef float f32x2 __attribute__((ext_vector_type(2)));
typedef float f32x16 __attribute__((ext_vector_type(16)));
typedef unsigned u32x4 __attribute__((ext_vector_type(4)));
typedef unsigned u32x2 __attribute__((ext_vector_type(2)));
typedef __bf16 bf16x2_t __attribute__((ext_vector_type(2)));

constexpr int D_MODEL = 1024, BATCH = 16, SEQ = 2048, NTOK = BATCH * SEQ, IN_W = 6656, D_MIX = 2048;
constexpr int OFF_AQ = 0, OFF_AK = 1024, OFF_AV = 1280, OFF_AG = 1536, OFF_RQ = 2560, OFF_RF = 3584, OFF_RI = 4608, OFF_RG = 5632;
constexpr size_t PB_AQ = 0, PB_AK = PB_AQ + (size_t)NTOK * 1024, PB_AV = PB_AK + (size_t)NTOK * 256, PB_AG = PB_AV + (size_t)NTOK * 256,
                 PB_RQ = PB_AG + (size_t)NTOK * 1024, PB_RF = PB_RQ + (size_t)NTOK * 1024, PB_RI = PB_RF + (size_t)NTOK * 1024, PB_RG = PB_RI + (size_t)NTOK * 1024;
constexpr float EPS = 1e-6f;
constexpr int NTHREADS = 512;
constexpr int LDS_BYTES = 131072 + 256;

constexpr size_t MiB = 1024 * 1024;
constexpr size_t WS_CTRL = 0, WS_XBAR = 2048, WS_MOD = 16384, WS_ROPE = 1 * MiB, WS_WTIN = 9 * MiB, WS_WTOUT = 22 * MiB, WS_H = 26 * MiB, WS_PROJ = 90 * MiB, WS_DL = 506 * MiB,
                 WS_END = WS_DL + 2 * MiB;

struct Params {
  const float* x; const float* c; const int* pos; const float* norm_w; const float* w_ada; const float* b_ada;
  const float* w_in; const float* q_norm_w; const float* k_norm_w; const float* sinks; const float* rec_norm_w;
  const float* lower_bounds; const float* w_out; float* out; char* ws; int st_a; int st_m;
};

DI int opaque_tid() { int t = threadIdx.x; asm volatile("" : "+v"(t)); return t; }
DI unsigned pk_bf16(float lo, float hi) { f32x2 v = {lo, hi}; bf16x2_t b = __builtin_convertvector(v, bf16x2_t); return __builtin_bit_cast(unsigned, b); }
DI float bf_lo(unsigned u) { return __uint_as_float(u << 16); }
DI float bf_hi(unsigned u) { return __uint_as_float(u & 0xffff0000u); }
DI bf16x8 pack8(float a0, float a1, float a2, float a3, float a4, float a5, float a6, float a7) {
  u32x4 w = {pk_bf16(a0, a1), pk_bf16(a2, a3), pk_bf16(a4, a5), pk_bf16(a6, a7)}; return __builtin_bit_cast(bf16x8, w);
}
DI float fast_exp(float x) { return __builtin_amdgcn_exp2f(x * 1.4426950408889634f); }
DI float fast_rcp(float x) { return __builtin_amdgcn_rcpf(x); }
DI float silu(float x) { return x * fast_rcp(1.f + fast_exp(-x)); }
#define MFMA16(a, b, c) __builtin_amdgcn_mfma_f32_16x16x32_bf16((a), (b), (c), 0, 0, 0)
#define MFMA32(a, b, c) __builtin_amdgcn_mfma_f32_32x32x16_bf16((a), (b), (c), 0, 0, 0)

constexpr int CW_WORK = 0, CW_BAR1 = 64, CW_BAR2 = 128, CW_MOD = 192, CW_NORM = 320, CW_TR = 384;
#define XB_TMO      128
#define XB_XCNT(j)  (256  + 64 * (j))
#define XB_XSUB(j)  (1280 + 64 * (j))
#define XB_XGEN(j)  (2304 + 64 * (j))
#define XB_TOP      3328
#define XB_TOPGEN   3392
#define XCD_BAR_WORDS 3456
#define XB_SPIN_CAP (1u << 22)
#define LAS __attribute__((address_space(3)))
DI unsigned xb_ld(unsigned* p) { return __hip_atomic_load(p, __ATOMIC_RELAXED, __HIP_MEMORY_SCOPE_AGENT); }
DI unsigned xb_add(unsigned* p, unsigned v) { return __hip_atomic_fetch_add(p, v, __ATOMIC_RELAXED, __HIP_MEMORY_SCOPE_AGENT); }
DI unsigned xb_xcc_id() { return (unsigned)__builtin_amdgcn_s_getreg((3 << 11) | 20) & 0xFu; }
#define XB_SPIN(cond, bar) do { unsigned _sp = 0; while (cond) { __builtin_amdgcn_s_sleep(1); \
    if ((++_sp & 255u) == 0u) { if (xb_ld(&(bar)[XB_TMO])) break; if (_sp > XB_SPIN_CAP) { atomicAdd(&(bar)[XB_TMO], 1u); break; } } } } while (0)
struct XcdBarrier { unsigned* bar; unsigned x; volatile LAS unsigned* st; };
DI XcdBarrier xcd_barrier_post(unsigned* bar, volatile LAS unsigned* st) {
  XcdBarrier b; b.bar = bar; b.x = xb_xcc_id(); b.st = st;
  if (threadIdx.x == 0) (void)xb_add(&bar[XB_XCNT(b.x)], 1u);
  return b;
}
DI void xcd_barrier_complete(unsigned* bar, unsigned x, unsigned& nloc, unsigned& nx) {
  const unsigned G = gridDim.x;
  unsigned sum, cnt, mine, sp = 0u;
  for (;;) {
    sum = 0u; cnt = 0u; mine = 0u;
#pragma unroll
    for (unsigned j = 0; j < 16; ++j) { const unsigned c = xb_ld(&bar[XB_XCNT(j)]); sum += c; cnt += (c > 0u) ? 1u : 0u; mine = (j == x) ? c : mine; }
    if (sum == G) break;
    __builtin_amdgcn_s_sleep(1);
    if ((++sp & 255u) == 0u) { if (xb_ld(&bar[XB_TMO])) break; if (sp > XB_SPIN_CAP) { atomicAdd(&bar[XB_TMO], 1u); break; } }
  }
  nloc = mine > 0u ? mine : 1u; nx = cnt > 0u ? cnt : 1u;
}
DI void xcd_barrier(const XcdBarrier& b) {
  asm volatile("s_waitcnt vmcnt(0)" ::: "memory");
  __syncthreads();
  if (threadIdx.x == 0) {
    unsigned* bar = b.bar;
    __builtin_amdgcn_s_waitcnt(0);
    unsigned nloc = b.st[0], nx = b.st[1];
    if (nloc == 0u) { xcd_barrier_complete(bar, b.x, nloc, nx); b.st[0] = nloc; b.st[1] = nx; }
    const unsigned old = xb_add(&bar[XB_XSUB(b.x)], 1u);
    const unsigned gen = old / nloc;
    if (old + 1u == (gen + 1u) * nloc) {
      __builtin_amdgcn_fence(__ATOMIC_RELEASE, "agent");
      asm volatile("s_waitcnt vmcnt(0)" ::: "memory");
      const unsigned og = xb_add(&bar[XB_TOP], 1u);
      const unsigned tg = og / nx;
      if (og + 1u == (tg + 1u) * nx) xb_add(&bar[XB_TOPGEN], 1u);
      else XB_SPIN(xb_ld(&bar[XB_TOPGEN]) == tg, bar);
      __builtin_amdgcn_fence(__ATOMIC_ACQUIRE, "agent");
      xb_add(&bar[XB_XGEN(b.x)], 1u);
      asm volatile("s_waitcnt vmcnt(0)" ::: "memory");
    } else {
      XB_SPIN(xb_ld(&bar[XB_XGEN(b.x)]) == gen, bar);
      __builtin_amdgcn_fence(__ATOMIC_ACQUIRE, "agent");
      asm volatile("s_waitcnt vmcnt(0)" ::: "memory");
    }
  }
  __syncthreads();
}

DI void transpose_tile4(const float* __restrict__ W, int ldw, bf16_t* __restrict__ Wt, int ldt, int k0, int n0, float* tile, int tid) {
  f32x4 v[8];
#pragma unroll
  for (int pass = 0; pass < 8; ++pass) {
    const int r = (tid >> 4) + 32 * pass, c4 = (tid & 15) * 4;
    v[pass] = __builtin_nontemporal_load((const f32x4*)(W + (size_t)(k0 + r) * ldw + n0 + c4));
  }
#pragma unroll
  for (int pass = 0; pass < 8; ++pass) {
    const int r = (tid >> 4) + 32 * pass, c4 = (tid & 15) * 4;
    tile[r * 65 + c4 + 0] = v[pass][0]; tile[r * 65 + c4 + 1] = v[pass][1]; tile[r * 65 + c4 + 2] = v[pass][2]; tile[r * 65 + c4 + 3] = v[pass][3];
  }
  __syncthreads();
#pragma unroll
  for (int pass = 0; pass < 4; ++pass) {
    const int idx = tid + 512 * pass, nl = idx >> 5, kseg = (idx & 31) * 8;
    float x[8];
#pragma unroll
    for (int j = 0; j < 8; ++j) x[j] = tile[(kseg + j) * 65 + nl];
    const int c = nl & 31, rho = 16 * ((c >> 2) & 1) + 4 * (c >> 3) + (c & 3), nrow = n0 + (nl & 32) + rho;
    u32x4 w = {pk_bf16(x[0], x[1]), pk_bf16(x[2], x[3]), pk_bf16(x[4], x[5]), pk_bf16(x[6], x[7])};
    *(u32x4*)(Wt + (size_t)nrow * ldt + k0 + kseg) = w;
  }
  __syncthreads();
}

DI void phase_prep(const Params& p, char* smem) {
  const int tid = opaque_tid();
  float* rope = (float*)(p.ws + WS_ROPE);
  for (int i = blockIdx.x * NTHREADS + tid; i < NTOK * 32; i += gridDim.x * NTHREADS) {
    const int tok = i >> 5, f = i & 31;
    const float inv = exp2f(-(float)f * (13.287712379549449f / 32.0f));
    const float ang = (float)p.pos[tok] * inv;
    double t = (double)ang * 0.15915494309189535; t -= rint(t);
    const float r = (float)t;
    rope[(size_t)tok * 64 + f] = __builtin_amdgcn_cosf(r);
    rope[(size_t)tok * 64 + 32 + f] = __builtin_amdgcn_sinf(r);
  }
  float* mod = (float*)(p.ws + WS_MOD);
  bf16_t* wtin = (bf16_t*)(p.ws + WS_WTIN);
  bf16_t* wtout = (bf16_t*)(p.ws + WS_WTOUT);
  constexpr int J_MOD = 192, J_WIN = 4 * 104, J_WOUT = 8 * 16;
  for (int job = blockIdx.x; job < J_MOD; job += gridDim.x) {
      float* cact = (float*)smem;
      float* red = (float*)(smem + 65536);
      for (int i = tid; i < 16 * 256; i += NTHREADS) { const int b = i >> 8, k = (job / 48) * 256 + (i & 255); const float v = p.c[b * 1024 + k]; cact[b * 1024 + k] = silu(v); }
      __syncthreads();
      const int n = tid & 63, ks = tid >> 6, n0 = (job % 48) * 64, ksp = job / 48;
      float acc[16];
#pragma unroll
      for (int b = 0; b < 16; ++b) acc[b] = 0.f;
#pragma unroll 1
      for (int k = ksp * 256 + ks * 32; k < ksp * 256 + ks * 32 + 32; k += 16) {
        float w[16];
#pragma unroll
        for (int u = 0; u < 16; ++u) w[u] = __builtin_nontemporal_load(p.w_ada + (size_t)(k + u) * 3072 + n0 + n);
#pragma unroll
        for (int u = 0; u < 16; ++u)
#pragma unroll
          for (int b = 0; b < 16; ++b) acc[b] += cact[b * 1024 + k + u] * w[u];
      }
#pragma unroll
      for (int b = 0; b < 16; ++b) red[(ks * 16 + b) * 64 + n] = acc[b];
      __syncthreads();
      for (int o = tid; o < 1024; o += NTHREADS) {
        const int b = o >> 6, nn = o & 63; float sacc = (ksp == 0) ? p.b_ada[n0 + nn] : 0.f;
#pragma unroll
        for (int k2 = 0; k2 < 8; ++k2) sacc += red[(k2 * 16 + b) * 64 + nn];
        mod[(ksp * 16 + b) * 3072 + n0 + nn] = sacc;
      }
      asm volatile("s_waitcnt vmcnt(0)" ::: "memory");
      __syncthreads();
      if (tid == 0) __hip_atomic_fetch_add((unsigned*)(p.ws + WS_CTRL) + CW_MOD, 1u, __ATOMIC_RELEASE, __HIP_MEMORY_SCOPE_AGENT);
  }
}
DI void prep_transpose_job(const Params& p, char* smem, int j, int tid) {
  constexpr int J_WIN = 4 * 104;
  bf16_t* wtin = (bf16_t*)(p.ws + WS_WTIN);
  bf16_t* wtout = (bf16_t*)(p.ws + WS_WTOUT);
  if (j < J_WIN) { const int kt = j & 3, nt = j >> 2; transpose_tile4(p.w_in, IN_W, wtin, D_MODEL, kt * 256, nt * 64, (float*)smem, tid); }
  else { const int j2 = j - J_WIN, kt = j2 & 7, nt = j2 >> 3; transpose_tile4(p.w_out, D_MODEL, wtout, D_MIX, kt * 256, nt * 64, (float*)smem, tid); }
}

DI void phase_norm(const Params& p, char* smem) {
  const int tid = opaque_tid(), lane = tid & 63, wave = tid >> 6;
  const float* mod = (const float*)(p.ws + WS_MOD);
  bf16_t* H = (bf16_t*)(p.ws + WS_H);
  float* sc1 = (float*)(smem + 69632);
  float* shv = (float*)(smem + 69632 + 4096);
  int* s_item = (int*)(smem + 131072);
  unsigned* nctr = (unsigned*)(p.ws + WS_CTRL) + CW_NORM;
  unsigned* tctr = (unsigned*)(p.ws + WS_CTRL) + CW_TR;
  int bprev = -1;
  bool tr_left = true, nm_left = true, mod_ok = false;
  for (int step = 0; tr_left || nm_left; ++step) {
    const bool do_tr = tr_left && ((step % 3) == 0 || !nm_left);
    if (tid == 0) *s_item = do_tr ? (int)atomicAdd(tctr, 1u) : (int)atomicAdd(nctr, 1u);
    __syncthreads();
    const int g = *s_item;
    __syncthreads();
    if (do_tr) {
      if (g >= 4 * 104 + 8 * 16) tr_left = false; else prep_transpose_job(p, smem, g, tid);
      continue;
    }
    if (g >= NTOK / 64) { nm_left = false; continue; }
    if (!mod_ok) {
      if (tid == 0) { const unsigned* mc = (const unsigned*)(p.ws + WS_CTRL) + CW_MOD; while (__hip_atomic_load(mc, __ATOMIC_ACQUIRE, __HIP_MEMORY_SCOPE_AGENT) < 192u) __builtin_amdgcn_s_sleep(1); }
      __syncthreads();
      mod_ok = true;
    }
    const int b = g >> 5;
    if (b != bprev) {
      for (int col = tid; col < 1024; col += NTHREADS) {
        float sh = 0.f, sc = 0.f;
#pragma unroll
        for (int k2 = 0; k2 < 4; ++k2) { sh += mod[(k2 * 16 + b) * 3072 + col]; sc += mod[(k2 * 16 + b) * 3072 + 1024 + col]; }
        sc1[col] = p.norm_w[col] * (1.f + sc); shv[col] = sh;
      }
      bprev = b;
      __syncthreads();
    }
#pragma unroll 1
    for (int it = 0; it < 4; ++it) {
      const int row0 = g * 64 + wave * 8 + it * 2;
      f32x4 v[2][4]; float ss[2] = {0.f, 0.f};
#pragma unroll
      for (int rr = 0; rr < 2; ++rr) {
        const f32x4* xr = (const f32x4*)(p.x + (size_t)(row0 + rr) * D_MODEL);
#pragma unroll
        for (int i = 0; i < 4; ++i) v[rr][i] = __builtin_nontemporal_load(xr + lane + 64 * i);
      }
#pragma unroll
      for (int rr = 0; rr < 2; ++rr) {
#pragma unroll
        for (int i = 0; i < 4; ++i) ss[rr] += v[rr][i][0] * v[rr][i][0] + v[rr][i][1] * v[rr][i][1] + v[rr][i][2] * v[rr][i][2] + v[rr][i][3] * v[rr][i][3];
#pragma unroll
        for (int o = 32; o >= 1; o >>= 1) ss[rr] += __shfl_xor(ss[rr], o);
        ss[rr] = rsqrtf(ss[rr] * (1.0f / D_MODEL) + EPS);
      }
#pragma unroll
      for (int i = 0; i < 4; ++i) {
        const int col = (lane + 64 * i) * 4;
        const f32x4 a = *(const f32x4*)(sc1 + col), sh = *(const f32x4*)(shv + col);
#pragma unroll
        for (int rr = 0; rr < 2; ++rr) {
          float h[4];
#pragma unroll
          for (int j = 0; j < 4; ++j) h[j] = v[rr][i][j] * ss[rr] * a[j] + sh[j];
          u32x2 w = {pk_bf16(h[0], h[1]), pk_bf16(h[2], h[3])};
          *(u32x2*)(H + (size_t)(row0 + rr) * D_MODEL + col) = w;
        }
      }
    }
  }
}

constexpr int BM = 256, BK = 64, HALF = 128, NXCD = 8, WGM = 8, HT = HALF * BK;
DI int lds_byte(int r, int c) { const int st = (r >> 4) * 2 + (c >> 5), rr = r & 15, cc = c & 31, ob = rr * 64 + cc * 2; return st * 1024 + (ob ^ (((ob >> 9) & 1) << 5)); }
DI void stage_rc(int b, int& R, int& C) { const int st = b / 1024, sb = b % 1024, swz = sb ^ (((sb >> 9) & 1) << 5); R = (st >> 1) * 16 + swz / 64; C = (st & 1) * 32 + (swz % 64) / 2; }

struct EpiProj {
  bf16_t* O;
  DI void operator()(const f32x4 (&acc)[2][2][4][2], int brow, int bcol, int wr, int wc, int fr, int fq) const {
    const bool gate_tile = (bcol >= OFF_AG && bcol < OFF_AG + 1024) || (bcol >= OFF_RG);
    size_t sbase; int sld, scol;
    if (bcol < OFF_AK) { sbase = PB_AQ; sld = 1024; scol = bcol - OFF_AQ; }
    else if (bcol < OFF_AV) { sbase = PB_AK; sld = 256; scol = bcol - OFF_AK; }
    else if (bcol < OFF_AG) { sbase = PB_AV; sld = 256; scol = bcol - OFF_AV; }
    else if (bcol < OFF_RQ) { sbase = PB_AG; sld = 1024; scol = bcol - OFF_AG; }
    else if (bcol < OFF_RF) { sbase = PB_RQ; sld = 1024; scol = bcol - OFF_RQ; }
    else if (bcol < OFF_RI) { sbase = PB_RF; sld = 1024; scol = bcol - OFF_RF; }
    else if (bcol < OFF_RG) { sbase = PB_RI; sld = 1024; scol = bcol - OFF_RI; }
    else { sbase = PB_RG; sld = 1024; scol = bcol - OFF_RG; }
#pragma unroll
    for (int ai = 0; ai < 2; ++ai)
#pragma unroll
      for (int m = 0; m < 4; ++m) {
        const int row = brow + ai * HALF + wr * 64 + m * 16 + fr;
        bf16_t* rp = O + sbase + (size_t)row * sld + scol + wc * 32 + 8 * fq;
#pragma unroll
        for (int bj = 0; bj < 2; ++bj) {
          f32x4 a0 = acc[ai][bj][m][0], a1 = acc[ai][bj][m][1];
          if (gate_tile) {
#pragma unroll
            for (int j = 0; j < 4; ++j) { a0[j] = silu(a0[j]); a1[j] = silu(a1[j]); }
          }
          u32x4 w = {pk_bf16(a0[0], a0[1]), pk_bf16(a0[2], a0[3]), pk_bf16(a1[0], a1[1]), pk_bf16(a1[2], a1[3])};
          __builtin_nontemporal_store(w, (u32x4*)(rp + bj * HALF));
        }
      }
  }
};
struct EpiOut {
  float* O; const float* X; const float* mod;
  DI void operator()(const f32x4 (&acc)[2][2][4][2], int brow, int bcol, int wr, int wc, int fr, int fq) const {
    const int b = brow >> 11;
    f32x4 g[2][2];
    {
      f32x4 gp[2][4][2];
#pragma unroll
      for (int bj = 0; bj < 2; ++bj)
#pragma unroll
        for (int k2 = 0; k2 < 4; ++k2) {
          const float* gq = mod + (k2 * 16 + b) * 3072 + 2048 + bcol + bj * HALF + wc * 32 + 8 * fq;
          gp[bj][k2][0] = *(const f32x4*)gq; gp[bj][k2][1] = *(const f32x4*)(gq + 4);
        }
#pragma unroll
      for (int bj = 0; bj < 2; ++bj) { g[bj][0] = (gp[bj][0][0] + gp[bj][1][0]) + (gp[bj][2][0] + gp[bj][3][0]); g[bj][1] = (gp[bj][0][1] + gp[bj][1][1]) + (gp[bj][2][1] + gp[bj][3][1]); }
    }
    f32x4 xb[2][4][2];
    auto ldb = [&](int q, f32x4 (&x)[4][2]) __attribute__((always_inline)) {
      const int bj = q >> 1, ai = q & 1, col = bcol + bj * HALF + wc * 32 + 8 * fq;
#pragma unroll
      for (int m = 0; m < 4; ++m) {
        const size_t o = (size_t)(brow + ai * HALF + wr * 64 + m * 16 + fr) * D_MODEL + col;
        x[m][0] = *(const f32x4*)(X + o); x[m][1] = *(const f32x4*)(X + o + 4);
      }
    };
    ldb(0, xb[0]);
#pragma unroll
    for (int q = 0; q < 4; ++q) {
      if (q + 1 < 4) ldb(q + 1, xb[(q + 1) & 1]);
      const int bj = q >> 1, ai = q & 1, col = bcol + bj * HALF + wc * 32 + 8 * fq;
#pragma unroll
      for (int m = 0; m < 4; ++m) {
        const size_t o = (size_t)(brow + ai * HALF + wr * 64 + m * 16 + fr) * D_MODEL + col;
        *(f32x4*)(O + o) = xb[q & 1][m][0] + g[bj][0] * acc[ai][bj][m][0];
        *(f32x4*)(O + o + 4) = xb[q & 1][m][1] + g[bj][1] * acc[ai][bj][m][1];
      }
    }
  }
};

template <int lda, int split_kt, int gap, int M, int N, int K, class Epi>
DI void gemm_phase(LAS unsigned char* lds, const bf16_t* __restrict__ A, const bf16_t* __restrict__ Bt, const Epi& epi) {
#define SA(b, h) (((b) * 2 + (h)) * (HT * 2))
#define SB(b, h) ((4 + (b) * 2 + (h)) * (HT * 2))
#define STAGE_A(P, br, kt) do { const char* _g = (const char*)(A + (size_t)(br) * lda + (kt) * BK + ((kt) >= split_kt ? gap : 0)); \
    _Pragma("unroll") for (int _i = 0; _i < 2; ++_i) { \
      __builtin_amdgcn_global_load_lds((const unsigned*)(_g + aoff[_i]), (LAS unsigned*)(lds + (P) + ldsw + _i * 8192), 16, 0, 0); } } while (0)
#define STAGE_B(P, br, kt) do { const char* _g = (const char*)(Bt + (size_t)(br) * K + (kt) * BK); \
    _Pragma("unroll") for (int _i = 0; _i < 2; ++_i) { \
      __builtin_amdgcn_global_load_lds((const unsigned*)(_g + boff[_i]), (LAS unsigned*)(lds + (P) + ldsw + _i * 8192), 16, 0, 0); } } while (0)
#define LDA(dst, b, h) _Pragma("unroll") for (int m = 0; m < 4; ++m) _Pragma("unroll") for (int k = 0; k < 2; ++k) \
    dst[m][k] = *(const LAS bf16x8*)(lds + SA(b, h) + ra + m * 2048 + k * 1024)
#define LDB(dst, b, h) _Pragma("unroll") for (int n = 0; n < 2; ++n) _Pragma("unroll") for (int k = 0; k < 2; ++k) \
    dst[n][k] = *(const LAS bf16x8*)(lds + SB(b, h) + rb + n * 2048 + k * 1024)
#define MMA(ai, bj, At, Bf) do { __builtin_amdgcn_s_setprio(1); \
    _Pragma("unroll") for (int m = 0; m < 4; ++m) _Pragma("unroll") for (int n = 0; n < 2; ++n) _Pragma("unroll") for (int k = 0; k < 2; ++k) \
      acc[ai][bj][m][n] = __builtin_amdgcn_mfma_f32_16x16x32_bf16(Bf[n][k], At[m][k], acc[ai][bj][m][n], 0, 0, 0); \
    __builtin_amdgcn_s_setprio(0); } while (0)
#define WAIT_V(n) asm volatile("s_waitcnt vmcnt(" #n ")" ::: "memory")
#define WAIT_L(n) asm volatile("s_waitcnt lgkmcnt(" #n ")" ::: "memory")
#define BAR __builtin_amdgcn_s_barrier()
#define SCHED __builtin_amdgcn_sched_barrier(0)
  const int nM = M / BM, nN = N / BM, nwg = nM * nN;
  const int gtid = opaque_tid();
  const int wid = __builtin_amdgcn_readfirstlane(gtid >> 6), lane = gtid & 63, wr = wid >> 2, wc = wid & 3, fr = lane & 15, fq = lane >> 4;
  constexpr int nt = K / BK;
  const unsigned ldsw = (unsigned)wid * 1024u;
  const int ra = lds_byte(wr * 64 + fr, fq * 8), rb = lds_byte(wc * 32 + fr, fq * 8);
  unsigned aoff[2], boff[2];
#pragma unroll
  for (int i = 0; i < 2; ++i) { int r_, c_; stage_rc(gtid * 16 + i * 8192, r_, c_); aoff[i] = (unsigned)(r_ * lda + c_) * 2u; boff[i] = (unsigned)(r_ * K + c_) * 2u; }
  auto decode = [&](int L, int& brow_, int& bcol_) __attribute__((always_inline)) {
    int wgid = L;
    { const int q = nwg / NXCD, r = nwg % NXCD, xcd = wgid % NXCD, off = wgid / NXCD; wgid = (xcd < r ? xcd * (q + 1) : r * (q + 1) + (xcd - r) * q) + off; }
    const int nig = WGM * nN, gid = wgid / nig, fm = gid * WGM, gsz = min(nM - fm, WGM);
    const int pm = fm + ((wgid % nig) % gsz), pn = (wgid % nig) / gsz; brow_ = pm * BM; bcol_ = pn * BM;
  };
  int L = blockIdx.x;
  if (L < nwg) {
    int brow, bcol; decode(L, brow, bcol);
    f32x4 acc[2][2][4][2];
#pragma unroll
    for (int a = 0; a < 2; ++a)
#pragma unroll
      for (int b = 0; b < 2; ++b)
#pragma unroll
        for (int m = 0; m < 4; ++m)
#pragma unroll
          for (int n = 0; n < 2; ++n) acc[a][b][m][n] = (f32x4){0.f, 0.f, 0.f, 0.f};
    bf16x8 At[4][2], B0[2][2], B1[2][2];
    STAGE_B(SB(0, 0), bcol, 0); STAGE_A(SA(0, 0), brow, 0);
    STAGE_B(SB(0, 1), bcol + HALF, 0); STAGE_A(SA(0, 1), brow + HALF, 0);
    if (wr == 1) BAR;
    WAIT_V(4); BAR;
    STAGE_B(SB(1, 0), bcol, 1); STAGE_A(SA(1, 0), brow, 1); STAGE_B(SB(1, 1), bcol + HALF, 1);
    WAIT_V(6); BAR;
#pragma unroll 1
    for (;;) {
      const int Ln = L + gridDim.x;
      int nrow = brow, ncol = bcol;
      if (Ln < nwg) decode(Ln, nrow, ncol);
#pragma unroll 1
      for (int t = 0; t < nt; t += 2) {
        const bool last = (t == nt - 2);
        const int r2 = last ? nrow : brow, c2 = last ? ncol : bcol, k2 = last ? 0 : t + 2, k3 = last ? 1 : t + 3;
        LDB(B0, 0, 0); SCHED; LDA(At, 0, 0); STAGE_A(SA(1, 1), brow + HALF, t + 1);
        WAIT_L(8); BAR; WAIT_L(0); MMA(0, 0, At, B0); BAR; SCHED;
        LDB(B1, 0, 1); STAGE_B(SB(0, 0), c2, k2);
        BAR; WAIT_L(0); MMA(0, 1, At, B1); BAR;
        LDA(At, 0, 1); STAGE_A(SA(0, 0), r2, k2);
        BAR; WAIT_L(0); MMA(1, 0, At, B0); BAR; SCHED;
        STAGE_B(SB(0, 1), c2 + HALF, k2);
        WAIT_V(6); BAR; MMA(1, 1, At, B1); BAR;
        LDB(B0, 1, 0); SCHED; LDA(At, 1, 0); STAGE_A(SA(0, 1), r2 + HALF, k2);
        WAIT_L(8); BAR; WAIT_L(0); MMA(0, 0, At, B0); BAR; SCHED;
        LDB(B1, 1, 1); STAGE_B(SB(1, 0), c2, k3);
        BAR; WAIT_L(0); MMA(0, 1, At, B1); BAR;
        LDA(At, 1, 1); STAGE_A(SA(1, 0), r2, k3);
        BAR; WAIT_L(0); MMA(1, 0, At, B0); BAR; SCHED;
        STAGE_B(SB(1, 1), c2 + HALF, k3);
        WAIT_V(6); BAR; MMA(1, 1, At, B1); BAR;
      }
      epi(acc, brow, bcol, wr, wc, fr, fq);
#pragma unroll
      for (int a = 0; a < 2; ++a)
#pragma unroll
        for (int b = 0; b < 2; ++b)
#pragma unroll
          for (int m = 0; m < 4; ++m)
#pragma unroll
            for (int n = 0; n < 2; ++n) acc[a][b][m][n] = (f32x4){0.f, 0.f, 0.f, 0.f};
      if (Ln >= nwg) break;
      L = Ln; brow = nrow; bcol = ncol;
    }
    WAIT_V(0);
    if (wr == 0) BAR;
  }
  __syncthreads();
#undef SA
#undef SB
}

DI void attn_unit(const Params& p, char* smem, int unit) {
  const int kvh = unit & 3, nb = (unit >> 2) & 15, b = unit >> 6;
  bf16_t* proj = (bf16_t*)(p.ws + WS_PROJ);
  const float* rope = (const float*)(p.ws + WS_ROPE);
  bf16_t* Ks = (bf16_t*)smem;
  bf16_t* Vt = (bf16_t*)(smem + 36864);
  const int tid = opaque_tid(), lane = tid & 63, wave = tid >> 6;
  {
    const int key = tid >> 1, half = tid & 1;
    const int tokl = nb * 128 - 128 + key;
    u32x4 o0 = {0, 0, 0, 0}, o1 = o0, o2 = o0, o3 = o0;
    u32x4 v0 = o0, v1 = o0, v2 = o0, v3 = o0;
    if (tokl >= 0) {
      const size_t tok = (size_t)b * SEQ + tokl;
      const bf16_t* kp = proj + PB_AK + tok * 256 + kvh * 64 + 16 * half;
      const u32x4 r0 = *(const u32x4*)kp, r1 = *(const u32x4*)(kp + 8), r2 = *(const u32x4*)(kp + 32), r3 = *(const u32x4*)(kp + 40);
      const bf16_t* vp = proj + PB_AV + tok * 256 + kvh * 64 + 32 * half;
      v0 = *(const u32x4*)vp; v1 = *(const u32x4*)(vp + 8); v2 = *(const u32x4*)(vp + 16); v3 = *(const u32x4*)(vp + 24);
      float x1[16], x2[16];
#pragma unroll
      for (int i = 0; i < 4; ++i) { x1[2 * i] = bf_lo(r0[i]); x1[2 * i + 1] = bf_hi(r0[i]); x1[8 + 2 * i] = bf_lo(r1[i]); x1[8 + 2 * i + 1] = bf_hi(r1[i]);
                                    x2[2 * i] = bf_lo(r2[i]); x2[2 * i + 1] = bf_hi(r2[i]); x2[8 + 2 * i] = bf_lo(r3[i]); x2[8 + 2 * i + 1] = bf_hi(r3[i]); }
      float ss = 0.f;
#pragma unroll
      for (int j = 0; j < 16; ++j) ss += x1[j] * x1[j] + x2[j] * x2[j];
      ss += __shfl_xor(ss, 1);
      const float rstd = rsqrtf(ss * (1.0f / 64.0f) + EPS);
      const float* cs = rope + tok * 64 + 16 * half;
      const float* kw = p.k_norm_w + 16 * half;
      float y1[16], y2[16];
#pragma unroll
      for (int j = 0; j < 16; ++j) {
        const float a1 = x1[j] * rstd * kw[j], a2 = x2[j] * rstd * kw[32 + j], c = cs[j], s = cs[32 + j];
        y1[j] = a1 * c - a2 * s; y2[j] = a2 * c + a1 * s;
      }
      o0 = (u32x4){pk_bf16(y1[0], y1[1]), pk_bf16(y1[2], y1[3]), pk_bf16(y1[4], y1[5]), pk_bf16(y1[6], y1[7])};
      o1 = (u32x4){pk_bf16(y1[8], y1[9]), pk_bf16(y1[10], y1[11]), pk_bf16(y1[12], y1[13]), pk_bf16(y1[14], y1[15])};
      o2 = (u32x4){pk_bf16(y2[0], y2[1]), pk_bf16(y2[2], y2[3]), pk_bf16(y2[4], y2[5]), pk_bf16(y2[6], y2[7])};
      o3 = (u32x4){pk_bf16(y2[8], y2[9]), pk_bf16(y2[10], y2[11]), pk_bf16(y2[12], y2[13]), pk_bf16(y2[14], y2[15])};
    }
    bf16_t* kd = Ks + key * 72 + 16 * half;
    *(u32x4*)kd = o0; *(u32x4*)(kd + 8) = o1; *(u32x4*)(kd + 32) = o2; *(u32x4*)(kd + 40) = o3;
    bf16_t* vd = Vt + (32 * half) * 260 + key;
#pragma unroll
    for (int i = 0; i < 4; ++i) {
      vd[(2 * i) * 260] = (bf16_t)(v0[i] & 0xffffu); vd[(2 * i + 1) * 260] = (bf16_t)(v0[i] >> 16);
      vd[(8 + 2 * i) * 260] = (bf16_t)(v1[i] & 0xffffu); vd[(8 + 2 * i + 1) * 260] = (bf16_t)(v1[i] >> 16);
      vd[(16 + 2 * i) * 260] = (bf16_t)(v2[i] & 0xffffu); vd[(16 + 2 * i + 1) * 260] = (bf16_t)(v2[i] >> 16);
      vd[(24 + 2 * i) * 260] = (bf16_t)(v3[i] & 0xffffu); vd[(24 + 2 * i + 1) * 260] = (bf16_t)(v3[i] >> 16);
    }
  }
  __syncthreads();
  const int r = lane & 31, h = lane >> 5;
  constexpr float LOG2E = 1.4426950408889634f;
#pragma unroll 1
  for (int it = 0; it < 2; ++it) {
    const int item = wave * 2 + it, g = item >> 2, qs = item & 3;
    const int head = kvh * 4 + g;
    const size_t tok = (size_t)b * SEQ + nb * 128 + qs * 32 + r;
    bf16x8 qf[4];
    u32x4 gr[4];
    bf16_t* gbase = proj + PB_AG + ((size_t)b * SEQ + nb * 128 + qs * 32 + (lane >> 3)) * 1024 + head * 64 + (lane & 7) * 8;
#pragma unroll
    for (int i = 0; i < 4; ++i) gr[i] = *(const u32x4*)(gbase + (size_t)(8 * i) * 1024);
    {
      const u32x4* qp = (const u32x4*)(proj + PB_AQ + tok * 1024 + head * 64 + 8 * h);
      float xq[4][8]; float ss = 0.f;
#pragma unroll
      for (int s = 0; s < 4; ++s) { const u32x4 rr = qp[2 * s];
#pragma unroll
        for (int i = 0; i < 4; ++i) { xq[s][2 * i] = bf_lo(rr[i]); xq[s][2 * i + 1] = bf_hi(rr[i]); } }
#pragma unroll
      for (int s = 0; s < 4; ++s)
#pragma unroll
        for (int j = 0; j < 8; ++j) ss += xq[s][j] * xq[s][j];
      ss += __shfl_xor(ss, 32);
      const float rstd = rsqrtf(ss * (1.0f / 64.0f) + EPS) * (0.125f * LOG2E);
      const float* cs = rope + tok * 64 + 8 * h;
      const float* qw = p.q_norm_w + 8 * h;
#pragma unroll
      for (int s = 0; s < 2; ++s) {
        float ya[8], yb[8];
#pragma unroll
        for (int j = 0; j < 8; ++j) {
          const float a1 = xq[s][j] * rstd * qw[16 * s + j], a2 = xq[s + 2][j] * rstd * qw[32 + 16 * s + j], c = cs[16 * s + j], sn = cs[32 + 16 * s + j];
          ya[j] = a1 * c - a2 * sn; yb[j] = a2 * c + a1 * sn;
        }
        qf[s] = pack8(ya[0], ya[1], ya[2], ya[3], ya[4], ya[5], ya[6], ya[7]);
        qf[s + 2] = pack8(yb[0], yb[1], yb[2], yb[3], yb[4], yb[5], yb[6], yb[7]);
      }
    }
    f32x16 sacc[5];
#pragma unroll
    for (int kt = 0; kt < 5; ++kt) {
#pragma unroll
      for (int i = 0; i < 16; ++i) sacc[kt][i] = 0.f;
#pragma unroll
      for (int s = 0; s < 4; ++s) {
        const bf16x8 a = *(const bf16x8*)(Ks + (qs * 32 + kt * 32 + r) * 72 + 16 * s + 8 * h);
        sacc[kt] = MFMA32(a, qf[s], sacc[kt]);
      }
    }
    const float sinkv = p.sinks[head] * LOG2E;
    float m = -INFINITY;
#pragma unroll
    for (int kt = 0; kt < 5; ++kt) {
      const bool tile_ok = (nb > 0) || (qs * 32 + kt * 32 >= 128);
#pragma unroll
      for (int i = 0; i < 16; ++i) {
        const int cr = (i & 3) + 8 * (i >> 2) + 4 * h;
        bool ok = tile_ok;
        if (kt == 0) ok = ok && (cr > r);
        if (kt == 4) ok = ok && (cr <= r);
        const float v = ok ? sacc[kt][i] : -INFINITY;
        sacc[kt][i] = v; m = fmaxf(m, v);
      }
    }
    m = fmaxf(m, __shfl_xor(m, 32)); m = fmaxf(m, sinkv);
    float l = 0.f;
#pragma unroll
    for (int kt = 0; kt < 5; ++kt)
#pragma unroll
      for (int i = 0; i < 16; ++i) { const float pv = __builtin_amdgcn_exp2f(sacc[kt][i] - m); sacc[kt][i] = pv; l += pv; }
    l += __shfl_xor(l, 32); l += __builtin_amdgcn_exp2f(sinkv - m);
    f32x16 oacc[2];
#pragma unroll
    for (int i = 0; i < 16; ++i) { oacc[0][i] = 0.f; oacc[1][i] = 0.f; }
#pragma unroll
    for (int kt = 0; kt < 5; ++kt)
#pragma unroll
      for (int s = 0; s < 2; ++s) {
        const bf16x8 pb = pack8(sacc[kt][8 * s], sacc[kt][8 * s + 1], sacc[kt][8 * s + 2], sacc[kt][8 * s + 3], sacc[kt][8 * s + 4], sacc[kt][8 * s + 5], sacc[kt][8 * s + 6], sacc[kt][8 * s + 7]);
#pragma unroll
        for (int ht = 0; ht < 2; ++ht) {
          const bf16_t* vp = Vt + (ht * 32 + r) * 260 + (qs * 32 + kt * 32 + 16 * s + 4 * h);
          const u32x2 lo = *(const u32x2*)vp, hi = *(const u32x2*)(vp + 8);
          const u32x4 av = {lo[0], lo[1], hi[0], hi[1]};
          oacc[ht] = MFMA32(__builtin_bit_cast(bf16x8, av), pb, oacc[ht]);
        }
      }
    const float inv = fast_rcp(l);
    bf16_t* Os = (bf16_t*)(smem + 70144) + wave * (32 * 72);
#pragma unroll
    for (int ht = 0; ht < 2; ++ht)
#pragma unroll
      for (int g4 = 0; g4 < 4; ++g4) {
        const u32x2 w = {pk_bf16(oacc[ht][4 * g4] * inv, oacc[ht][4 * g4 + 1] * inv), pk_bf16(oacc[ht][4 * g4 + 2] * inv, oacc[ht][4 * g4 + 3] * inv)};
        *(u32x2*)(Os + r * 72 + ht * 32 + 8 * g4 + 4 * h) = w;
      }
    __builtin_amdgcn_wave_barrier();
    asm volatile("s_waitcnt lgkmcnt(0)" ::: "memory");
#pragma unroll
    for (int i = 0; i < 4; ++i) {
      const u32x4 ov = *(const u32x4*)(Os + ((lane >> 3) + 8 * i) * 72 + (lane & 7) * 8);
      const u32x4 gv = gr[i];
      u32x4 w;
#pragma unroll
      for (int j = 0; j < 4; ++j) w[j] = pk_bf16(bf_lo(ov[j]) * bf_lo(gv[j]), bf_hi(ov[j]) * bf_hi(gv[j]));
      if (p.st_m) *(u32x4*)(gbase + (size_t)(8 * i) * 1024) = w;
    }
    __builtin_amdgcn_wave_barrier();
  }
  __syncthreads();
}

struct HgrnRegs { unsigned rq[8], rf[8]; };
DI void hgrn_chunk_load(HgrnRegs& R, const bf16_t* proj, int u, int seg, int kp) {
  const int hh = u & 7, c = (u >> 3) & 31, b = u >> 8;
  const size_t tok0 = (size_t)b * SEQ + c * 64;
#pragma unroll
  for (int j = 0; j < 8; ++j) {
    const bf16_t* base = proj + (tok0 + 8 * seg + j) * 1024 + hh * 128 + 2 * kp;
    R.rq[j] = __builtin_nontemporal_load((const unsigned*)(base + PB_RQ)); R.rf[j] = __builtin_nontemporal_load((const unsigned*)(base + PB_RF));
  }
}
DI void phase_hgrn_chunk(const Params& p, char* smem) {
  bf16_t* proj = (bf16_t*)(p.ws + WS_PROJ);
  bf16_t* Hb = (bf16_t*)(p.ws + WS_H);
  float* DL = (float*)(p.ws + WS_DL);
  bf16_t* QD = (bf16_t*)smem;
  bf16_t* KI = (bf16_t*)(smem + 17408);
  bf16_t* KoT = (bf16_t*)(smem + 34816);
  bf16_t* VT = (bf16_t*)(smem + 53248);
  bf16_t* Am = (bf16_t*)(smem + 71680);
  f32x4* segp = (f32x4*)(smem + 80896);
  float* Ob = (float*)(smem + 89600);
  const int tid = opaque_tid(), lane = tid & 63, wave = tid >> 6;
  const int kp = lane, seg = wave;
  const int c16 = lane & 15, q4 = lane >> 4;
  const int ft = tid >> 3, fv = (tid & 7) * 16;
  HgrnRegs R;
  if ((int)blockIdx.x < 4096) hgrn_chunk_load(R, proj, blockIdx.x, seg, kp);
#pragma unroll 1
  for (int u = blockIdx.x; u < 4096; u += gridDim.x) {
    const int hh = u & 7, c = (u >> 3) & 31, b = u >> 8;
    const size_t tok0 = (size_t)b * SEQ + c * 64;
    float lb0, lb1;
    {
      const f32x2 l0 = *(const f32x2*)(p.lower_bounds + hh * 128 + 2 * kp), l1 = *(const f32x2*)(p.lower_bounds + 1024 + hh * 128 + 2 * kp);
      lb0 = fast_rcp(1.f + fast_exp(l1[0] - l0[0])); lb1 = fast_rcp(1.f + fast_exp(l1[1] - l0[1]));
    }
    const f32x2 lbv = {lb0, lb1}, olb = {1.f - lb0, 1.f - lb1};
    f32x2 Ev[8], Iv[8], Kv[8];
    {
      f32x2 P = {1.f, 1.f}, Q = {1.f, 1.f};
#pragma unroll
      for (int j = 0; j < 8; ++j) {
        const float x0 = __builtin_amdgcn_fmed3f(bf_lo(R.rf[j]), -30.f, 30.f), x1 = __builtin_amdgcn_fmed3f(bf_hi(R.rf[j]), -30.f, 30.f);
        const f32x2 e = {__builtin_amdgcn_exp2f(x0 * -1.4426950408889634f), __builtin_amdgcn_exp2f(x1 * -1.4426950408889634f)};
        const f32x2 a1 = e + 1.f, a2 = lbv * e + 1.f, pr = a1 * a2;
        const f32x2 w = {fast_rcp(pr[0]), fast_rcp(pr[1])};
        const f32x2 r = w * a2;
        Kv[j] = olb * e * r;
        P = P * (a2 * r); Q = Q * (a1 * a1 * w);
        Ev[j] = P; Iv[j] = Q;
      }
      segp[seg * 64 + kp] = (f32x4){P[0], P[1], Q[0], Q[1]};
    }
    __syncthreads();
    {
      f32x2 pre = {1.f, 1.f}, pin = {1.f, 1.f}, tot = {1.f, 1.f};
#pragma unroll
      for (int s2 = 0; s2 < 8; ++s2) {
        const f32x4 v = segp[s2 * 64 + kp];
        const f32x2 vp = {v[0], v[1]}, vq = {v[2], v[3]};
        if (s2 < seg) { pre = pre * vp; pin = pin * vq; }
        tot = tot * vp;
      }
      f32x2 ko[8];
#pragma unroll
      for (int j = 0; j < 8; ++j) {
        const f32x2 Ea = pre * Ev[j], ia = pin * Iv[j];
        const f32x2 qv = {bf_lo(R.rq[j]), bf_hi(R.rq[j])};
        const f32x2 qd2 = qv * Ea, ki = Kv[j] * ia;
        ko[j] = ki * tot;
        const unsigned qd = pk_bf16(qd2[0], qd2[1]);
        *(unsigned*)(QD + (8 * seg + j) * 136 + 2 * kp) = qd;
        if (p.st_a) *(unsigned*)(proj + PB_RQ + (tok0 + 8 * seg + j) * 1024 + hh * 128 + 2 * kp) = qd;
        *(unsigned*)(KI + (8 * seg + j) * 136 + 2 * kp) = pk_bf16(ki[0], ki[1]);
      }
      *(bf16x8*)(KoT + (2 * kp) * 72 + 8 * seg) = pack8(ko[0][0], ko[1][0], ko[2][0], ko[3][0], ko[4][0], ko[5][0], ko[6][0], ko[7][0]);
      *(bf16x8*)(KoT + (2 * kp + 1) * 72 + 8 * seg) = pack8(ko[0][1], ko[1][1], ko[2][1], ko[3][1], ko[4][1], ko[5][1], ko[6][1], ko[7][1]);
      if (seg == 0 && p.st_a) { *(f32x2*)(DL + (size_t)u * 128 + 2 * kp) = tot; }
    }
    if (u + (int)gridDim.x < 4096) hgrn_chunk_load(R, proj, u + gridDim.x, seg, kp);
    __syncthreads();
    {
      const int ti = wave >> 1;
#pragma unroll
      for (int uu = 0; uu < 2; ++uu) {
        const int si = 2 * (wave & 1) + uu;
        f32x4 acc = {0.f, 0.f, 0.f, 0.f};
        if (si <= ti) {
#pragma unroll
          for (int ks = 0; ks < 4; ++ks) {
            const bf16x8 a = *(const bf16x8*)(QD + (16 * ti + c16) * 136 + 32 * ks + 8 * q4);
            const bf16x8 bb = *(const bf16x8*)(KI + (16 * si + c16) * 136 + 32 * ks + 8 * q4);
            acc = MFMA16(a, bb, acc);
          }
        }
#pragma unroll
        for (int j = 0; j < 4; ++j) {
          const int t = 16 * ti + 4 * q4 + j, s = 16 * si + c16;
          const float v = (s <= t) ? acc[j] : 0.f;
          Am[t * 72 + s] = (bf16_t)(pk_bf16(v, 0.f) & 0xffffu);
        }
      }
    }
    __syncthreads();
    {
#pragma unroll
      for (int i = 0; i < 2; ++i) {
        const int idx = tid + 512 * i, k = idx >> 3, t8 = (idx & 7) * 8;
        const u32x4 w = *(const u32x4*)(KoT + k * 72 + t8);
        if (p.st_a) *(u32x4*)(proj + PB_RF + (tok0 + (k >> 1)) * 1024 + hh * 128 + (k & 1) * 64 + t8) = w;
      }
      const int t = tid >> 3, s8 = (tid & 7) * 8;
      const u32x4 w = *(const u32x4*)(Am + t * 72 + s8);
      if (p.st_a) *(u32x4*)(Hb + ((size_t)u * 64 + t) * 64 + s8) = w;
    }
  }
  __syncthreads();
}

struct ScanRegs { u32x4 qd[2]; u32x4 ko[2]; u32x4 am; unsigned rv[8]; };
DI void hgrn_scan_load(ScanRegs& R, const Params& p, int b, int hh, int c, int tid) {
  const bf16_t* proj = (const bf16_t*)(p.ws + WS_PROJ);
  const bf16_t* Hb = (const bf16_t*)(p.ws + WS_H);
  const int lane = tid & 63, wave = tid >> 6;
  const size_t tok0 = (size_t)b * SEQ + c * 64;
  const size_t u = (size_t)(b * 32 + c) * 8 + hh;
#pragma unroll
  for (int i = 0; i < 2; ++i) {
    const int idx = tid + 512 * i;
    R.qd[i] = *(const u32x4*)(proj + PB_RQ + (tok0 + (idx >> 4)) * 1024 + hh * 128 + (idx & 15) * 8);
    const int k = idx >> 3, t8 = (idx & 7) * 8;
    R.ko[i] = *(const u32x4*)(proj + PB_RF + (tok0 + (k >> 1)) * 1024 + hh * 128 + (k & 1) * 64 + t8);
  }
  R.am = *(const u32x4*)(Hb + (u * 64 + (tid >> 3)) * 64 + (tid & 7) * 8);
#pragma unroll
  for (int j = 0; j < 8; ++j) R.rv[j] = *(const unsigned*)(proj + PB_RI + (tok0 + 8 * wave + j) * 1024 + hh * 128 + 2 * lane);
}
DI void hgrn_scan_unit(const Params& p, char* smem, int unit) {
  const int hh = unit & 7, b = unit >> 3;
  bf16_t* proj = (bf16_t*)(p.ws + WS_PROJ);
  bf16_t* QD = (bf16_t*)smem;
  bf16_t* KoT = (bf16_t*)(smem + 17408);
  bf16_t* VT = (bf16_t*)(smem + 35840);
  bf16_t* Am = (bf16_t*)(smem + 54272);
  float* dla = (float*)(smem + 97792);
  float* Ob = (float*)(smem + 64000);
  const int tid = opaque_tid(), lane = tid & 63, wave = tid >> 6;
  const int c16 = lane & 15, q4 = lane >> 4;
  const int ft = tid >> 3, fv = (tid & 7) * 16;
  const int vcol = 16 * wave + c16;
  f32x4 S[8];
#pragma unroll
  for (int i = 0; i < 8; ++i) S[i] = (f32x4){0.f, 0.f, 0.f, 0.f};
  ScanRegs R0, R1;
  hgrn_scan_load(R0, p, b, hh, 0, tid);
  hgrn_scan_load(R1, p, b, hh, 1, tid);
  {
    const float* DL = (const float*)(p.ws + WS_DL);
#pragma unroll
    for (int i = 0; i < 2; ++i) { const int idx = tid + 512 * i, c = idx >> 5, k4 = (idx & 31) * 4; *(f32x4*)(dla + c * 128 + k4) = *(const f32x4*)(DL + ((size_t)(b * 32 + c) * 8 + hh) * 128 + k4); }
  }
  auto body = [&](const int c, ScanRegs& C) __attribute__((always_inline)) {
    const size_t tok0 = (size_t)b * SEQ + c * 64;
#pragma unroll
    for (int i = 0; i < 2; ++i) {
      const int idx = tid + 512 * i;
      *(u32x4*)(QD + (idx >> 4) * 136 + (idx & 15) * 8) = C.qd[i];
      *(u32x4*)(KoT + (idx >> 3) * 72 + (idx & 7) * 8) = C.ko[i];
    }
    *(u32x4*)(Am + (tid >> 3) * 72 + (tid & 7) * 8) = C.am;
    {
      u32x4 wl, wh;
#pragma unroll
      for (int i = 0; i < 4; ++i) { wl[i] = (C.rv[2 * i] & 0xffffu) | (C.rv[2 * i + 1] << 16); wh[i] = (C.rv[2 * i] >> 16) | (C.rv[2 * i + 1] & 0xffff0000u); }
      *(u32x4*)(VT + (2 * lane) * 72 + 8 * wave) = wl;
      *(u32x4*)(VT + (2 * lane + 1) * 72 + 8 * wave) = wh;
    }
    if (c + 2 < 32) hgrn_scan_load(C, p, b, hh, c + 2, tid);
    const float* dl = dla + c * 128;
    u32x4 rg[2];
    __syncthreads();
    {
      bf16x8 bv[2];
#pragma unroll
      for (int ks = 0; ks < 2; ++ks) bv[ks] = *(const bf16x8*)(VT + vcol * 72 + 32 * ks + 8 * q4);
#pragma unroll
      for (int th = 0; th < 2; ++th) {
        f32x4 o[2];
#pragma unroll
        for (int i = 0; i < 2; ++i) o[i] = (f32x4){0.f, 0.f, 0.f, 0.f};
#pragma unroll
        for (int kq = 0; kq < 4; ++kq) {
          const bf16x8 sf = pack8(S[2 * kq][0], S[2 * kq][1], S[2 * kq][2], S[2 * kq][3], S[2 * kq + 1][0], S[2 * kq + 1][1], S[2 * kq + 1][2], S[2 * kq + 1][3]);
#pragma unroll
          for (int t2 = 0; t2 < 2; ++t2) {
            const int ti = 2 * th + t2;
            const bf16_t* ap = QD + (16 * ti + c16) * 136 + 32 * kq + 4 * q4;
            const u32x2 lo = *(const u32x2*)ap, hi = *(const u32x2*)(ap + 16);
            const u32x4 av = {lo[0], lo[1], hi[0], hi[1]};
            o[t2] = MFMA16(__builtin_bit_cast(bf16x8, av), sf, o[t2]);
          }
        }
#pragma unroll
        for (int t2 = 0; t2 < 2; ++t2)
#pragma unroll
          for (int ks = 0; ks < 2; ++ks) {
            const bf16x8 a = *(const bf16x8*)(Am + (16 * (2 * th + t2) + c16) * 72 + 32 * ks + 8 * q4);
            o[t2] = MFMA16(a, bv[ks], o[t2]);
          }
#pragma unroll
        for (int t2 = 0; t2 < 2; ++t2)
#pragma unroll
          for (int j = 0; j < 4; ++j) Ob[(16 * (2 * th + t2) + 4 * q4 + j) * 132 + vcol] = o[t2][j];
        __builtin_amdgcn_sched_barrier(0);
      }
      {
        const bf16_t* gq = proj + PB_RG + (tok0 + ft) * 1024 + hh * 128 + fv;
        rg[0] = *(const u32x4*)gq; rg[1] = *(const u32x4*)(gq + 8);
      }
#pragma unroll
      for (int kt = 0; kt < 8; ++kt) {
        const f32x4 d = *(const f32x4*)(dl + 16 * kt + 4 * q4);
        S[kt] = S[kt] * d;
#pragma unroll
        for (int ks = 0; ks < 2; ++ks) {
          const bf16x8 a = *(const bf16x8*)(KoT + (16 * kt + c16) * 72 + 32 * ks + 8 * q4);
          S[kt] = MFMA16(a, bv[ks], S[kt]);
        }
        if (kt & 1) __builtin_amdgcn_sched_barrier(0);
      }
    }
    __syncthreads();
    {
      f32x4 ov[4]; float ss = 0.f;
#pragma unroll
      for (int i = 0; i < 4; ++i) { ov[i] = *(const f32x4*)(Ob + ft * 132 + fv + 4 * i); ss += ov[i][0] * ov[i][0] + ov[i][1] * ov[i][1] + ov[i][2] * ov[i][2] + ov[i][3] * ov[i][3]; }
      ss += __shfl_xor(ss, 1); ss += __shfl_xor(ss, 2); ss += __shfl_xor(ss, 4);
      const float rstd = rsqrtf(ss * (1.0f / 128.0f) + EPS);
      float y[16];
#pragma unroll
      for (int i = 0; i < 4; ++i) {
        const f32x4 w = *(const f32x4*)(p.rec_norm_w + fv + 4 * i);
        const unsigned ga = (i < 2) ? rg[0][2 * i] : rg[1][2 * (i - 2)], gb = (i < 2) ? rg[0][2 * i + 1] : rg[1][2 * (i - 2) + 1];
        y[4 * i + 0] = ov[i][0] * rstd * w[0] * bf_lo(ga);
        y[4 * i + 1] = ov[i][1] * rstd * w[1] * bf_hi(ga);
        y[4 * i + 2] = ov[i][2] * rstd * w[2] * bf_lo(gb);
        y[4 * i + 3] = ov[i][3] * rstd * w[3] * bf_hi(gb);
      }
      bf16_t* gp = proj + PB_RG + (tok0 + ft) * 1024 + hh * 128 + fv;
      if (p.st_m) {
      *(bf16x8*)gp = pack8(y[0], y[1], y[2], y[3], y[4], y[5], y[6], y[7]);
      *(bf16x8*)(gp + 8) = pack8(y[8], y[9], y[10], y[11], y[12], y[13], y[14], y[15]);
      }
    }
  };
#pragma unroll 1
  for (int c = 0; c < 32; c += 2) { body(c, R0); body(c + 1, R1); }
  __syncthreads();
}

DI void phase_mix(const Params& p, char* smem) {
  int* s_item = (int*)(smem + 131072);
  unsigned* ctr = (unsigned*)(p.ws + WS_CTRL) + CW_WORK;
  while (true) {
    if (threadIdx.x == 0) *s_item = (int)atomicAdd(ctr, 1u);
    __syncthreads();
    const int item = *s_item;
    __syncthreads();
    if (item >= 128 + 1024) break;
    if (item < 128) hgrn_scan_unit(p, smem, item); else attn_unit(p, smem, item - 128);
  }
}

DI void phase_gemm1(const Params& p, char* smem) {
  EpiProj e{(bf16_t*)(p.ws + WS_PROJ)};
  gemm_phase<D_MODEL, (1 << 30), 0, NTOK, IN_W, D_MODEL>((LAS unsigned char*)smem, (const bf16_t*)(p.ws + WS_H), (const bf16_t*)(p.ws + WS_WTIN), e);
}
DI void phase_gemm2(const Params& p, char* smem) {
  EpiOut e{p.out, p.x, (const float*)(p.ws + WS_MOD)};
  gemm_phase<1024, 16, (int)(PB_RG - PB_AG) - 1024, NTOK, D_MODEL, D_MIX>((LAS unsigned char*)smem, (const bf16_t*)(p.ws + WS_PROJ) + PB_AG, (const bf16_t*)(p.ws + WS_WTOUT), e);
}

extern __shared__ __attribute__((aligned(16))) char dyn_smem[];

#if ONE_LAUNCH
__global__ void __launch_bounds__(NTHREADS, 2) hymba_fwd(Params p) {
  cg::grid_group grid = cg::this_grid();
  volatile LAS unsigned* st = (volatile LAS unsigned*)((LAS unsigned char*)dyn_smem + 131072 + 16);
  if (threadIdx.x == 0) { st[0] = 0u; st[1] = 0u; }
  __syncthreads();
  const XcdBarrier xb = xcd_barrier_post((unsigned*)(p.ws + WS_XBAR), st);
  phase_prep(p, dyn_smem);
  phase_norm(p, dyn_smem);
  if (p.ws == nullptr) grid.sync();
  xcd_barrier(xb);
  phase_gemm1(p, dyn_smem);
  xcd_barrier(xb);
  phase_hgrn_chunk(p, dyn_smem);
  xcd_barrier(xb);
  phase_mix(p, dyn_smem);
  xcd_barrier(xb);
  phase_gemm2(p, dyn_smem);
}
#else
__global__ void __launch_bounds__(NTHREADS, 2) k_prep(Params p) { phase_prep(p, dyn_smem); }
__global__ void __launch_bounds__(NTHREADS, 2) k_norm(Params p) { phase_norm(p, dyn_smem); }
__global__ void __launch_bounds__(NTHREADS, 2) k_gemm1(Params p) { phase_gemm1(p, dyn_smem); }
__global__ void __launch_bounds__(NTHREADS, 2) k_hgrna(Params p) { phase_hgrn_chunk(p, dyn_smem); }
__global__ void __launch_bounds__(NTHREADS, 2) k_mix(Params p) { phase_mix(p, dyn_smem); }
__global__ void __launch_bounds__(NTHREADS, 2) k_gemm2(Params p) { phase_gemm2(p, dyn_smem); }
#endif

extern "C" void kernel_launch(void* const* d_in, const int* in_sizes, int n_in, void* d_out, int out_size, void* d_ws, size_t ws_size, hipStream_t stream) {
  static int grid = 0;
  if (grid == 0) {
    if (n_in != 13 || ws_size < WS_END) { fprintf(stderr, "kernel_launch: unexpected n_in %d or workspace %zu < %zu\n", n_in, ws_size, (size_t)WS_END); grid = -1; return; }
    int dev = 0, cus = 0, per_cu = 0;
    hipGetDevice(&dev);
    hipDeviceGetAttribute(&cus, hipDeviceAttributeMultiprocessorCount, dev);
#if ONE_LAUNCH
    if (hipFuncSetAttribute((const void*)hymba_fwd, hipFuncAttributeMaxDynamicSharedMemorySize, LDS_BYTES) != hipSuccess) { fprintf(stderr, "hipFuncSetAttribute failed\n"); grid = -1; return; }
    hipOccupancyMaxActiveBlocksPerMultiprocessor(&per_cu, (const void*)hymba_fwd, NTHREADS, LDS_BYTES);
    if (per_cu < 1) { fprintf(stderr, "occupancy query says %d blocks per CU\n", per_cu); per_cu = 1; }
    grid = cus * per_cu;
#else
    hipFuncSetAttribute((const void*)k_prep, hipFuncAttributeMaxDynamicSharedMemorySize, LDS_BYTES);
    hipFuncSetAttribute((const void*)k_gemm1, hipFuncAttributeMaxDynamicSharedMemorySize, LDS_BYTES);
    hipFuncSetAttribute((const void*)k_mix, hipFuncAttributeMaxDynamicSharedMemorySize, LDS_BYTES);
    hipFuncSetAttribute((const void*)k_hgrna, hipFuncAttributeMaxDynamicSharedMemorySize, LDS_BYTES);
    hipFuncSetAttribute((const void*)k_gemm2, hipFuncAttributeMaxDynamicSharedMemorySize, LDS_BYTES);
    (void)per_cu;
    grid = cus;
#endif
    (void)hipGetLastError();
  }
  if (grid < 0) return;
  (void)hipMemsetAsync((char*)d_ws + WS_CTRL, 0, 16384, stream);
  Params p{};
  p.x = (const float*)d_in[0]; p.c = (const float*)d_in[1]; p.pos = (const int*)d_in[2]; p.norm_w = (const float*)d_in[3];
  p.w_ada = (const float*)d_in[4]; p.b_ada = (const float*)d_in[5]; p.w_in = (const float*)d_in[6]; p.q_norm_w = (const float*)d_in[7];
  p.k_norm_w = (const float*)d_in[8]; p.sinks = (const float*)d_in[9]; p.rec_norm_w = (const float*)d_in[10];
  p.lower_bounds = (const float*)d_in[11]; p.w_out = (const float*)d_in[12]; p.out = (float*)d_out; p.ws = (char*)d_ws; p.st_a = 1; p.st_m = 1;
#if ONE_LAUNCH
  void* args[] = {&p};
  hipError_t e = hipLaunchCooperativeKernel((const void*)hymba_fwd, dim3(grid), dim3(NTHREADS), args, LDS_BYTES, stream);
  if (e != hipSuccess) fprintf(stderr, "cooperative launch failed: %s (grid %d)\n", hipGetErrorString(e), grid);
#else
  for (int r = 0; r < REP_PREP; ++r) hipLaunchKernelGGL(k_prep, dim3(grid), dim3(NTHREADS), LDS_BYTES, stream, p);
  for (int r = 0; r < REP_NORM; ++r) hipLaunchKernelGGL(k_norm, dim3(grid), dim3(NTHREADS), 16384, stream, p);
  for (int r = 0; r < REP_G1; ++r) hipLaunchKernelGGL(k_gemm1, dim3(grid), dim3(NTHREADS), LDS_BYTES, stream, p);
  for (int r = 0; r < REP_A; ++r) { p.st_a = (r == REP_A - 1); hipLaunchKernelGGL(k_hgrna, dim3(grid), dim3(NTHREADS), LDS_BYTES, stream, p); }
  for (int r = 0; r < REP_M; ++r) { p.st_m = (r == REP_M - 1); (void)hipMemsetAsync((char*)d_ws + WS_CTRL, 0, 16384, stream); hipLaunchKernelGGL(k_mix, dim3(grid), dim3(NTHREADS), LDS_BYTES, stream, p); }
  for (int r = 0; r < REP_G2; ++r) hipLaunchKernelGGL(k_gemm2, dim3(grid), dim3(NTHREADS), LDS_BYTES, stream, p);
#endif
}
```

```cpp
#include <hip/hip_runtime.h>
#include <hip/hip_cooperative_groups.h>
#include <cstdio>
#include <cstdint>
namespace cg = cooperative_groups;

#ifndef ONE_LAUNCH
#define ONE_LAUNCH 1
#endif

#define REP_PREP 1
#define REP_NORM 1
#define REP_G1 1
#define REP_G2 1
#define REP_A 1
#define REP_M 1
#define DI __device__ __forceinline__
typedef unsigned short bf16_t;
typedef short bf16x8 __attribute__((ext_vector_type(8)));
typedef float f32x4 __attribute__((ext_vector_type(4)));
typedef float f32x2 __attribute__((ext_vector_type(2)));
typedef float f32x16 __attribute__((ext_vector_type(16)));
typedef unsigned u32x4 __attribute__((ext_vector_type(4)));
typedef unsigned u32x2 __attribute__((ext_vector_type(2)));
typedef __bf16 bf16x2_t __attribute__((ext_vector_type(2)));

constexpr int D_MODEL = 1024, BATCH = 16, SEQ = 2048, NTOK = BATCH * SEQ, IN_W = 6656, D_MIX = 2048;
constexpr int OFF_AQ = 0, OFF_AK = 1024, OFF_AV = 1280, OFF_AG = 1536, OFF_RQ = 2560, OFF_RF = 3584, OFF_RI = 4608, OFF_RG = 5632;
constexpr size_t PB_AQ = 0, PB_AK = PB_AQ + (size_t)NTOK * 1024, PB_AV = PB_AK + (size_t)NTOK * 256, PB_AG = PB_AV + (size_t)NTOK * 256,
                 PB_RQ = PB_AG + (size_t)NTOK * 1024, PB_RF = PB_RQ + (size_t)NTOK * 1024, PB_RI = PB_RF + (size_t)NTOK * 1024, PB_RG = PB_RI + (size_t)NTOK * 1024;
constexpr float EPS = 1e-6f;
constexpr int NTHREADS = 512;
constexpr int LDS_BYTES = 131072 + 256;

constexpr size_t MiB = 1024 * 1024;
constexpr size_t WS_CTRL = 0, WS_XBAR = 2048, WS_MOD = 16384, WS_ROPE = 1 * MiB, WS_WTIN = 9 * MiB, WS_WTOUT = 22 * MiB, WS_H = 26 * MiB, WS_PROJ = 90 * MiB, WS_DL = 506 * MiB,
                 WS_END = WS_DL + 2 * MiB;

struct Params {
  const float* x; const float* c; const int* pos; const float* norm_w; const float* w_ada; const float* b_ada;
  const float* w_in; const float* q_norm_w; const float* k_norm_w; const float* sinks; const float* rec_norm_w;
  const float* lower_bounds; const float* w_out; float* out; char* ws; int st_a; int st_m;
};

DI int opaque_tid() { int t = threadIdx.x; asm volatile("" : "+v"(t)); return t; }
DI unsigned pk_bf16(float lo, float hi) { f32x2 v = {lo, hi}; bf16x2_t b = __builtin_convertvector(v, bf16x2_t); return __builtin_bit_cast(unsigned, b); }
DI float bf_lo(unsigned u) { return __uint_as_float(u << 16); }
DI float bf_hi(unsigned u) { return __uint_as_float(u & 0xffff0000u); }
DI bf16x8 pack8(float a0, float a1, float a2, float a3, float a4, float a5, float a6, float a7) {
  u32x4 w = {pk_bf16(a0, a1), pk_bf16(a2, a3), pk_bf16(a4, a5), pk_bf16(a6, a7)}; return __builtin_bit_cast(bf16x8, w);
}
DI float fast_exp(float x) { return __builtin_amdgcn_exp2f(x * 1.4426950408889634f); }
DI float fast_rcp(float x) { return __builtin_amdgcn_rcpf(x); }
DI float silu(float x) { return x * fast_rcp(1.f + fast_exp(-x)); }
#define MFMA16(a, b, c) __builtin_amdgcn_mfma_f32_16x16x32_bf16((a), (b), (c), 0, 0, 0)
#define MFMA32(a, b, c) __builtin_amdgcn_mfma_f32_32x32x16_bf16((a), (b), (c), 0, 0, 0)

constexpr int CW_WORK = 0, CW_BAR1 = 64, CW_BAR2 = 128, CW_MOD = 192, CW_NORM = 320, CW_TR = 384;
#define XB_TMO      128
#define XB_XCNT(j)  (256  + 64 * (j))
#define XB_XSUB(j)  (1280 + 64 * (j))
#define XB_XGEN(j)  (2304 + 64 * (j))
#define XB_TOP      3328
#define XB_TOPGEN   3392
#define XCD_BAR_WORDS 3456
#define XB_SPIN_CAP (1u << 22)
#define LAS __attribute__((address_space(3)))
DI unsigned xb_ld(unsigned* p) { return __hip_atomic_load(p, __ATOMIC_RELAXED, __HIP_MEMORY_SCOPE_AGENT); }
DI unsigned xb_add(unsigned* p, unsigned v) { return __hip_atomic_fetch_add(p, v, __ATOMIC_RELAXED, __HIP_MEMORY_SCOPE_AGENT); }
DI unsigned xb_xcc_id() { return (unsigned)__builtin_amdgcn_s_getreg((3 << 11) | 20) & 0xFu; }
#define XB_SPIN(cond, bar) do { unsigned _sp = 0; while (cond) { __builtin_amdgcn_s_sleep(1); \
    if ((++_sp & 255u) == 0u) { if (xb_ld(&(bar)[XB_TMO])) break; if (_sp > XB_SPIN_CAP) { atomicAdd(&(bar)[XB_TMO], 1u); break; } } } } while (0)
struct XcdBarrier { unsigned* bar; unsigned x; volatile LAS unsigned* st; };
DI XcdBarrier xcd_barrier_post(unsigned* bar, volatile LAS unsigned* st) {
  XcdBarrier b; b.bar = bar; b.x = xb_xcc_id(); b.st = st;
  if (threadIdx.x == 0) (void)xb_add(&bar[XB_XCNT(b.x)], 1u);
  return b;
}
DI void xcd_barrier_complete(unsigned* bar, unsigned x, unsigned& nloc, unsigned& nx) {
  const unsigned G = gridDim.x;
  unsigned sum, cnt, mine, sp = 0u;
  for (;;) {
    sum = 0u; cnt = 0u; mine = 0u;
#pragma unroll
    for (unsigned j = 0; j < 16; ++j) { const unsigned c = xb_ld(&bar[XB_XCNT(j)]); sum += c; cnt += (c > 0u) ? 1u : 0u; mine = (j == x) ? c : mine; }
    if (sum == G) break;
    __builtin_amdgcn_s_sleep(1);
    if ((++sp & 255u) == 0u) { if (xb_ld(&bar[XB_TMO])) break; if (sp > XB_SPIN_CAP) { atomicAdd(&bar[XB_TMO], 1u); break; } }
  }
  nloc = mine > 0u ? mine : 1u; nx = cnt > 0u ? cnt : 1u;
}
DI void xcd_barrier(const XcdBarrier& b) {
  asm volatile("s_waitcnt vmcnt(0)" ::: "memory");
  __syncthreads();
  if (threadIdx.x == 0) {
    unsigned* bar = b.bar;
    __builtin_amdgcn_s_waitcnt(0);
    unsigned nloc = b.st[0], nx = b.st[1];
    if (nloc == 0u) { xcd_barrier_complete(bar, b.x, nloc, nx); b.st[0] = nloc; b.st[1] = nx; }
    const unsigned old = xb_add(&bar[XB_XSUB(b.x)], 1u);
    const unsigned gen = old / nloc;
    if (old + 1u == (gen + 1u) * nloc) {
      __builtin_amdgcn_fence(__ATOMIC_RELEASE, "agent");
      asm volatile("s_waitcnt vmcnt(0)" ::: "memory");
      const unsigned og = xb_add(&bar[XB_TOP], 1u);
      const unsigned tg = og / nx;
      if (og + 1u == (tg + 1u) * nx) xb_add(&bar[XB_TOPGEN], 1u);
      else XB_SPIN(xb_ld(&bar[XB_TOPGEN]) == tg, bar);
      __builtin_amdgcn_fence(__ATOMIC_ACQUIRE, "agent");
      xb_add(&bar[XB_XGEN(b.x)], 1u);
      asm volatile("s_waitcnt vmcnt(0)" ::: "memory");
    } else {
      XB_SPIN(xb_ld(&bar[XB_XGEN(b.x)]) == gen, bar);
      __builtin_amdgcn_fence(__ATOMIC_ACQUIRE, "agent");
      asm volatile("s_waitcnt vmcnt(0)" ::: "memory");
    }
  }
  __syncthreads();
}

DI void transpose_tile4(const float* __restrict__ W, int ldw, bf16_t* __restrict__ Wt, int ldt, int k0, int n0, float* tile, int tid) {
  f32x4 v[8];
#pragma unroll
  for (int pass = 0; pass < 8; ++pass) {
    const int r = (tid >> 4) + 32 * pass, c4 = (tid & 15) * 4;
    v[pass] = __builtin_nontemporal_load((const f32x4*)(W + (size_t)(k0 + r) * ldw + n0 + c4));
  }
#pragma unroll
  for (int pass = 0; pass < 8; ++pass) {
    const int r = (tid >> 4) + 32 * pass, c4 = (tid & 15) * 4;
    tile[r * 65 + c4 + 0] = v[pass][0]; tile[r * 65 + c4 + 1] = v[pass][1]; tile[r * 65 + c4 + 2] = v[pass][2]; tile[r * 65 + c4 + 3] = v[pass][3];
  }
  __syncthreads();
#pragma unroll
  for (int pass = 0; pass < 4; ++pass) {
    const int idx = tid + 512 * pass, nl = idx >> 5, kseg = (idx & 31) * 8;
    float x[8];
#pragma unroll
    for (int j = 0; j < 8; ++j) x[j] = tile[(kseg + j) * 65 + nl];
    const int c = nl & 31, rho = 16 * ((c >> 2) & 1) + 4 * (c >> 3) + (c & 3), nrow = n0 + (nl & 32) + rho;
    u32x4 w = {pk_bf16(x[0], x[1]), pk_bf16(x[2], x[3]), pk_bf16(x[4], x[5]), pk_bf16(x[6], x[7])};
    *(u32x4*)(Wt + (size_t)nrow * ldt + k0 + kseg) = w;
  }
  __syncthreads();
}

DI void phase_prep(const Params& p, char* smem) {
  const int tid = opaque_tid();
  float* rope = (float*)(p.ws + WS_ROPE);
  for (int i = blockIdx.x * NTHREADS + tid; i < NTOK * 32; i += gridDim.x * NTHREADS) {
    const int tok = i >> 5, f = i & 31;
    const float inv = exp2f(-(float)f * (13.287712379549449f / 32.0f));
    const float ang = (float)p.pos[tok] * inv;
    double t = (double)ang * 0.15915494309189535; t -= rint(t);
    const float r = (float)t;
    rope[(size_t)tok * 64 + f] = __builtin_amdgcn_cosf(r);
    rope[(size_t)tok * 64 + 32 + f] = __builtin_amdgcn_sinf(r);
  }
  float* mod = (float*)(p.ws + WS_MOD);
  bf16_t* wtin = (bf16_t*)(p.ws + WS_WTIN);
  bf16_t* wtout = (bf16_t*)(p.ws + WS_WTOUT);
  constexpr int J_MOD = 192, J_WIN = 4 * 104, J_WOUT = 8 * 16;
  for (int job = blockIdx.x; job < J_MOD; job += gridDim.x) {
      float* cact = (float*)smem;
      float* red = (float*)(smem + 65536);
      for (int i = tid; i < 16 * 256; i += NTHREADS) { const int b = i >> 8, k = (job / 48) * 256 + (i & 255); const float v = p.c[b * 1024 + k]; cact[b * 1024 + k] = silu(v); }
      __syncthreads();
      const int n = tid & 63, ks = tid >> 6, n0 = (job % 48) * 64, ksp = job / 48;
      float acc[16];
#pragma unroll
      for (int b = 0; b < 16; ++b) acc[b] = 0.f;
#pragma unroll 1
      for (int k = ksp * 256 + ks * 32; k < ksp * 256 + ks * 32 + 32; k += 16) {
        float w[16];
#pragma unroll
        for (int u = 0; u < 16; ++u) w[u] = __builtin_nontemporal_load(p.w_ada + (size_t)(k + u) * 3072 + n0 + n);
#pragma unroll
        for (int u = 0; u < 16; ++u)
#pragma unroll
          for (int b = 0; b < 16; ++b) acc[b] += cact[b * 1024 + k + u] * w[u];
      }
#pragma unroll
      for (int b = 0; b < 16; ++b) red[(ks * 16 + b) * 64 + n] = acc[b];
      __syncthreads();
      for (int o = tid; o < 1024; o += NTHREADS) {
        const int b = o >> 6, nn = o & 63; float sacc = (ksp == 0) ? p.b_ada[n0 + nn] : 0.f;
#pragma unroll
        for (int k2 = 0; k2 < 8; ++k2) sacc += red[(k2 * 16 + b) * 64 + nn];
        mod[(ksp * 16 + b) * 3072 + n0 + nn] = sacc;
      }
      asm volatile("s_waitcnt vmcnt(0)" ::: "memory");
      __syncthreads();
      if (tid == 0) __hip_atomic_fetch_add((unsigned*)(p.ws + WS_CTRL) + CW_MOD, 1u, __ATOMIC_RELEASE, __HIP_MEMORY_SCOPE_AGENT);
  }
}
DI void prep_transpose_job(const Params& p, char* smem, int j, int tid) {
  constexpr int J_WIN = 4 * 104;
  bf16_t* wtin = (bf16_t*)(p.ws + WS_WTIN);
  bf16_t* wtout = (bf16_t*)(p.ws + WS_WTOUT);
  if (j < J_WIN) { const int kt = j & 3, nt = j >> 2; transpose_tile4(p.w_in, IN_W, wtin, D_MODEL, kt * 256, nt * 64, (float*)smem, tid); }
  else { const int j2 = j - J_WIN, kt = j2 & 7, nt = j2 >> 3; transpose_tile4(p.w_out, D_MODEL, wtout, D_MIX, kt * 256, nt * 64, (float*)smem, tid); }
}

DI void phase_norm(const Params& p, char* smem) {
  const int tid = opaque_tid(), lane = tid & 63, wave = tid >> 6;
  const float* mod = (const float*)(p.ws + WS_MOD);
  bf16_t* H = (bf16_t*)(p.ws + WS_H);
  float* sc1 = (float*)(smem + 69632);
  float* shv = (float*)(smem + 69632 + 4096);
  int* s_item = (int*)(smem + 131072);
  unsigned* nctr = (unsigned*)(p.ws + WS_CTRL) + CW_NORM;
  unsigned* tctr = (unsigned*)(p.ws + WS_CTRL) + CW_TR;
  int bprev = -1;
  bool tr_left = true, nm_left = true, mod_ok = false;
  for (int step = 0; tr_left || nm_left; ++step) {
    const bool do_tr = tr_left && ((step % 3) == 0 || !nm_left);
    if (tid == 0) *s_item = do_tr ? (int)atomicAdd(tctr, 1u) : (int)atomicAdd(nctr, 1u);
    __syncthreads();
    const int g = *s_item;
    __syncthreads();
    if (do_tr) {
      if (g >= 4 * 104 + 8 * 16) tr_left = false; else prep_transpose_job(p, smem, g, tid);
      continue;
    }
    if (g >= NTOK / 64) { nm_left = false; continue; }
    if (!mod_ok) {
      if (tid == 0) { const unsigned* mc = (const unsigned*)(p.ws + WS_CTRL) + CW_MOD; while (__hip_atomic_load(mc, __ATOMIC_ACQUIRE, __HIP_MEMORY_SCOPE_AGENT) < 192u) __builtin_amdgcn_s_sleep(1); }
      __syncthreads();
      mod_ok = true;
    }
    const int b = g >> 5;
    if (b != bprev) {
      for (int col = tid; col < 1024; col += NTHREADS) {
        float sh = 0.f, sc = 0.f;
#pragma unroll
        for (int k2 = 0; k2 < 4; ++k2) { sh += mod[(k2 * 16 + b) * 3072 + col]; sc += mod[(k2 * 16 + b) * 3072 + 1024 + col]; }
        sc1[col] = p.norm_w[col] * (1.f + sc); shv[col] = sh;
      }
      bprev = b;
      __syncthreads();
    }
#pragma unroll 1
    for (int it = 0; it < 4; ++it) {
      const int row0 = g * 64 + wave * 8 + it * 2;
      f32x4 v[2][4]; float ss[2] = {0.f, 0.f};
#pragma unroll
      for (int rr = 0; rr < 2; ++rr) {
        const f32x4* xr = (const f32x4*)(p.x + (size_t)(row0 + rr) * D_MODEL);
#pragma unroll
        for (int i = 0; i < 4; ++i) v[rr][i] = __builtin_nontemporal_load(xr + lane + 64 * i);
      }
#pragma unroll
      for (int rr = 0; rr < 2; ++rr) {
#pragma unroll
        for (int i = 0; i < 4; ++i) ss[rr] += v[rr][i][0] * v[rr][i][0] + v[rr][i][1] * v[rr][i][1] + v[rr][i][2] * v[rr][i][2] + v[rr][i][3] * v[rr][i][3];
#pragma unroll
        for (int o = 32; o >= 1; o >>= 1) ss[rr] += __shfl_xor(ss[rr], o);
        ss[rr] = rsqrtf(ss[rr] * (1.0f / D_MODEL) + EPS);
      }
#pragma unroll
      for (int i = 0; i < 4; ++i) {
        const int col = (lane + 64 * i) * 4;
        const f32x4 a = *(const f32x4*)(sc1 + col), sh = *(const f32x4*)(shv + col);
#pragma unroll
        for (int rr = 0; rr < 2; ++rr) {
          float h[4];
#pragma unroll
          for (int j = 0; j < 4; ++j) h[j] = v[rr][i][j] * ss[rr] * a[j] + sh[j];
          u32x2 w = {pk_bf16(h[0], h[1]), pk_bf16(h[2], h[3])};
          *(u32x2*)(H + (size_t)(row0 + rr) * D_MODEL + col) = w;
        }
      }
    }
  }
}

constexpr int BM = 256, BK = 64, HALF = 128, NXCD = 8, WGM = 8, HT = HALF * BK;
DI int lds_byte(int r, int c) { const int st = (r >> 4) * 2 + (c >> 5), rr = r & 15, cc = c & 31, ob = rr * 64 + cc * 2; return st * 1024 + (ob ^ (((ob >> 9) & 1) << 5)); }
DI void stage_rc(int b, int& R, int& C) { const int st = b / 1024, sb = b % 1024, swz = sb ^ (((sb >> 9) & 1) << 5); R = (st >> 1) * 16 + swz / 64; C = (st & 1) * 32 + (swz % 64) / 2; }

struct EpiProj {
  bf16_t* O;
  DI void operator()(const f32x4 (&acc)[2][2][4][2], int brow, int bcol, int wr, int wc, int fr, int fq) const {
    const bool gate_tile = (bcol >= OFF_AG && bcol < OFF_AG + 1024) || (bcol >= OFF_RG);
    size_t sbase; int sld, scol;
    if (bcol < OFF_AK) { sbase = PB_AQ; sld = 1024; scol = bcol - OFF_AQ; }
    else if (bcol < OFF_AV) { sbase = PB_AK; sld = 256; scol = bcol - OFF_AK; }
    else if (bcol < OFF_AG) { sbase = PB_AV; sld = 256; scol = bcol - OFF_AV; }
    else if (bcol < OFF_RQ) { sbase = PB_AG; sld = 1024; scol = bcol - OFF_AG; }
    else if (bcol < OFF_RF) { sbase = PB_RQ; sld = 1024; scol = bcol - OFF_RQ; }
    else if (bcol < OFF_RI) { sbase = PB_RF; sld = 1024; scol = bcol - OFF_RF; }
    else if (bcol < OFF_RG) { sbase = PB_RI; sld = 1024; scol = bcol - OFF_RI; }
    else { sbase = PB_RG; sld = 1024; scol = bcol - OFF_RG; }
#pragma unroll
    for (int ai = 0; ai < 2; ++ai)
#pragma unroll
      for (int m = 0; m < 4; ++m) {
        const int row = brow + ai * HALF + wr * 64 + m * 16 + fr;
        bf16_t* rp = O + sbase + (size_t)row * sld + scol + wc * 32 + 8 * fq;
#pragma unroll
        for (int bj = 0; bj < 2; ++bj) {
          f32x4 a0 = acc[ai][bj][m][0], a1 = acc[ai][bj][m][1];
          if (gate_tile) {
#pragma unroll
            for (int j = 0; j < 4; ++j) { a0[j] = silu(a0[j]); a1[j] = silu(a1[j]); }
          }
          u32x4 w = {pk_bf16(a0[0], a0[1]), pk_bf16(a0[2], a0[3]), pk_bf16(a1[0], a1[1]), pk_bf16(a1[2], a1[3])};
          __builtin_nontemporal_store(w, (u32x4*)(rp + bj * HALF));
        }
      }
  }
};
struct EpiOut {
  float* O; const float* X; const float* mod;
  DI void operator()(const f32x4 (&acc)[2][2][4][2], int brow, int bcol, int wr, int wc, int fr, int fq) const {
    const int b = brow >> 11;
    f32x4 g[2][2];
    {
      f32x4 gp[2][4][2];
#pragma unroll
      for (int bj = 0; bj < 2; ++bj)
#pragma unroll
        for (int k2 = 0; k2 < 4; ++k2) {
          const float* gq = mod + (k2 * 16 + b) * 3072 + 2048 + bcol + bj * HALF + wc * 32 + 8 * fq;
          gp[bj][k2][0] = *(const f32x4*)gq; gp[bj][k2][1] = *(const f32x4*)(gq + 4);
        }
#pragma unroll
      for (int bj = 0; bj < 2; ++bj) { g[bj][0] = (gp[bj][0][0] + gp[bj][1][0]) + (gp[bj][2][0] + gp[bj][3][0]); g[bj][1] = (gp[bj][0][1] + gp[bj][1][1]) + (gp[bj][2][1] + gp[bj][3][1]); }
    }
    f32x4 xb[2][4][2];
    auto ldb = [&](int q, f32x4 (&x)[4][2]) __attribute__((always_inline)) {
      const int bj = q >> 1, ai = q & 1, col = bcol + bj * HALF + wc * 32 + 8 * fq;
#pragma unroll
      for (int m = 0; m < 4; ++m) {
        const size_t o = (size_t)(brow + ai * HALF + wr * 64 + m * 16 + fr) * D_MODEL + col;
        x[m][0] = *(const f32x4*)(X + o); x[m][1] = *(const f32x4*)(X + o + 4);
      }
    };
    ldb(0, xb[0]);
#pragma unroll
    for (int q = 0; q < 4; ++q) {
      if (q + 1 < 4) ldb(q + 1, xb[(q + 1) & 1]);
      const int bj = q >> 1, ai = q & 1, col = bcol + bj * HALF + wc * 32 + 8 * fq;
#pragma unroll
      for (int m = 0; m < 4; ++m) {
        const size_t o = (size_t)(brow + ai * HALF + wr * 64 + m * 16 + fr) * D_MODEL + col;
        *(f32x4*)(O + o) = xb[q & 1][m][0] + g[bj][0] * acc[ai][bj][m][0];
        *(f32x4*)(O + o + 4) = xb[q & 1][m][1] + g[bj][1] * acc[ai][bj][m][1];
      }
    }
  }
};

template <int lda, int split_kt, int gap, int M, int N, int K, class Epi>
DI void gemm_phase(LAS unsigned char* lds, const bf16_t* __restrict__ A, const bf16_t* __restrict__ Bt, const Epi& epi) {
#define SA(b, h) (((b) * 2 + (h)) * (HT * 2))
#define SB(b, h) ((4 + (b) * 2 + (h)) * (HT * 2))
#define STAGE_A(P, br, kt) do { const char* _g = (const char*)(A + (size_t)(br) * lda + (kt) * BK + ((kt) >= split_kt ? gap : 0)); \
    _Pragma("unroll") for (int _i = 0; _i < 2; ++_i) { \
      __builtin_amdgcn_global_load_lds((const unsigned*)(_g + aoff[_i]), (LAS unsigned*)(lds + (P) + ldsw + _i * 8192), 16, 0, 0); } } while (0)
#define STAGE_B(P, br, kt) do { const char* _g = (const char*)(Bt + (size_t)(br) * K + (kt) * BK); \
    _Pragma("unroll") for (int _i = 0; _i < 2; ++_i) { \
      __builtin_amdgcn_global_load_lds((const unsigned*)(_g + boff[_i]), (LAS unsigned*)(lds + (P) + ldsw + _i * 8192), 16, 0, 0); } } while (0)
#define LDA(dst, b, h) _Pragma("unroll") for (int m = 0; m < 4; ++m) _Pragma("unroll") for (int k = 0; k < 2; ++k) \
    dst[m][k] = *(const LAS bf16x8*)(lds + SA(b, h) + ra + m * 2048 + k * 1024)
#define LDB(dst, b, h) _Pragma("unroll") for (int n = 0; n < 2; ++n) _Pragma("unroll") for (int k = 0; k < 2; ++k) \
    dst[n][k] = *(const LAS bf16x8*)(lds + SB(b, h) + rb + n * 2048 + k * 1024)
#define MMA(ai, bj, At, Bf) do { __builtin_amdgcn_s_setprio(1); \
    _Pragma("unroll") for (int m = 0; m < 4; ++m) _Pragma("unroll") for (int n = 0; n < 2; ++n) _Pragma("unroll") for (int k = 0; k < 2; ++k) \
      acc[ai][bj][m][n] = __builtin_amdgcn_mfma_f32_16x16x32_bf16(Bf[n][k], At[m][k], acc[ai][bj][m][n], 0, 0, 0); \
    __builtin_amdgcn_s_setprio(0); } while (0)
#define WAIT_V(n) asm volatile("s_waitcnt vmcnt(" #n ")" ::: "memory")
#define WAIT_L(n) asm volatile("s_waitcnt lgkmcnt(" #n ")" ::: "memory")
#define BAR __builtin_amdgcn_s_barrier()
#define SCHED __builtin_amdgcn_sched_barrier(0)
  const int nM = M / BM, nN = N / BM, nwg = nM * nN;
  const int gtid = opaque_tid();
  const int wid = __builtin_amdgcn_readfirstlane(gtid >> 6), lane = gtid & 63, wr = wid >> 2, wc = wid & 3, fr = lane & 15, fq = lane >> 4;
  constexpr int nt = K / BK;
  const unsigned ldsw = (unsigned)wid * 1024u;
  const int ra = lds_byte(wr * 64 + fr, fq * 8), rb = lds_byte(wc * 32 + fr, fq * 8);
  unsigned aoff[2], boff[2];
#pragma unroll
  for (int i = 0; i < 2; ++i) { int r_, c_; stage_rc(gtid * 16 + i * 8192, r_, c_); aoff[i] = (unsigned)(r_ * lda + c_) * 2u; boff[i] = (unsigned)(r_ * K + c_) * 2u; }
  auto decode = [&](int L, int& brow_, int& bcol_) __attribute__((always_inline)) {
    int wgid = L;
    { const int q = nwg / NXCD, r = nwg % NXCD, xcd = wgid % NXCD, off = wgid / NXCD; wgid = (xcd < r ? xcd * (q + 1) : r * (q + 1) + (xcd - r) * q) + off; }
    const int nig = WGM * nN, gid = wgid / nig, fm = gid * WGM, gsz = min(nM - fm, WGM);
    const int pm = fm + ((wgid % nig) % gsz), pn = (wgid % nig) / gsz; brow_ = pm * BM; bcol_ = pn * BM;
  };
  int L = blockIdx.x;
  if (L < nwg) {
    int brow, bcol; decode(L, brow, bcol);
    f32x4 acc[2][2][4][2];
#pragma unroll
    for (int a = 0; a < 2; ++a)
#pragma unroll
      for (int b = 0; b < 2; ++b)
#pragma unroll
        for (int m = 0; m < 4; ++m)
#pragma unroll
          for (int n = 0; n < 2; ++n) acc[a][b][m][n] = (f32x4){0.f, 0.f, 0.f, 0.f};
    bf16x8 At[4][2], B0[2][2], B1[2][2];
    STAGE_B(SB(0, 0), bcol, 0); STAGE_A(SA(0, 0), brow, 0);
    STAGE_B(SB(0, 1), bcol + HALF, 0); STAGE_A(SA(0, 1), brow + HALF, 0);
    if (wr == 1) BAR;
    WAIT_V(4); BAR;
    STAGE_B(SB(1, 0), bcol, 1); STAGE_A(SA(1, 0), brow, 1); STAGE_B(SB(1, 1), bcol + HALF, 1);
    WAIT_V(6); BAR;
#pragma unroll 1
    for (;;) {
      const int Ln = L + gridDim.x;
      int nrow = brow, ncol = bcol;
      if (Ln < nwg) decode(Ln, nrow, ncol);
#pragma unroll 1
      for (int t = 0; t < nt; t += 2) {
        const bool last = (t == nt - 2);
        const int r2 = last ? nrow : brow, c2 = last ? ncol : bcol, k2 = last ? 0 : t + 2, k3 = last ? 1 : t + 3;
        LDB(B0, 0, 0); SCHED; LDA(At, 0, 0); STAGE_A(SA(1, 1), brow + HALF, t + 1);
        WAIT_L(8); BAR; WAIT_L(0); MMA(0, 0, At, B0); BAR; SCHED;
        LDB(B1, 0, 1); STAGE_B(SB(0, 0), c2, k2);
        BAR; WAIT_L(0); MMA(0, 1, At, B1); BAR;
        LDA(At, 0, 1); STAGE_A(SA(0, 0), r2, k2);
        BAR; WAIT_L(0); MMA(1, 0, At, B0); BAR; SCHED;
        STAGE_B(SB(0, 1), c2 + HALF, k2);
        WAIT_V(6); BAR; MMA(1, 1, At, B1); BAR;
        LDB(B0, 1, 0); SCHED; LDA(At, 1, 0); STAGE_A(SA(0, 1), r2 + HALF, k2);
        WAIT_L(8); BAR; WAIT_L(0); MMA(0, 0, At, B0); BAR; SCHED;
        LDB(B1, 1, 1); STAGE_B(SB(1, 0), c2, k3);
        BAR; WAIT_L(0); MMA(0, 1, At, B1); BAR;
        LDA(At, 1, 1); STAGE_A(SA(1, 0), r2, k3);
        BAR; WAIT_L(0); MMA(1, 0, At, B0); BAR; SCHED;
        STAGE_B(SB(1, 1), c2 + HALF, k3);
        WAIT_V(6); BAR; MMA(1, 1, At, B1); BAR;
      }
      epi(acc, brow, bcol, wr, wc, fr, fq);
#pragma unroll
      for (int a = 0; a < 2; ++a)
#pragma unroll
        for (int b = 0; b < 2; ++b)
#pragma unroll
          for (int m = 0; m < 4; ++m)
#pragma unroll
            for (int n = 0; n < 2; ++n) acc[a][b][m][n] = (f32x4){0.f, 0.f, 0.f, 0.f};
      if (Ln >= nwg) break;
      L = Ln; brow = nrow; bcol = ncol;
    }
    WAIT_V(0);
    if (wr == 0) BAR;
  }
  __syncthreads();
#undef SA
#undef SB
}

DI void attn_unit(const Params& p, char* smem, int unit) {
  const int kvh = unit & 3, nb = (unit >> 2) & 15, b = unit >> 6;
  bf16_t* proj = (bf16_t*)(p.ws + WS_PROJ);
  const float* rope = (const float*)(p.ws + WS_ROPE);
  bf16_t* Ks = (bf16_t*)smem;
  bf16_t* Vt = (bf16_t*)(smem + 36864);
  const int tid = opaque_tid(), lane = tid & 63, wave = tid >> 6;
  {
    const int key = tid >> 1, half = tid & 1;
    const int tokl = nb * 128 - 128 + key;
    u32x4 o0 = {0, 0, 0, 0}, o1 = o0, o2 = o0, o3 = o0;
    u32x4 v0 = o0, v1 = o0, v2 = o0, v3 = o0;
    if (tokl >= 0) {
      const size_t tok = (size_t)b * SEQ + tokl;
      const bf16_t* kp = proj + PB_AK + tok * 256 + kvh * 64 + 16 * half;
      const u32x4 r0 = *(const u32x4*)kp, r1 = *(const u32x4*)(kp + 8), r2 = *(const u32x4*)(kp + 32), r3 = *(const u32x4*)(kp + 40);
      const bf16_t* vp = proj + PB_AV + tok * 256 + kvh * 64 + 32 * half;
      v0 = *(const u32x4*)vp; v1 = *(const u32x4*)(vp + 8); v2 = *(const u32x4*)(vp + 16); v3 = *(const u32x4*)(vp + 24);
      float x1[16], x2[16];
#pragma unroll
      for (int i = 0; i < 4; ++i) { x1[2 * i] = bf_lo(r0[i]); x1[2 * i + 1] = bf_hi(r0[i]); x1[8 + 2 * i] = bf_lo(r1[i]); x1[8 + 2 * i + 1] = bf_hi(r1[i]);
                                    x2[2 * i] = bf_lo(r2[i]); x2[2 * i + 1] = bf_hi(r2[i]); x2[8 + 2 * i] = bf_lo(r3[i]); x2[8 + 2 * i + 1] = bf_hi(r3[i]); }
      float ss = 0.f;
#pragma unroll
      for (int j = 0; j < 16; ++j) ss += x1[j] * x1[j] + x2[j] * x2[j];
      ss += __shfl_xor(ss, 1);
      const float rstd = rsqrtf(ss * (1.0f / 64.0f) + EPS);
      const float* cs = rope + tok * 64 + 16 * half;
      const float* kw = p.k_norm_w + 16 * half;
      float y1[16], y2[16];
#pragma unroll
      for (int j = 0; j < 16; ++j) {
        const float a1 = x1[j] * rstd * kw[j], a2 = x2[j] * rstd * kw[32 + j], c = cs[j], s = cs[32 + j];
        y1[j] = a1 * c - a2 * s; y2[j] = a2 * c + a1 * s;
      }
      o0 = (u32x4){pk_bf16(y1[0], y1[1]), pk_bf16(y1[2], y1[3]), pk_bf16(y1[4], y1[5]), pk_bf16(y1[6], y1[7])};
      o1 = (u32x4){pk_bf16(y1[8], y1[9]), pk_bf16(y1[10], y1[11]), pk_bf16(y1[12], y1[13]), pk_bf16(y1[14], y1[15])};
      o2 = (u32x4){pk_bf16(y2[0], y2[1]), pk_bf16(y2[2], y2[3]), pk_bf16(y2[4], y2[5]), pk_bf16(y2[6], y2[7])};
      o3 = (u32x4){pk_bf16(y2[8], y2[9]), pk_bf16(y2[10], y2[11]), pk_bf16(y2[12], y2[13]), pk_bf16(y2[14], y2[15])};
    }
    bf16_t* kd = Ks + key * 72 + 16 * half;
    *(u32x4*)kd = o0; *(u32x4*)(kd + 8) = o1; *(u32x4*)(kd + 32) = o2; *(u32x4*)(kd + 40) = o3;
    bf16_t* vd = Vt + (32 * half) * 260 + key;
#pragma unroll
    for (int i = 0; i < 4; ++i) {
      vd[(2 * i) * 260] = (bf16_t)(v0[i] & 0xffffu); vd[(2 * i + 1) * 260] = (bf16_t)(v0[i] >> 16);
      vd[(8 + 2 * i) * 260] = (bf16_t)(v1[i] & 0xffffu); vd[(8 + 2 * i + 1) * 260] = (bf16_t)(v1[i] >> 16);
      vd[(16 + 2 * i) * 260] = (bf16_t)(v2[i] & 0xffffu); vd[(16 + 2 * i + 1) * 260] = (bf16_t)(v2[i] >> 16);
      vd[(24 + 2 * i) * 260] = (bf16_t)(v3[i] & 0xffffu); vd[(24 + 2 * i + 1) * 260] = (bf16_t)(v3[i] >> 16);
    }
  }
  __syncthreads();
  const int r = lane & 31, h = lane >> 5;
  constexpr float LOG2E = 1.4426950408889634f;
#pragma unroll 1
  for (int it = 0; it < 2; ++it) {
    const int item = wave * 2 + it, g = item >> 2, qs = item & 3;
    const int head = kvh * 4 + g;
    const size_t tok = (size_t)b * SEQ + nb * 128 + qs * 32 + r;
    bf16x8 qf[4];
    u32x4 gr[4];
    bf16_t* gbase = proj + PB_AG + ((size_t)b * SEQ + nb * 128 + qs * 32 + (lane >> 3)) * 1024 + head * 64 + (lane & 7) * 8;
#pragma unroll
    for (int i = 0; i < 4; ++i) gr[i] = *(const u32x4*)(gbase + (size_t)(8 * i) * 1024);
    {
      const u32x4* qp = (const u32x4*)(proj + PB_AQ + tok * 1024 + head * 64 + 8 * h);
      float xq[4][8]; float ss = 0.f;
#pragma unroll
      for (int s = 0; s < 4; ++s) { const u32x4 rr = qp[2 * s];
#pragma unroll
        for (int i = 0; i < 4; ++i) { xq[s][2 * i] = bf_lo(rr[i]); xq[s][2 * i + 1] = bf_hi(rr[i]); } }
#pragma unroll
      for (int s = 0; s < 4; ++s)
#pragma unroll
        for (int j = 0; j < 8; ++j) ss += xq[s][j] * xq[s][j];
      ss += __shfl_xor(ss, 32);
      const float rstd = rsqrtf(ss * (1.0f / 64.0f) + EPS) * (0.125f * LOG2E);
      const float* cs = rope + tok * 64 + 8 * h;
      const float* qw = p.q_norm_w + 8 * h;
#pragma unroll
      for (int s = 0; s < 2; ++s) {
        float ya[8], yb[8];
#pragma unroll
        for (int j = 0; j < 8; ++j) {
          const float a1 = xq[s][j] * rstd * qw[16 * s + j], a2 = xq[s + 2][j] * rstd * qw[32 + 16 * s + j], c = cs[16 * s + j], sn = cs[32 + 16 * s + j];
          ya[j] = a1 * c - a2 * sn; yb[j] = a2 * c + a1 * sn;
        }
        qf[s] = pack8(ya[0], ya[1], ya[2], ya[3], ya[4], ya[5], ya[6], ya[7]);
        qf[s + 2] = pack8(yb[0], yb[1], yb[2], yb[3], yb[4], yb[5], yb[6], yb[7]);
      }
    }
    f32x16 sacc[5];
#pragma unroll
    for (int kt = 0; kt < 5; ++kt) {
#pragma unroll
      for (int i = 0; i < 16; ++i) sacc[kt][i] = 0.f;
#pragma unroll
      for (int s = 0; s < 4; ++s) {
        const bf16x8 a = *(const bf16x8*)(Ks + (qs * 32 + kt * 32 + r) * 72 + 16 * s + 8 * h);
        sacc[kt] = MFMA32(a, qf[s], sacc[kt]);
      }
    }
    const float sinkv = p.sinks[head] * LOG2E;
    float m = -INFINITY;
#pragma unroll
    for (int kt = 0; kt < 5; ++kt) {
      const bool tile_ok = (nb > 0) || (qs * 32 + kt * 32 >= 128);
#pragma unroll
      for (int i = 0; i < 16; ++i) {
        const int cr = (i & 3) + 8 * (i >> 2) + 4 * h;
        bool ok = tile_ok;
        if (kt == 0) ok = ok && (cr > r);
        if (kt == 4) ok = ok && (cr <= r);
        const float v = ok ? sacc[kt][i] : -INFINITY;
        sacc[kt][i] = v; m = fmaxf(m, v);
      }
    }
    m = fmaxf(m, __shfl_xor(m, 32)); m = fmaxf(m, sinkv);
    float l = 0.f;
#pragma unroll
    for (int kt = 0; kt < 5; ++kt)
#pragma unroll
      for (int i = 0; i < 16; ++i) { const float pv = __builtin_amdgcn_exp2f(sacc[kt][i] - m); sacc[kt][i] = pv; l += pv; }
    l += __shfl_xor(l, 32); l += __builtin_amdgcn_exp2f(sinkv - m);
    f32x16 oacc[2];
#pragma unroll
    for (int i = 0; i < 16; ++i) { oacc[0][i] = 0.f; oacc[1][i] = 0.f; }
#pragma unroll
    for (int kt = 0; kt < 5; ++kt)
#pragma unroll
      for (int s = 0; s < 2; ++s) {
        const bf16x8 pb = pack8(sacc[kt][8 * s], sacc[kt][8 * s + 1], sacc[kt][8 * s + 2], sacc[kt][8 * s + 3], sacc[kt][8 * s + 4], sacc[kt][8 * s + 5], sacc[kt][8 * s + 6], sacc[kt][8 * s + 7]);
#pragma unroll
        for (int ht = 0; ht < 2; ++ht) {
          const bf16_t* vp = Vt + (ht * 32 + r) * 260 + (qs * 32 + kt * 32 + 16 * s + 4 * h);
          const u32x2 lo = *(const u32x2*)vp, hi = *(const u32x2*)(vp + 8);
          const u32x4 av = {lo[0], lo[1], hi[0], hi[1]};
          oacc[ht] = MFMA32(__builtin_bit_cast(bf16x8, av), pb, oacc[ht]);
        }
      }
    const float inv = fast_rcp(l);
    bf16_t* Os = (bf16_t*)(smem + 70144) + wave * (32 * 72);
#pragma unroll
    for (int ht = 0; ht < 2; ++ht)
#pragma unroll
      for (int g4 = 0; g4 < 4; ++g4) {
        const u32x2 w = {pk_bf16(oacc[ht][4 * g4] * inv, oacc[ht][4 * g4 + 1] * inv), pk_bf16(oacc[ht][4 * g4 + 2] * inv, oacc[ht][4 * g4 + 3] * inv)};
        *(u32x2*)(Os + r * 72 + ht * 32 + 8 * g4 + 4 * h) = w;
      }
    __builtin_amdgcn_wave_barrier();
    asm volatile("s_waitcnt lgkmcnt(0)" ::: "memory");
#pragma unroll
    for (int i = 0; i < 4; ++i) {
      const u32x4 ov = *(const u32x4*)(Os + ((lane >> 3) + 8 * i) * 72 + (lane & 7) * 8);
      const u32x4 gv = gr[i];
      u32x4 w;
#pragma unroll
      for (int j = 0; j < 4; ++j) w[j] = pk_bf16(bf_lo(ov[j]) * bf_lo(gv[j]), bf_hi(ov[j]) * bf_hi(gv[j]));
      if (p.st_m) *(u32x4*)(gbase + (size_t)(8 * i) * 1024) = w;
    }
    __builtin_amdgcn_wave_barrier();
  }
  __syncthreads();
}

struct HgrnRegs { unsigned rq[8], rf[8]; };
DI void hgrn_chunk_load(HgrnRegs& R, const bf16_t* proj, int u, int seg, int kp) {
  const int hh = u & 7, c = (u >> 3) & 31, b = u >> 8;
  const size_t tok0 = (size_t)b * SEQ + c * 64;
#pragma unroll
  for (int j = 0; j < 8; ++j) {
    const bf16_t* base = proj + (tok0 + 8 * seg + j) * 1024 + hh * 128 + 2 * kp;
    R.rq[j] = __builtin_nontemporal_load((const unsigned*)(base + PB_RQ)); R.rf[j] = __builtin_nontemporal_load((const unsigned*)(base + PB_RF));
  }
}
DI void phase_hgrn_chunk(const Params& p, char* smem) {
  bf16_t* proj = (bf16_t*)(p.ws + WS_PROJ);
  bf16_t* Hb = (bf16_t*)(p.ws + WS_H);
  float* DL = (float*)(p.ws + WS_DL);
  bf16_t* QD = (bf16_t*)smem;
  bf16_t* KI = (bf16_t*)(smem + 17408);
  bf16_t* KoT = (bf16_t*)(smem + 34816);
  bf16_t* VT = (bf16_t*)(smem + 53248);
  bf16_t* Am = (bf16_t*)(smem + 71680);
  f32x4* segp = (f32x4*)(smem + 80896);
  float* Ob = (float*)(smem + 89600);
  const int tid = opaque_tid(), lane = tid & 63, wave = tid >> 6;
  const int kp = lane, seg = wave;
  const int c16 = lane & 15, q4 = lane >> 4;
  const int ft = tid >> 3, fv = (tid & 7) * 16;
  HgrnRegs R;
  if ((int)blockIdx.x < 4096) hgrn_chunk_load(R, proj, blockIdx.x, seg, kp);
#pragma unroll 1
  for (int u = blockIdx.x; u < 4096; u += gridDim.x) {
    const int hh = u & 7, c = (u >> 3) & 31, b = u >> 8;
    const size_t tok0 = (size_t)b * SEQ + c * 64;
    float lb0, lb1;
    {
      const f32x2 l0 = *(const f32x2*)(p.lower_bounds + hh * 128 + 2 * kp), l1 = *(const f32x2*)(p.lower_bounds + 1024 + hh * 128 + 2 * kp);
      lb0 = fast_rcp(1.f + fast_exp(l1[0] - l0[0])); lb1 = fast_rcp(1.f + fast_exp(l1[1] - l0[1]));
    }
    const f32x2 lbv = {lb0, lb1}, olb = {1.f - lb0, 1.f - lb1};
    f32x2 Ev[8], Iv[8], Kv[8];
    {
      f32x2 P = {1.f, 1.f}, Q = {1.f, 1.f};
#pragma unroll
      for (int j = 0; j < 8; ++j) {
        const float x0 = __builtin_amdgcn_fmed3f(bf_lo(R.rf[j]), -30.f, 30.f), x1 = __builtin_amdgcn_fmed3f(bf_hi(R.rf[j]), -30.f, 30.f);
        const f32x2 e = {__builtin_amdgcn_exp2f(x0 * -1.4426950408889634f), __builtin_amdgcn_exp2f(x1 * -1.4426950408889634f)};
        const f32x2 a1 = e + 1.f, a2 = lbv * e + 1.f, pr = a1 * a2;
        const f32x2 w = {fast_rcp(pr[0]), fast_rcp(pr[1])};
        const f32x2 r = w * a2;
        Kv[j] = olb * e * r;
        P = P * (a2 * r); Q = Q * (a1 * a1 * w);
        Ev[j] = P; Iv[j] = Q;
      }
      segp[seg * 64 + kp] = (f32x4){P[0], P[1], Q[0], Q[1]};
    }
    __syncthreads();
    {
      f32x2 pre = {1.f, 1.f}, pin = {1.f, 1.f}, tot = {1.f, 1.f};
#pragma unroll
      for (int s2 = 0; s2 < 8; ++s2) {
        const f32x4 v = segp[s2 * 64 + kp];
        const f32x2 vp = {v[0], v[1]}, vq = {v[2], v[3]};
        if (s2 < seg) { pre = pre * vp; pin = pin * vq; }
        tot = tot * vp;
      }
      f32x2 ko[8];
#pragma unroll
      for (int j = 0; j < 8; ++j) {
        const f32x2 Ea = pre * Ev[j], ia = pin * Iv[j];
        const f32x2 qv = {bf_lo(R.rq[j]), bf_hi(R.rq[j])};
        const f32x2 qd2 = qv * Ea, ki = Kv[j] * ia;
        ko[j] = ki * tot;
        const unsigned qd = pk_bf16(qd2[0], qd2[1]);
        *(unsigned*)(QD + (8 * seg + j) * 136 + 2 * kp) = qd;
        if (p.st_a) *(unsigned*)(proj + PB_RQ + (tok0 + 8 * seg + j) * 1024 + hh * 128 + 2 * kp) = qd;
        *(unsigned*)(KI + (8 * seg + j) * 136 + 2 * kp) = pk_bf16(ki[0], ki[1]);
      }
      *(bf16x8*)(KoT + (2 * kp) * 72 + 8 * seg) = pack8(ko[0][0], ko[1][0], ko[2][0], ko[3][0], ko[4][0], ko[5][0], ko[6][0], ko[7][0]);
      *(bf16x8*)(KoT + (2 * kp + 1) * 72 + 8 * seg) = pack8(ko[0][1], ko[1][1], ko[2][1], ko[3][1], ko[4][1], ko[5][1], ko[6][1], ko[7][1]);
      if (seg == 0 && p.st_a) { *(f32x2*)(DL + (size_t)u * 128 + 2 * kp) = tot; }
    }
    if (u + (int)gridDim.x < 4096) hgrn_chunk_load(R, proj, u + gridDim.x, seg, kp);
    __syncthreads();
    {
      const int ti = wave >> 1;
#pragma unroll
      for (int uu = 0; uu < 2; ++uu) {
        const int si = 2 * (wave & 1) + uu;
        f32x4 acc = {0.f, 0.f, 0.f, 0.f};
        if (si <= ti) {
#pragma unroll
          for (int ks = 0; ks < 4; ++ks) {
            const bf16x8 a = *(const bf16x8*)(QD + (16 * ti + c16) * 136 + 32 * ks + 8 * q4);
            const bf16x8 bb = *(const bf16x8*)(KI + (16 * si + c16) * 136 + 32 * ks + 8 * q4);
            acc = MFMA16(a, bb, acc);
          }
        }
#pragma unroll
        for (int j = 0; j < 4; ++j) {
          const int t = 16 * ti + 4 * q4 + j, s = 16 * si + c16;
          const float v = (s <= t) ? acc[j] : 0.f;
          Am[t * 72 + s] = (bf16_t)(pk_bf16(v, 0.f) & 0xffffu);
        }
      }
    }
    __syncthreads();
    {
#pragma unroll
      for (int i = 0; i < 2; ++i) {
        const int idx = tid + 512 * i, k = idx >> 3, t8 = (idx & 7) * 8;
        const u32x4 w = *(const u32x4*)(KoT + k * 72 + t8);
        if (p.st_a) *(u32x4*)(proj + PB_RF + (tok0 + (k >> 1)) * 1024 + hh * 128 + (k & 1) * 64 + t8) = w;
      }
      const int t = tid >> 3, s8 = (tid & 7) * 8;
      const u32x4 w = *(const u32x4*)(Am + t * 72 + s8);
      if (p.st_a) *(u32x4*)(Hb + ((size_t)u * 64 + t) * 64 + s8) = w;
    }
  }
  __syncthreads();
}

struct ScanRegs { u32x4 qd[2]; u32x4 ko[2]; u32x4 am; unsigned rv[8]; };
DI void hgrn_scan_load(ScanRegs& R, const Params& p, int b, int hh, int c, int tid) {
  const bf16_t* proj = (const bf16_t*)(p.ws + WS_PROJ);
  const bf16_t* Hb = (const bf16_t*)(p.ws + WS_H);
  const int lane = tid & 63, wave = tid >> 6;
  const size_t tok0 = (size_t)b * SEQ + c * 64;
  const size_t u = (size_t)(b * 32 + c) * 8 + hh;
#pragma unroll
  for (int i = 0; i < 2; ++i) {
    const int idx = tid + 512 * i;
    R.qd[i] = __builtin_nontemporal_load((const u32x4*)(proj + PB_RQ + (tok0 + (idx >> 4)) * 1024 + hh * 128 + (idx & 15) * 8));
    const int k = idx >> 3, t8 = (idx & 7) * 8;
    R.ko[i] = __builtin_nontemporal_load((const u32x4*)(proj + PB_RF + (tok0 + (k >> 1)) * 1024 + hh * 128 + (k & 1) * 64 + t8));
  }
  R.am = __builtin_nontemporal_load((const u32x4*)(Hb + (u * 64 + (tid >> 3)) * 64 + (tid & 7) * 8));
#pragma unroll
  for (int j = 0; j < 8; ++j) R.rv[j] = __builtin_nontemporal_load((const unsigned*)(proj + PB_RI + (tok0 + 8 * wave + j) * 1024 + hh * 128 + 2 * lane));
}
DI void hgrn_scan_unit(const Params& p, char* smem, int unit) {
  const int hh = unit & 7, b = unit >> 3;
  bf16_t* proj = (bf16_t*)(p.ws + WS_PROJ);
  bf16_t* QD = (bf16_t*)smem;
  bf16_t* KoT = (bf16_t*)(smem + 17408);
  bf16_t* VT = (bf16_t*)(smem + 35840);
  bf16_t* Am = (bf16_t*)(smem + 54272);
  float* dla = (float*)(smem + 97792);
  float* Ob = (float*)(smem + 64000);
  const int tid = opaque_tid(), lane = tid & 63, wave = tid >> 6;
  const int c16 = lane & 15, q4 = lane >> 4;
  const int ft = tid >> 3, fv = (tid & 7) * 16;
  const int vcol = 16 * wave + c16;
  f32x4 S[8];
#pragma unroll
  for (int i = 0; i < 8; ++i) S[i] = (f32x4){0.f, 0.f, 0.f, 0.f};
  ScanRegs R0, R1;
  hgrn_scan_load(R0, p, b, hh, 0, tid);
  hgrn_scan_load(R1, p, b, hh, 1, tid);
  {
    const float* DL = (const float*)(p.ws + WS_DL);
#pragma unroll
    for (int i = 0; i < 2; ++i) { const int idx = tid + 512 * i, c = idx >> 5, k4 = (idx & 31) * 4; *(f32x4*)(dla + c * 128 + k4) = *(const f32x4*)(DL + ((size_t)(b * 32 + c) * 8 + hh) * 128 + k4); }
  }
  auto body = [&](const int c, ScanRegs& C) __attribute__((always_inline)) {
    const size_t tok0 = (size_t)b * SEQ + c * 64;
#pragma unroll
    for (int i = 0; i < 2; ++i) {
      const int idx = tid + 512 * i;
      *(u32x4*)(QD + (idx >> 4) * 136 + (idx & 15) * 8) = C.qd[i];
      *(u32x4*)(KoT + (idx >> 3) * 72 + (idx & 7) * 8) = C.ko[i];
    }
    *(u32x4*)(Am + (tid >> 3) * 72 + (tid & 7) * 8) = C.am;
    {
      u32x4 wl, wh;
#pragma unroll
      for (int i = 0; i < 4; ++i) { wl[i] = (C.rv[2 * i] & 0xffffu) | (C.rv[2 * i + 1] << 16); wh[i] = (C.rv[2 * i] >> 16) | (C.rv[2 * i + 1] & 0xffff0000u); }
      *(u32x4*)(VT + (2 * lane) * 72 + 8 * wave) = wl;
      *(u32x4*)(VT + (2 * lane + 1) * 72 + 8 * wave) = wh;
    }
    if (c + 2 < 32) hgrn_scan_load(C, p, b, hh, c + 2, tid);
    const float* dl = dla + c * 128;
    u32x4 rg[2];
    __syncthreads();
    {
      bf16x8 bv[2];
#pragma unroll
      for (int ks = 0; ks < 2; ++ks) bv[ks] = *(const bf16x8*)(VT + vcol * 72 + 32 * ks + 8 * q4);
#pragma unroll
      for (int th = 0; th < 2; ++th) {
        f32x4 o[2];
#pragma unroll
        for (int i = 0; i < 2; ++i) o[i] = (f32x4){0.f, 0.f, 0.f, 0.f};
#pragma unroll
        for (int kq = 0; kq < 4; ++kq) {
          const bf16x8 sf = pack8(S[2 * kq][0], S[2 * kq][1], S[2 * kq][2], S[2 * kq][3], S[2 * kq + 1][0], S[2 * kq + 1][1], S[2 * kq + 1][2], S[2 * kq + 1][3]);
#pragma unroll
          for (int t2 = 0; t2 < 2; ++t2) {
            const int ti = 2 * th + t2;
            const bf16_t* ap = QD + (16 * ti + c16) * 136 + 32 * kq + 4 * q4;
            const u32x2 lo = *(const u32x2*)ap, hi = *(const u32x2*)(ap + 16);
            const u32x4 av = {lo[0], lo[1], hi[0], hi[1]};
            o[t2] = MFMA16(__builtin_bit_cast(bf16x8, av), sf, o[t2]);
          }
        }
#pragma unroll
        for (int t2 = 0; t2 < 2; ++t2)
#pragma unroll
          for (int ks = 0; ks < 2; ++ks) {
            const bf16x8 a = *(const bf16x8*)(Am + (16 * (2 * th + t2) + c16) * 72 + 32 * ks + 8 * q4);
            o[t2] = MFMA16(a, bv[ks], o[t2]);
          }
#pragma unroll
        for (int t2 = 0; t2 < 2; ++t2)
#pragma unroll
          for (int j = 0; j < 4; ++j) Ob[(16 * (2 * th + t2) + 4 * q4 + j) * 132 + vcol] = o[t2][j];
        __builtin_amdgcn_sched_barrier(0);
      }
      {
        const bf16_t* gq = proj + PB_RG + (tok0 + ft) * 1024 + hh * 128 + fv;
        rg[0] = __builtin_nontemporal_load((const u32x4*)gq); rg[1] = __builtin_nontemporal_load((const u32x4*)(gq + 8));
      }
#pragma unroll
      for (int kt = 0; kt < 8; ++kt) {
        const f32x4 d = *(const f32x4*)(dl + 16 * kt + 4 * q4);
        S[kt] = S[kt] * d;
#pragma unroll
        for (int ks = 0; ks < 2; ++ks) {
          const bf16x8 a = *(const bf16x8*)(KoT + (16 * kt + c16) * 72 + 32 * ks + 8 * q4);
          S[kt] = MFMA16(a, bv[ks], S[kt]);
        }
        if (kt & 1) __builtin_amdgcn_sched_barrier(0);
      }
    }
    __syncthreads();
    {
      f32x4 ov[4]; float ss = 0.f;
#pragma unroll
      for (int i = 0; i < 4; ++i) { ov[i] = *(const f32x4*)(Ob + ft * 132 + fv + 4 * i); ss += ov[i][0] * ov[i][0] + ov[i][1] * ov[i][1] + ov[i][2] * ov[i][2] + ov[i][3] * ov[i][3]; }
      ss += __shfl_xor(ss, 1); ss += __shfl_xor(ss, 2); ss += __shfl_xor(ss, 4);
      const float rstd = rsqrtf(ss * (1.0f / 128.0f) + EPS);
      float y[16];
#pragma unroll
      for (int i = 0; i < 4; ++i) {
        const f32x4 w = *(const f32x4*)(p.rec_norm_w + fv + 4 * i);
        const unsigned ga = (i < 2) ? rg[0][2 * i] : rg[1][2 * (i - 2)], gb = (i < 2) ? rg[0][2 * i + 1] : rg[1][2 * (i - 2) + 1];
        y[4 * i + 0] = ov[i][0] * rstd * w[0] * bf_lo(ga);
        y[4 * i + 1] = ov[i][1] * rstd * w[1] * bf_hi(ga);
        y[4 * i + 2] = ov[i][2] * rstd * w[2] * bf_lo(gb);
        y[4 * i + 3] = ov[i][3] * rstd * w[3] * bf_hi(gb);
      }
      bf16_t* gp = proj + PB_RG + (tok0 + ft) * 1024 + hh * 128 + fv;
      if (p.st_m) {
      *(bf16x8*)gp = pack8(y[0], y[1], y[2], y[3], y[4], y[5], y[6], y[7]);
      *(bf16x8*)(gp + 8) = pack8(y[8], y[9], y[10], y[11], y[12], y[13], y[14], y[15]);
      }
    }
  };
#pragma unroll 1
  for (int c = 0; c < 32; c += 2) { body(c, R0); body(c + 1, R1); }
  __syncthreads();
}

DI void phase_mix(const Params& p, char* smem) {
  int* s_item = (int*)(smem + 131072);
  unsigned* ctr = (unsigned*)(p.ws + WS_CTRL) + CW_WORK;
  while (true) {
    if (threadIdx.x == 0) *s_item = (int)atomicAdd(ctr, 1u);
    __syncthreads();
    const int item = *s_item;
    __syncthreads();
    if (item >= 128 + 1024) break;
    if (item < 128) hgrn_scan_unit(p, smem, item); else attn_unit(p, smem, item - 128);
  }
}

DI void phase_gemm1(const Params& p, char* smem) {
  EpiProj e{(bf16_t*)(p.ws + WS_PROJ)};
  gemm_phase<D_MODEL, (1 << 30), 0, NTOK, IN_W, D_MODEL>((LAS unsigned char*)smem, (const bf16_t*)(p.ws + WS_H), (const bf16_t*)(p.ws + WS_WTIN), e);
}
DI void phase_gemm2(const Params& p, char* smem) {
  EpiOut e{p.out, p.x, (const float*)(p.ws + WS_MOD)};
  gemm_phase<1024, 16, (int)(PB_RG - PB_AG) - 1024, NTOK, D_MODEL, D_MIX>((LAS unsigned char*)smem, (const bf16_t*)(p.ws + WS_PROJ) + PB_AG, (const bf16_t*)(p.ws + WS_WTOUT), e);
}

extern __shared__ __attribute__((aligned(16))) char dyn_smem[];

#if ONE_LAUNCH
__global__ void __launch_bounds__(NTHREADS, 2) hymba_fwd(Params p) {
  cg::grid_group grid = cg::this_grid();
  volatile LAS unsigned* st = (volatile LAS unsigned*)((LAS unsigned char*)dyn_smem + 131072 + 16);
  if (threadIdx.x == 0) { st[0] = 0u; st[1] = 0u; }
  __syncthreads();
  const XcdBarrier xb = xcd_barrier_post((unsigned*)(p.ws + WS_XBAR), st);
  phase_prep(p, dyn_smem);
  phase_norm(p, dyn_smem);
  if (p.ws == nullptr) grid.sync();
  xcd_barrier(xb);
  phase_gemm1(p, dyn_smem);
  xcd_barrier(xb);
  phase_hgrn_chunk(p, dyn_smem);
  xcd_barrier(xb);
  phase_mix(p, dyn_smem);
  xcd_barrier(xb);
  phase_gemm2(p, dyn_smem);
}
#else
__global__ void __launch_bounds__(NTHREADS, 2) k_prep(Params p) { phase_prep(p, dyn_smem); }
__global__ void __launch_bounds__(NTHREADS, 2) k_norm(Params p) { phase_norm(p, dyn_smem); }
__global__ void __launch_bounds__(NTHREADS, 2) k_gemm1(Params p) { phase_gemm1(p, dyn_smem); }
__global__ void __launch_bounds__(NTHREADS, 2) k_hgrna(Params p) { phase_hgrn_chunk(p, dyn_smem); }
__global__ void __launch_bounds__(NTHREADS, 2) k_mix(Params p) { phase_mix(p, dyn_smem); }
__global__ void __launch_bounds__(NTHREADS, 2) k_gemm2(Params p) { phase_gemm2(p, dyn_smem); }
#endif

extern "C" void kernel_launch(void* const* d_in, const int* in_sizes, int n_in, void* d_out, int out_size, void* d_ws, size_t ws_size, hipStream_t stream) {
  static int grid = 0;
  if (grid == 0) {
    if (n_in != 13 || ws_size < WS_END) { fprintf(stderr, "kernel_launch: unexpected n_in %d or workspace %zu < %zu\n", n_in, ws_size, (size_t)WS_END); grid = -1; return; }
    int dev = 0, cus = 0, per_cu = 0;
    hipGetDevice(&dev);
    hipDeviceGetAttribute(&cus, hipDeviceAttributeMultiprocessorCount, dev);
#if ONE_LAUNCH
    if (hipFuncSetAttribute((const void*)hymba_fwd, hipFuncAttributeMaxDynamicSharedMemorySize, LDS_BYTES) != hipSuccess) { fprintf(stderr, "hipFuncSetAttribute failed\n"); grid = -1; return; }
    hipOccupancyMaxActiveBlocksPerMultiprocessor(&per_cu, (const void*)hymba_fwd, NTHREADS, LDS_BYTES);
    if (per_cu < 1) { fprintf(stderr, "occupancy query says %d blocks per CU\n", per_cu); per_cu = 1; }
    grid = cus * per_cu;
#else
    hipFuncSetAttribute((const void*)k_prep, hipFuncAttributeMaxDynamicSharedMemorySize, LDS_BYTES);
    hipFuncSetAttribute((const void*)k_gemm1, hipFuncAttributeMaxDynamicSharedMemorySize, LDS_BYTES);
    hipFuncSetAttribute((const void*)k_mix, hipFuncAttributeMaxDynamicSharedMemorySize, LDS_BYTES);
    hipFuncSetAttribute((const void*)k_hgrna, hipFuncAttributeMaxDynamicSharedMemorySize, LDS_BYTES);
    hipFuncSetAttribute((const void*)k_gemm2, hipFuncAttributeMaxDynamicSharedMemorySize, LDS_BYTES);
    (void)per_cu;
    grid = cus;
#endif
    (void)hipGetLastError();
  }
  if (grid < 0) return;
  (void)hipMemsetAsync((char*)d_ws + WS_CTRL, 0, 16384, stream);
  Params p{};
  p.x = (const float*)d_in[0]; p.c = (const float*)d_in[1]; p.pos = (const int*)d_in[2]; p.norm_w = (const float*)d_in[3];
  p.w_ada = (const float*)d_in[4]; p.b_ada = (const float*)d_in[5]; p.w_in = (const float*)d_in[6]; p.q_norm_w = (const float*)d_in[7];
  p.k_norm_w = (const float*)d_in[8]; p.sinks = (const float*)d_in[9]; p.rec_norm_w = (const float*)d_in[10];
  p.lower_bounds = (const float*)d_in[11]; p.w_out = (const float*)d_in[12]; p.out = (float*)d_out; p.ws = (char*)d_ws; p.st_a = 1; p.st_m = 1;
#if ONE_LAUNCH
  void* args[] = {&p};
  hipError_t e = hipLaunchCooperativeKernel((const void*)hymba_fwd, dim3(grid), dim3(NTHREADS), args, LDS_BYTES, stream);
  if (e != hipSuccess) fprintf(stderr, "cooperative launch failed: %s (grid %d)\n", hipGetErrorString(e), grid);
#else
  for (int r = 0; r < REP_PREP; ++r) hipLaunchKernelGGL(k_prep, dim3(grid), dim3(NTHREADS), LDS_BYTES, stream, p);
  for (int r = 0; r < REP_NORM; ++r) hipLaunchKernelGGL(k_norm, dim3(grid), dim3(NTHREADS), 16384, stream, p);
  for (int r = 0; r < REP_G1; ++r) hipLaunchKernelGGL(k_gemm1, dim3(grid), dim3(NTHREADS), LDS_BYTES, stream, p);
  for (int r = 0; r < REP_A; ++r) { p.st_a = (r == REP_A - 1); hipLaunchKernelGGL(k_hgrna, dim3(grid), dim3(NTHREADS), LDS_BYTES, stream, p); }
  for (int r = 0; r < REP_M; ++r) { p.st_m = (r == REP_M - 1); (void)hipMemsetAsync((char*)d_ws + WS_CTRL, 0, 16384, stream); hipLaunchKernelGGL(k_mix, dim3(grid), dim3(NTHREADS), LDS_BYTES, stream, p); }
  for (int r = 0; r < REP_G2; ++r) hipLaunchKernelGGL(k_gemm2, dim3(grid), dim3(NTHREADS), LDS_BYTES, stream, p);
#endif
}
```

```cpp
#include <hip/hip_runtime.h>
#include <hip/hip_cooperative_groups.h>
#include <cstdio>
#include <cstdint>
namespace cg = cooperative_groups;

#ifndef ONE_LAUNCH
#define ONE_LAUNCH 1
#endif

#define REP_PREP 1
#define REP_NORM 1
#define REP_G1 1
#define REP_G2 1
#define REP_A 1
#define REP_M 1
#define DI __device__ __forceinline__
typedef unsigned short bf16_t;
typedef short bf16x8 __attribute__((ext_vector_type(8)));
typedef float f32x4 __attribute__((ext_vector_type(4)));
typedef float f32x2 __attribute__((ext_vector_type(2)));
typedef float f32x16 __attribute__((ext_vector_type(16)));
typedef unsigned u32x4 __attribute__((ext_vector_type(4)));
typedef unsigned u32x2 __attribute__((ext_vector_type(2)));
typedef short s16x4 __attribute__((ext_vector_type(4)));
typedef __bf16 bf16x2_t __attribute__((ext_vector_type(2)));

constexpr int D_MODEL = 1024, BATCH = 16, SEQ = 2048, NTOK = BATCH * SEQ, IN_W = 6656, D_MIX = 2048;
constexpr int OFF_AQ = 0, OFF_AK = 1024, OFF_AV = 1280, OFF_AG = 1536, OFF_RQ = 2560, OFF_RF = 3584, OFF_RI = 4608, OFF_RG = 5632;
constexpr size_t PB_AQ = 0, PB_AK = PB_AQ + (size_t)NTOK * 1024, PB_AV = PB_AK + (size_t)NTOK * 256, PB_AG = PB_AV + (size_t)NTOK * 256,
                 PB_RQ = PB_AG + (size_t)NTOK * 1024, PB_RF = PB_RQ + (size_t)NTOK * 1024, PB_RI = PB_RF + (size_t)NTOK * 1024, PB_RG = PB_RI + (size_t)NTOK * 1024;
constexpr float EPS = 1e-6f;
constexpr int NTHREADS = 512;
constexpr int LDS_BYTES = 131072 + 256;

constexpr size_t MiB = 1024 * 1024;
constexpr size_t WS_CTRL = 0, WS_XBAR = 2048, WS_MOD = 16384, WS_ROPE = 1 * MiB, WS_WTIN = 9 * MiB, WS_WTOUT = 22 * MiB, WS_H = 26 * MiB, WS_PROJ = 90 * MiB, WS_DL = 506 * MiB,
                 WS_END = WS_DL + 2 * MiB;

struct Params {
  const float* x; const float* c; const int* pos; const float* norm_w; const float* w_ada; const float* b_ada;
  const float* w_in; const float* q_norm_w; const float* k_norm_w; const float* sinks; const float* rec_norm_w;
  const float* lower_bounds; const float* w_out; float* out; char* ws; int st_a; int st_m;
};

DI int opaque_tid() { int t = threadIdx.x; asm volatile("" : "+v"(t)); return t; }
DI unsigned pk_bf16(float lo, float hi) { f32x2 v = {lo, hi}; bf16x2_t b = __builtin_convertvector(v, bf16x2_t); return __builtin_bit_cast(unsigned, b); }
DI float bf_lo(unsigned u) { return __uint_as_float(u << 16); }
DI float bf_hi(unsigned u) { return __uint_as_float(u & 0xffff0000u); }
DI bf16x8 pack8(float a0, float a1, float a2, float a3, float a4, float a5, float a6, float a7) {
  u32x4 w = {pk_bf16(a0, a1), pk_bf16(a2, a3), pk_bf16(a4, a5), pk_bf16(a6, a7)}; return __builtin_bit_cast(bf16x8, w);
}
DI float fast_exp(float x) { return __builtin_amdgcn_exp2f(x * 1.4426950408889634f); }
DI float fast_rcp(float x) { return __builtin_amdgcn_rcpf(x); }
DI float silu(float x) { return x * fast_rcp(1.f + fast_exp(-x)); }
#define MFMA16(a, b, c) __builtin_amdgcn_mfma_f32_16x16x32_bf16((a), (b), (c), 0, 0, 0)
#define MFMA32(a, b, c) __builtin_amdgcn_mfma_f32_32x32x16_bf16((a), (b), (c), 0, 0, 0)

constexpr int CW_WORK = 0, CW_BAR1 = 64, CW_BAR2 = 128, CW_MOD = 192, CW_NORM = 320, CW_TR = 384;
#define XB_TMO      128
#define XB_XCNT(j)  (256  + 64 * (j))
#define XB_XSUB(j)  (1280 + 64 * (j))
#define XB_XGEN(j)  (2304 + 64 * (j))
#define XB_TOP      3328
#define XB_TOPGEN   3392
#define XCD_BAR_WORDS 3456
#define XB_SPIN_CAP (1u << 22)
#define LAS __attribute__((address_space(3)))
DI unsigned xb_ld(unsigned* p) { return __hip_atomic_load(p, __ATOMIC_RELAXED, __HIP_MEMORY_SCOPE_AGENT); }
DI unsigned xb_add(unsigned* p, unsigned v) { return __hip_atomic_fetch_add(p, v, __ATOMIC_RELAXED, __HIP_MEMORY_SCOPE_AGENT); }
DI unsigned xb_xcc_id() { return (unsigned)__builtin_amdgcn_s_getreg((3 << 11) | 20) & 0xFu; }
#define XB_SPIN(cond, bar) do { unsigned _sp = 0; while (cond) { __builtin_amdgcn_s_sleep(1); \
    if ((++_sp & 255u) == 0u) { if (xb_ld(&(bar)[XB_TMO])) break; if (_sp > XB_SPIN_CAP) { atomicAdd(&(bar)[XB_TMO], 1u); break; } } } } while (0)
struct XcdBarrier { unsigned* bar; unsigned x; volatile LAS unsigned* st; };
DI XcdBarrier xcd_barrier_post(unsigned* bar, volatile LAS unsigned* st) {
  XcdBarrier b; b.bar = bar; b.x = xb_xcc_id(); b.st = st;
  if (threadIdx.x == 0) (void)xb_add(&bar[XB_XCNT(b.x)], 1u);
  return b;
}
DI void xcd_barrier_complete(unsigned* bar, unsigned x, unsigned& nloc, unsigned& nx) {
  const unsigned G = gridDim.x;
  unsigned sum, cnt, mine, sp = 0u;
  for (;;) {
    sum = 0u; cnt = 0u; mine = 0u;
#pragma unroll
    for (unsigned j = 0; j < 16; ++j) { const unsigned c = xb_ld(&bar[XB_XCNT(j)]); sum += c; cnt += (c > 0u) ? 1u : 0u; mine = (j == x) ? c : mine; }
    if (sum == G) break;
    __builtin_amdgcn_s_sleep(1);
    if ((++sp & 255u) == 0u) { if (xb_ld(&bar[XB_TMO])) break; if (sp > XB_SPIN_CAP) { atomicAdd(&bar[XB_TMO], 1u); break; } }
  }
  nloc = mine > 0u ? mine : 1u; nx = cnt > 0u ? cnt : 1u;
}
DI void xcd_barrier(const XcdBarrier& b) {
  asm volatile("s_waitcnt vmcnt(0)" ::: "memory");
  __syncthreads();
  if (threadIdx.x == 0) {
    unsigned* bar = b.bar;
    __builtin_amdgcn_s_waitcnt(0);
    unsigned nloc = b.st[0], nx = b.st[1];
    if (nloc == 0u) { xcd_barrier_complete(bar, b.x, nloc, nx); b.st[0] = nloc; b.st[1] = nx; }
    const unsigned old = xb_add(&bar[XB_XSUB(b.x)], 1u);
    const unsigned gen = old / nloc;
    if (old + 1u == (gen + 1u) * nloc) {
      __builtin_amdgcn_fence(__ATOMIC_RELEASE, "agent");
      asm volatile("s_waitcnt vmcnt(0)" ::: "memory");
      const unsigned og = xb_add(&bar[XB_TOP], 1u);
      const unsigned tg = og / nx;
      if (og + 1u == (tg + 1u) * nx) xb_add(&bar[XB_TOPGEN], 1u);
      else XB_SPIN(xb_ld(&bar[XB_TOPGEN]) == tg, bar);
      __builtin_amdgcn_fence(__ATOMIC_ACQUIRE, "agent");
      xb_add(&bar[XB_XGEN(b.x)], 1u);
      asm volatile("s_waitcnt vmcnt(0)" ::: "memory");
    } else {
      XB_SPIN(xb_ld(&bar[XB_XGEN(b.x)]) == gen, bar);
      __builtin_amdgcn_fence(__ATOMIC_ACQUIRE, "agent");
      asm volatile("s_waitcnt vmcnt(0)" ::: "memory");
    }
  }
  __syncthreads();
}

DI void transpose_tile4(const float* __restrict__ W, int ldw, bf16_t* __restrict__ Wt, int ldt, int k0, int n0, float* tile, int tid) {
  f32x4 v[8];
#pragma unroll
  for (int pass = 0; pass < 8; ++pass) {
    const int r = (tid >> 4) + 32 * pass, c4 = (tid & 15) * 4;
    v[pass] = __builtin_nontemporal_load((const f32x4*)(W + (size_t)(k0 + r) * ldw + n0 + c4));
  }
#pragma unroll
  for (int pass = 0; pass < 8; ++pass) {
    const int r = (tid >> 4) + 32 * pass, c4 = (tid & 15) * 4;
    tile[r * 65 + c4 + 0] = v[pass][0]; tile[r * 65 + c4 + 1] = v[pass][1]; tile[r * 65 + c4 + 2] = v[pass][2]; tile[r * 65 + c4 + 3] = v[pass][3];
  }
  __syncthreads();
#pragma unroll
  for (int pass = 0; pass < 4; ++pass) {
    const int idx = tid + 512 * pass, nl = idx >> 5, kseg = (idx & 31) * 8;
    float x[8];
#pragma unroll
    for (int j = 0; j < 8; ++j) x[j] = tile[(kseg + j) * 65 + nl];
    const int c = nl & 31, rho = 16 * ((c >> 2) & 1) + 4 * (c >> 3) + (c & 3), nrow = n0 + (nl & 32) + rho;
    u32x4 w = {pk_bf16(x[0], x[1]), pk_bf16(x[2], x[3]), pk_bf16(x[4], x[5]), pk_bf16(x[6], x[7])};
    *(u32x4*)(Wt + (size_t)nrow * ldt + k0 + kseg) = w;
  }
  __syncthreads();
}

DI void phase_prep(const Params& p, char* smem) {
  const int tid = opaque_tid();
  float* rope = (float*)(p.ws + WS_ROPE);
  for (int i = blockIdx.x * NTHREADS + tid; i < NTOK * 32; i += gridDim.x * NTHREADS) {
    const int tok = i >> 5, f = i & 31;
    const float inv = exp2f(-(float)f * (13.287712379549449f / 32.0f));
    const float ang = (float)p.pos[tok] * inv;
    double t = (double)ang * 0.15915494309189535; t -= rint(t);
    const float r = (float)t;
    rope[(size_t)tok * 64 + f] = __builtin_amdgcn_cosf(r);
    rope[(size_t)tok * 64 + 32 + f] = __builtin_amdgcn_sinf(r);
  }
  float* mod = (float*)(p.ws + WS_MOD);
  bf16_t* wtin = (bf16_t*)(p.ws + WS_WTIN);
  bf16_t* wtout = (bf16_t*)(p.ws + WS_WTOUT);
  constexpr int J_MOD = 192, J_WIN = 4 * 104, J_WOUT = 8 * 16;
  for (int job = blockIdx.x; job < J_MOD; job += gridDim.x) {
      float* cact = (float*)smem;
      float* red = (float*)(smem + 65536);
      for (int i = tid; i < 16 * 256; i += NTHREADS) { const int b = i >> 8, k = (job / 48) * 256 + (i & 255); const float v = p.c[b * 1024 + k]; cact[b * 1024 + k] = silu(v); }
      __syncthreads();
      const int n = tid & 63, ks = tid >> 6, n0 = (job % 48) * 64, ksp = job / 48;
      float acc[16];
#pragma unroll
      for (int b = 0; b < 16; ++b) acc[b] = 0.f;
#pragma unroll 1
      for (int k = ksp * 256 + ks * 32; k < ksp * 256 + ks * 32 + 32; k += 16) {
        float w[16];
#pragma unroll
        for (int u = 0; u < 16; ++u) w[u] = __builtin_nontemporal_load(p.w_ada + (size_t)(k + u) * 3072 + n0 + n);
#pragma unroll
        for (int u = 0; u < 16; ++u)
#pragma unroll
          for (int b = 0; b < 16; ++b) acc[b] += cact[b * 1024 + k + u] * w[u];
      }
#pragma unroll
      for (int b = 0; b < 16; ++b) red[(ks * 16 + b) * 64 + n] = acc[b];
      __syncthreads();
      for (int o = tid; o < 1024; o += NTHREADS) {
        const int b = o >> 6, nn = o & 63; float sacc = (ksp == 0) ? p.b_ada[n0 + nn] : 0.f;
#pragma unroll
        for (int k2 = 0; k2 < 8; ++k2) sacc += red[(k2 * 16 + b) * 64 + nn];
        mod[(ksp * 16 + b) * 3072 + n0 + nn] = sacc;
      }
      asm volatile("s_waitcnt vmcnt(0)" ::: "memory");
      __syncthreads();
      if (tid == 0) __hip_atomic_fetch_add((unsigned*)(p.ws + WS_CTRL) + CW_MOD, 1u, __ATOMIC_RELEASE, __HIP_MEMORY_SCOPE_AGENT);
  }
}
DI void prep_transpose_job(const Params& p, char* smem, int j, int tid) {
  constexpr int J_WIN = 4 * 104;
  bf16_t* wtin = (bf16_t*)(p.ws + WS_WTIN);
  bf16_t* wtout = (bf16_t*)(p.ws + WS_WTOUT);
  if (j < J_WIN) { const int kt = j & 3, nt = j >> 2; transpose_tile4(p.w_in, IN_W, wtin, D_MODEL, kt * 256, nt * 64, (float*)smem, tid); }
  else { const int j2 = j - J_WIN, kt = j2 & 7, nt = j2 >> 3; transpose_tile4(p.w_out, D_MODEL, wtout, D_MIX, kt * 256, nt * 64, (float*)smem, tid); }
}

DI void phase_norm(const Params& p, char* smem) {
  const int tid = opaque_tid(), lane = tid & 63, wave = tid >> 6;
  const float* mod = (const float*)(p.ws + WS_MOD);
  bf16_t* H = (bf16_t*)(p.ws + WS_H);
  float* sc1 = (float*)(smem + 69632);
  float* shv = (float*)(smem + 69632 + 4096);
  int* s_item = (int*)(smem + 131072);
  unsigned* nctr = (unsigned*)(p.ws + WS_CTRL) + CW_NORM;
  unsigned* tctr = (unsigned*)(p.ws + WS_CTRL) + CW_TR;
  int bprev = -1;
  bool tr_left = true, nm_left = true, mod_ok = false;
  for (int step = 0; tr_left || nm_left; ++step) {
    const bool do_tr = tr_left && ((step % 3) == 0 || !nm_left);
    if (tid == 0) *s_item = do_tr ? (int)atomicAdd(tctr, 1u) : (int)atomicAdd(nctr, 1u);
    __syncthreads();
    const int g = *s_item;
    __syncthreads();
    if (do_tr) {
      if (g >= 4 * 104 + 8 * 16) tr_left = false; else prep_transpose_job(p, smem, g, tid);
      continue;
    }
    if (g >= NTOK / 64) { nm_left = false; continue; }
    if (!mod_ok) {
      if (tid == 0) { const unsigned* mc = (const unsigned*)(p.ws + WS_CTRL) + CW_MOD; while (__hip_atomic_load(mc, __ATOMIC_ACQUIRE, __HIP_MEMORY_SCOPE_AGENT) < 192u) __builtin_amdgcn_s_sleep(1); }
      __syncthreads();
      mod_ok = true;
    }
    const int b = g >> 5;
    if (b != bprev) {
      for (int col = tid; col < 1024; col += NTHREADS) {
        float sh = 0.f, sc = 0.f;
#pragma unroll
        for (int k2 = 0; k2 < 4; ++k2) { sh += mod[(k2 * 16 + b) * 3072 + col]; sc += mod[(k2 * 16 + b) * 3072 + 1024 + col]; }
        sc1[col] = p.norm_w[col] * (1.f + sc); shv[col] = sh;
      }
      bprev = b;
      __syncthreads();
    }
#pragma unroll 1
    for (int it = 0; it < 4; ++it) {
      const int row0 = g * 64 + wave * 8 + it * 2;
      f32x4 v[2][4]; float ss[2] = {0.f, 0.f};
#pragma unroll
      for (int rr = 0; rr < 2; ++rr) {
        const f32x4* xr = (const f32x4*)(p.x + (size_t)(row0 + rr) * D_MODEL);
#pragma unroll
        for (int i = 0; i < 4; ++i) v[rr][i] = __builtin_nontemporal_load(xr + lane + 64 * i);
      }
#pragma unroll
      for (int rr = 0; rr < 2; ++rr) {
#pragma unroll
        for (int i = 0; i < 4; ++i) ss[rr] += v[rr][i][0] * v[rr][i][0] + v[rr][i][1] * v[rr][i][1] + v[rr][i][2] * v[rr][i][2] + v[rr][i][3] * v[rr][i][3];
#pragma unroll
        for (int o = 32; o >= 1; o >>= 1) ss[rr] += __shfl_xor(ss[rr], o);
        ss[rr] = rsqrtf(ss[rr] * (1.0f / D_MODEL) + EPS);
      }
#pragma unroll
      for (int i = 0; i < 4; ++i) {
        const int col = (lane + 64 * i) * 4;
        const f32x4 a = *(const f32x4*)(sc1 + col), sh = *(const f32x4*)(shv + col);
#pragma unroll
        for (int rr = 0; rr < 2; ++rr) {
          float h[4];
#pragma unroll
          for (int j = 0; j < 4; ++j) h[j] = v[rr][i][j] * ss[rr] * a[j] + sh[j];
          u32x2 w = {pk_bf16(h[0], h[1]), pk_bf16(h[2], h[3])};
          *(u32x2*)(H + (size_t)(row0 + rr) * D_MODEL + col) = w;
        }
      }
    }
  }
}

constexpr int BM = 256, BK = 64, HALF = 128, NXCD = 8, WGM = 8, HT = HALF * BK;
DI int lds_byte(int r, int c) { const int st = (r >> 4) * 2 + (c >> 5), rr = r & 15, cc = c & 31, ob = rr * 64 + cc * 2; return st * 1024 + (ob ^ (((ob >> 9) & 1) << 5)); }
DI void stage_rc(int b, int& R, int& C) { const int st = b / 1024, sb = b % 1024, swz = sb ^ (((sb >> 9) & 1) << 5); R = (st >> 1) * 16 + swz / 64; C = (st & 1) * 32 + (swz % 64) / 2; }

struct EpiProj {
  bf16_t* O;
  DI void operator()(const f32x4 (&acc)[2][2][4][2], int brow, int bcol, int wr, int wc, int fr, int fq) const {
    const bool gate_tile = (bcol >= OFF_AG && bcol < OFF_AG + 1024) || (bcol >= OFF_RG);
    size_t sbase; int sld, scol;
    if (bcol < OFF_AK) { sbase = PB_AQ; sld = 1024; scol = bcol - OFF_AQ; }
    else if (bcol < OFF_AV) { sbase = PB_AK; sld = 256; scol = bcol - OFF_AK; }
    else if (bcol < OFF_AG) { sbase = PB_AV; sld = 256; scol = bcol - OFF_AV; }
    else if (bcol < OFF_RQ) { sbase = PB_AG; sld = 1024; scol = bcol - OFF_AG; }
    else if (bcol < OFF_RF) { sbase = PB_RQ; sld = 1024; scol = bcol - OFF_RQ; }
    else if (bcol < OFF_RI) { sbase = PB_RF; sld = 1024; scol = bcol - OFF_RF; }
    else if (bcol < OFF_RG) { sbase = PB_RI; sld = 1024; scol = bcol - OFF_RI; }
    else { sbase = PB_RG; sld = 1024; scol = bcol - OFF_RG; }
#pragma unroll
    for (int ai = 0; ai < 2; ++ai)
#pragma unroll
      for (int m = 0; m < 4; ++m) {
        const int row = brow + ai * HALF + wr * 64 + m * 16 + fr;
        bf16_t* rp = O + sbase + (size_t)row * sld + scol + wc * 32 + 8 * fq;
#pragma unroll
        for (int bj = 0; bj < 2; ++bj) {
          f32x4 a0 = acc[ai][bj][m][0], a1 = acc[ai][bj][m][1];
          if (gate_tile) {
#pragma unroll
            for (int j = 0; j < 4; ++j) { a0[j] = silu(a0[j]); a1[j] = silu(a1[j]); }
          }
          u32x4 w = {pk_bf16(a0[0], a0[1]), pk_bf16(a0[2], a0[3]), pk_bf16(a1[0], a1[1]), pk_bf16(a1[2], a1[3])};
          __builtin_nontemporal_store(w, (u32x4*)(rp + bj * HALF));
        }
      }
  }
};
struct EpiOut {
  float* O; const float* X; const float* mod;
  DI void operator()(const f32x4 (&acc)[2][2][4][2], int brow, int bcol, int wr, int wc, int fr, int fq) const {
    const int b = brow >> 11;
    f32x4 g[2][2];
    {
      f32x4 gp[2][4][2];
#pragma unroll
      for (int bj = 0; bj < 2; ++bj)
#pragma unroll
        for (int k2 = 0; k2 < 4; ++k2) {
          const float* gq = mod + (k2 * 16 + b) * 3072 + 2048 + bcol + bj * HALF + wc * 32 + 8 * fq;
          gp[bj][k2][0] = *(const f32x4*)gq; gp[bj][k2][1] = *(const f32x4*)(gq + 4);
        }
#pragma unroll
      for (int bj = 0; bj < 2; ++bj) { g[bj][0] = (gp[bj][0][0] + gp[bj][1][0]) + (gp[bj][2][0] + gp[bj][3][0]); g[bj][1] = (gp[bj][0][1] + gp[bj][1][1]) + (gp[bj][2][1] + gp[bj][3][1]); }
    }
    f32x4 xb[2][4][2];
    auto ldb = [&](int q, f32x4 (&x)[4][2]) __attribute__((always_inline)) {
      const int bj = q >> 1, ai = q & 1, col = bcol + bj * HALF + wc * 32 + 8 * fq;
#pragma unroll
      for (int m = 0; m < 4; ++m) {
        const size_t o = (size_t)(brow + ai * HALF + wr * 64 + m * 16 + fr) * D_MODEL + col;
        x[m][0] = *(const f32x4*)(X + o); x[m][1] = *(const f32x4*)(X + o + 4);
      }
    };
    ldb(0, xb[0]);
#pragma unroll
    for (int q = 0; q < 4; ++q) {
      if (q + 1 < 4) ldb(q + 1, xb[(q + 1) & 1]);
      const int bj = q >> 1, ai = q & 1, col = bcol + bj * HALF + wc * 32 + 8 * fq;
#pragma unroll
      for (int m = 0; m < 4; ++m) {
        const size_t o = (size_t)(brow + ai * HALF + wr * 64 + m * 16 + fr) * D_MODEL + col;
        *(f32x4*)(O + o) = xb[q & 1][m][0] + g[bj][0] * acc[ai][bj][m][0];
        *(f32x4*)(O + o + 4) = xb[q & 1][m][1] + g[bj][1] * acc[ai][bj][m][1];
      }
    }
  }
};

template <int lda, int split_kt, int gap, int M, int N, int K, class Epi>
DI void gemm_phase(LAS unsigned char* lds, const bf16_t* __restrict__ A, const bf16_t* __restrict__ Bt, const Epi& epi) {
#define SA(b, h) (((b) * 2 + (h)) * (HT * 2))
#define SB(b, h) ((4 + (b) * 2 + (h)) * (HT * 2))
#define STAGE_A(P, br, kt) do { const char* _g = (const char*)(A + (size_t)(br) * lda + (kt) * BK + ((kt) >= split_kt ? gap : 0)); \
    _Pragma("unroll") for (int _i = 0; _i < 2; ++_i) { \
      __builtin_amdgcn_global_load_lds((const unsigned*)(_g + aoff[_i]), (LAS unsigned*)(lds + (P) + ldsw + _i * 8192), 16, 0, 0); } } while (0)
#define STAGE_B(P, br, kt) do { const char* _g = (const char*)(Bt + (size_t)(br) * K + (kt) * BK); \
    _Pragma("unroll") for (int _i = 0; _i < 2; ++_i) { \
      __builtin_amdgcn_global_load_lds((const unsigned*)(_g + boff[_i]), (LAS unsigned*)(lds + (P) + ldsw + _i * 8192), 16, 0, 0); } } while (0)
#define LDA(dst, b, h) _Pragma("unroll") for (int m = 0; m < 4; ++m) _Pragma("unroll") for (int k = 0; k < 2; ++k) \
    dst[m][k] = *(const LAS bf16x8*)(lds + SA(b, h) + ra + m * 2048 + k * 1024)
#define LDB(dst, b, h) _Pragma("unroll") for (int n = 0; n < 2; ++n) _Pragma("unroll") for (int k = 0; k < 2; ++k) \
    dst[n][k] = *(const LAS bf16x8*)(lds + SB(b, h) + rb + n * 2048 + k * 1024)
#define MMA(ai, bj, At, Bf) do { __builtin_amdgcn_s_setprio(1); \
    _Pragma("unroll") for (int m = 0; m < 4; ++m) _Pragma("unroll") for (int n = 0; n < 2; ++n) _Pragma("unroll") for (int k = 0; k < 2; ++k) \
      acc[ai][bj][m][n] = __builtin_amdgcn_mfma_f32_16x16x32_bf16(Bf[n][k], At[m][k], acc[ai][bj][m][n], 0, 0, 0); \
    __builtin_amdgcn_s_setprio(0); } while (0)
#define WAIT_V(n) asm volatile("s_waitcnt vmcnt(" #n ")" ::: "memory")
#define WAIT_L(n) asm volatile("s_waitcnt lgkmcnt(" #n ")" ::: "memory")
#define BAR __builtin_amdgcn_s_barrier()
#define SCHED __builtin_amdgcn_sched_barrier(0)
  const int nM = M / BM, nN = N / BM, nwg = nM * nN;
  const int gtid = opaque_tid();
  const int wid = __builtin_amdgcn_readfirstlane(gtid >> 6), lane = gtid & 63, wr = wid >> 2, wc = wid & 3, fr = lane & 15, fq = lane >> 4;
  constexpr int nt = K / BK;
  const unsigned ldsw = (unsigned)wid * 1024u;
  const int ra = lds_byte(wr * 64 + fr, fq * 8), rb = lds_byte(wc * 32 + fr, fq * 8);
  unsigned aoff[2], boff[2];
#pragma unroll
  for (int i = 0; i < 2; ++i) { int r_, c_; stage_rc(gtid * 16 + i * 8192, r_, c_); aoff[i] = (unsigned)(r_ * lda + c_) * 2u; boff[i] = (unsigned)(r_ * K + c_) * 2u; }
  auto decode = [&](int L, int& brow_, int& bcol_) __attribute__((always_inline)) {
    int wgid = L;
    { const int q = nwg / NXCD, r = nwg % NXCD, xcd = wgid % NXCD, off = wgid / NXCD; wgid = (xcd < r ? xcd * (q + 1) : r * (q + 1) + (xcd - r) * q) + off; }
    const int nig = WGM * nN, gid = wgid / nig, fm = gid * WGM, gsz = min(nM - fm, WGM);
    const int pm = fm + ((wgid % nig) % gsz), pn = (wgid % nig) / gsz; brow_ = pm * BM; bcol_ = pn * BM;
  };
  int L = blockIdx.x;
  if (L < nwg) {
    int brow, bcol; decode(L, brow, bcol);
    f32x4 acc[2][2][4][2];
#pragma unroll
    for (int a = 0; a < 2; ++a)
#pragma unroll
      for (int b = 0; b < 2; ++b)
#pragma unroll
        for (int m = 0; m < 4; ++m)
#pragma unroll
          for (int n = 0; n < 2; ++n) acc[a][b][m][n] = (f32x4){0.f, 0.f, 0.f, 0.f};
    bf16x8 At[4][2], B0[2][2], B1[2][2];
    STAGE_B(SB(0, 0), bcol, 0); STAGE_A(SA(0, 0), brow, 0);
    STAGE_B(SB(0, 1), bcol + HALF, 0); STAGE_A(SA(0, 1), brow + HALF, 0);
    if (wr == 1) BAR;
    WAIT_V(4); BAR;
    STAGE_B(SB(1, 0), bcol, 1); STAGE_A(SA(1, 0), brow, 1); STAGE_B(SB(1, 1), bcol + HALF, 1);
    WAIT_V(6); BAR;
#pragma unroll 1
    for (;;) {
      const int Ln = L + gridDim.x;
      int nrow = brow, ncol = bcol;
      if (Ln < nwg) decode(Ln, nrow, ncol);
#pragma unroll 1
      for (int t = 0; t < nt; t += 2) {
        const bool last = (t == nt - 2);
        const int r2 = last ? nrow : brow, c2 = last ? ncol : bcol, k2 = last ? 0 : t + 2, k3 = last ? 1 : t + 3;
        LDB(B0, 0, 0); SCHED; LDA(At, 0, 0); STAGE_A(SA(1, 1), brow + HALF, t + 1);
        WAIT_L(8); BAR; WAIT_L(0); MMA(0, 0, At, B0); BAR; SCHED;
        LDB(B1, 0, 1); STAGE_B(SB(0, 0), c2, k2);
        BAR; WAIT_L(0); MMA(0, 1, At, B1); BAR;
        LDA(At, 0, 1); STAGE_A(SA(0, 0), r2, k2);
        BAR; WAIT_L(0); MMA(1, 0, At, B0); BAR; SCHED;
        STAGE_B(SB(0, 1), c2 + HALF, k2);
        WAIT_V(6); BAR; MMA(1, 1, At, B1); BAR;
        LDB(B0, 1, 0); SCHED; LDA(At, 1, 0); STAGE_A(SA(0, 1), r2 + HALF, k2);
        WAIT_L(8); BAR; WAIT_L(0); MMA(0, 0, At, B0); BAR; SCHED;
        LDB(B1, 1, 1); STAGE_B(SB(1, 0), c2, k3);
        BAR; WAIT_L(0); MMA(0, 1, At, B1); BAR;
        LDA(At, 1, 1); STAGE_A(SA(1, 0), r2, k3);
        BAR; WAIT_L(0); MMA(1, 0, At, B0); BAR; SCHED;
        STAGE_B(SB(1, 1), c2 + HALF, k3);
        WAIT_V(6); BAR; MMA(1, 1, At, B1); BAR;
      }
      epi(acc, brow, bcol, wr, wc, fr, fq);
#pragma unroll
      for (int a = 0; a < 2; ++a)
#pragma unroll
        for (int b = 0; b < 2; ++b)
#pragma unroll
          for (int m = 0; m < 4; ++m)
#pragma unroll
            for (int n = 0; n < 2; ++n) acc[a][b][m][n] = (f32x4){0.f, 0.f, 0.f, 0.f};
      if (Ln >= nwg) break;
      L = Ln; brow = nrow; bcol = ncol;
    }
    WAIT_V(0);
    if (wr == 0) BAR;
  }
  __syncthreads();
#undef SA
#undef SB
}

DI void attn_unit(const Params& p, char* smem, int unit) {
  const int kvh = unit & 3, nb = (unit >> 2) & 15, b = unit >> 6;
  bf16_t* proj = (bf16_t*)(p.ws + WS_PROJ);
  const float* rope = (const float*)(p.ws + WS_ROPE);
  bf16_t* Ks = (bf16_t*)smem;
  bf16_t* Vr = (bf16_t*)(smem + 36864);
  const int tid = opaque_tid(), lane = tid & 63, wave = tid >> 6;
  {
    const int key = tid >> 1, half = tid & 1;
    const int tokl = nb * 128 - 128 + key;
    u32x4 o0 = {0, 0, 0, 0}, o1 = o0, o2 = o0, o3 = o0;
    u32x4 v0 = o0, v1 = o0, v2 = o0, v3 = o0;
    if (tokl >= 0) {
      const size_t tok = (size_t)b * SEQ + tokl;
      const bf16_t* kp = proj + PB_AK + tok * 256 + kvh * 64 + 16 * half;
      const u32x4 r0 = *(const u32x4*)kp, r1 = *(const u32x4*)(kp + 8), r2 = *(const u32x4*)(kp + 32), r3 = *(const u32x4*)(kp + 40);
      const bf16_t* vp = proj + PB_AV + tok * 256 + kvh * 64 + 32 * half;
      v0 = *(const u32x4*)vp; v1 = *(const u32x4*)(vp + 8); v2 = *(const u32x4*)(vp + 16); v3 = *(const u32x4*)(vp + 24);
      float x1[16], x2[16];
#pragma unroll
      for (int i = 0; i < 4; ++i) { x1[2 * i] = bf_lo(r0[i]); x1[2 * i + 1] = bf_hi(r0[i]); x1[8 + 2 * i] = bf_lo(r1[i]); x1[8 + 2 * i + 1] = bf_hi(r1[i]);
                                    x2[2 * i] = bf_lo(r2[i]); x2[2 * i + 1] = bf_hi(r2[i]); x2[8 + 2 * i] = bf_lo(r3[i]); x2[8 + 2 * i + 1] = bf_hi(r3[i]); }
      float ss = 0.f;
#pragma unroll
      for (int j = 0; j < 16; ++j) ss += x1[j] * x1[j] + x2[j] * x2[j];
      ss += __shfl_xor(ss, 1);
      const float rstd = rsqrtf(ss * (1.0f / 64.0f) + EPS);
      const float* cs = rope + tok * 64 + 16 * half;
      const float* kw = p.k_norm_w + 16 * half;
      float y1[16], y2[16];
#pragma unroll
      for (int j = 0; j < 16; ++j) {
        const float a1 = x1[j] * rstd * kw[j], a2 = x2[j] * rstd * kw[32 + j], c = cs[j], s = cs[32 + j];
        y1[j] = a1 * c - a2 * s; y2[j] = a2 * c + a1 * s;
      }
      o0 = (u32x4){pk_bf16(y1[0], y1[1]), pk_bf16(y1[2], y1[3]), pk_bf16(y1[4], y1[5]), pk_bf16(y1[6], y1[7])};
      o1 = (u32x4){pk_bf16(y1[8], y1[9]), pk_bf16(y1[10], y1[11]), pk_bf16(y1[12], y1[13]), pk_bf16(y1[14], y1[15])};
      o2 = (u32x4){pk_bf16(y2[0], y2[1]), pk_bf16(y2[2], y2[3]), pk_bf16(y2[4], y2[5]), pk_bf16(y2[6], y2[7])};
      o3 = (u32x4){pk_bf16(y2[8], y2[9]), pk_bf16(y2[10], y2[11]), pk_bf16(y2[12], y2[13]), pk_bf16(y2[14], y2[15])};
    }
    bf16_t* kd = Ks + key * 72 + 16 * half;
    *(u32x4*)kd = o0; *(u32x4*)(kd + 8) = o1; *(u32x4*)(kd + 32) = o2; *(u32x4*)(kd + 40) = o3;
    bf16_t* vd = Vr + key * 96 + 32 * half;
    *(u32x4*)vd = v0; *(u32x4*)(vd + 8) = v1; *(u32x4*)(vd + 16) = v2; *(u32x4*)(vd + 24) = v3;
  }
  __syncthreads();
  const int r = lane & 31, h = lane >> 5;
  const bf16_t* vtb = Vr + (((lane >> 5) * 4 + ((lane & 15) >> 2)) * 96 + 16 * ((lane >> 4) & 1) + 4 * (lane & 3));
  constexpr float LOG2E = 1.4426950408889634f;
#pragma unroll 1
  for (int it = 0; it < 2; ++it) {
    const int item = wave * 2 + it, g = item >> 2, qs = item & 3;
    const int head = kvh * 4 + g;
    const size_t tok = (size_t)b * SEQ + nb * 128 + qs * 32 + r;
    bf16x8 qf[4];
    u32x4 gr[4];
    bf16_t* gbase = proj + PB_AG + ((size_t)b * SEQ + nb * 128 + qs * 32 + (lane >> 3)) * 1024 + head * 64 + (lane & 7) * 8;
#pragma unroll
    for (int i = 0; i < 4; ++i) gr[i] = *(const u32x4*)(gbase + (size_t)(8 * i) * 1024);
    {
      const u32x4* qp = (const u32x4*)(proj + PB_AQ + tok * 1024 + head * 64 + 8 * h);
      float xq[4][8]; float ss = 0.f;
#pragma unroll
      for (int s = 0; s < 4; ++s) { const u32x4 rr = qp[2 * s];
#pragma unroll
        for (int i = 0; i < 4; ++i) { xq[s][2 * i] = bf_lo(rr[i]); xq[s][2 * i + 1] = bf_hi(rr[i]); } }
#pragma unroll
      for (int s = 0; s < 4; ++s)
#pragma unroll
        for (int j = 0; j < 8; ++j) ss += xq[s][j] * xq[s][j];
      ss += __shfl_xor(ss, 32);
      const float rstd = rsqrtf(ss * (1.0f / 64.0f) + EPS) * (0.125f * LOG2E);
      const float* cs = rope + tok * 64 + 8 * h;
      const float* qw = p.q_norm_w + 8 * h;
#pragma unroll
      for (int s = 0; s < 2; ++s) {
        float ya[8], yb[8];
#pragma unroll
        for (int j = 0; j < 8; ++j) {
          const float a1 = xq[s][j] * rstd * qw[16 * s + j], a2 = xq[s + 2][j] * rstd * qw[32 + 16 * s + j], c = cs[16 * s + j], sn = cs[32 + 16 * s + j];
          ya[j] = a1 * c - a2 * sn; yb[j] = a2 * c + a1 * sn;
        }
        qf[s] = pack8(ya[0], ya[1], ya[2], ya[3], ya[4], ya[5], ya[6], ya[7]);
        qf[s + 2] = pack8(yb[0], yb[1], yb[2], yb[3], yb[4], yb[5], yb[6], yb[7]);
      }
    }
    f32x16 sacc[5];
#pragma unroll
    for (int kt = 0; kt < 5; ++kt) {
#pragma unroll
      for (int i = 0; i < 16; ++i) sacc[kt][i] = 0.f;
#pragma unroll
      for (int s = 0; s < 4; ++s) {
        const bf16x8 a = *(const bf16x8*)(Ks + (qs * 32 + kt * 32 + r) * 72 + 16 * s + 8 * h);
        sacc[kt] = MFMA32(a, qf[s], sacc[kt]);
      }
    }
    const float sinkv = p.sinks[head] * LOG2E;
    float m = -INFINITY;
#pragma unroll
    for (int kt = 0; kt < 5; ++kt) {
      const bool tile_ok = (nb > 0) || (qs * 32 + kt * 32 >= 128);
#pragma unroll
      for (int i = 0; i < 16; ++i) {
        const int cr = (i & 3) + 8 * (i >> 2) + 4 * h;
        bool ok = tile_ok;
        if (kt == 0) ok = ok && (cr > r);
        if (kt == 4) ok = ok && (cr <= r);
        const float v = ok ? sacc[kt][i] : -INFINITY;
        sacc[kt][i] = v; m = fmaxf(m, v);
      }
    }
    m = fmaxf(m, __shfl_xor(m, 32)); m = fmaxf(m, sinkv);
    float l = 0.f;
#pragma unroll
    for (int kt = 0; kt < 5; ++kt)
#pragma unroll
      for (int i = 0; i < 16; ++i) { const float pv = __builtin_amdgcn_exp2f(sacc[kt][i] - m); sacc[kt][i] = pv; l += pv; }
    l += __shfl_xor(l, 32); l += __builtin_amdgcn_exp2f(sinkv - m);
    f32x16 oacc[2];
#pragma unroll
    for (int i = 0; i < 16; ++i) { oacc[0][i] = 0.f; oacc[1][i] = 0.f; }
#pragma unroll
    for (int kt = 0; kt < 5; ++kt)
#pragma unroll
      for (int s = 0; s < 2; ++s) {
        const bf16x8 pb = pack8(sacc[kt][8 * s], sacc[kt][8 * s + 1], sacc[kt][8 * s + 2], sacc[kt][8 * s + 3], sacc[kt][8 * s + 4], sacc[kt][8 * s + 5], sacc[kt][8 * s + 6], sacc[kt][8 * s + 7]);
#pragma unroll
        for (int ht = 0; ht < 2; ++ht) {
          const bf16_t* vp = vtb + (qs * 32 + kt * 32 + 16 * s) * 96 + ht * 32;
          const s16x4 lo = __builtin_amdgcn_ds_read_tr16_b64_v4i16((LAS s16x4*)vp), hi = __builtin_amdgcn_ds_read_tr16_b64_v4i16((LAS s16x4*)(vp + 8 * 96));
          const bf16x8 av = __builtin_shufflevector(lo, hi, 0, 1, 2, 3, 4, 5, 6, 7);
          oacc[ht] = MFMA32(av, pb, oacc[ht]);
        }
      }
    const float inv = fast_rcp(l);
    bf16_t* Os = (bf16_t*)(smem + 86016) + wave * (32 * 72);
#pragma unroll
    for (int ht = 0; ht < 2; ++ht)
#pragma unroll
      for (int g4 = 0; g4 < 4; ++g4) {
        const u32x2 w = {pk_bf16(oacc[ht][4 * g4] * inv, oacc[ht][4 * g4 + 1] * inv), pk_bf16(oacc[ht][4 * g4 + 2] * inv, oacc[ht][4 * g4 + 3] * inv)};
        *(u32x2*)(Os + r * 72 + ht * 32 + 8 * g4 + 4 * h) = w;
      }
    __builtin_amdgcn_wave_barrier();
    asm volatile("s_waitcnt lgkmcnt(0)" ::: "memory");
#pragma unroll
    for (int i = 0; i < 4; ++i) {
      const u32x4 ov = *(const u32x4*)(Os + ((lane >> 3) + 8 * i) * 72 + (lane & 7) * 8);
      const u32x4 gv = gr[i];
      u32x4 w;
#pragma unroll
      for (int j = 0; j < 4; ++j) w[j] = pk_bf16(bf_lo(ov[j]) * bf_lo(gv[j]), bf_hi(ov[j]) * bf_hi(gv[j]));
      if (p.st_m) *(u32x4*)(gbase + (size_t)(8 * i) * 1024) = w;
    }
    __builtin_amdgcn_wave_barrier();
  }
  __syncthreads();
}

struct HgrnRegs { unsigned rq[8], rf[8]; };
DI void hgrn_chunk_load(HgrnRegs& R, const bf16_t* proj, int u, int seg, int kp) {
  const int hh = u & 7, c = (u >> 3) & 31, b = u >> 8;
  const size_t tok0 = (size_t)b * SEQ + c * 64;
#pragma unroll
  for (int j = 0; j < 8; ++j) {
    const bf16_t* base = proj + (tok0 + 8 * seg + j) * 1024 + hh * 128 + 2 * kp;
    R.rq[j] = __builtin_nontemporal_load((const unsigned*)(base + PB_RQ)); R.rf[j] = __builtin_nontemporal_load((const unsigned*)(base + PB_RF));
  }
}
DI void phase_hgrn_chunk(const Params& p, char* smem) {
  bf16_t* proj = (bf16_t*)(p.ws + WS_PROJ);
  bf16_t* Hb = (bf16_t*)(p.ws + WS_H);
  float* DL = (float*)(p.ws + WS_DL);
  bf16_t* QD = (bf16_t*)smem;
  bf16_t* KI = (bf16_t*)(smem + 17408);
  bf16_t* KoT = (bf16_t*)(smem + 34816);
  bf16_t* VT = (bf16_t*)(smem + 53248);
  bf16_t* Am = (bf16_t*)(smem + 71680);
  f32x4* segp = (f32x4*)(smem + 80896);
  float* Ob = (float*)(smem + 89600);
  const int tid = opaque_tid(), lane = tid & 63, wave = tid >> 6;
  const int kp = lane, seg = wave;
  const int c16 = lane & 15, q4 = lane >> 4;
  const int ft = tid >> 3, fv = (tid & 7) * 16;
  HgrnRegs R;
  if ((int)blockIdx.x < 4096) hgrn_chunk_load(R, proj, blockIdx.x, seg, kp);
#pragma unroll 1
  for (int u = blockIdx.x; u < 4096; u += gridDim.x) {
    const int hh = u & 7, c = (u >> 3) & 31, b = u >> 8;
    const size_t tok0 = (size_t)b * SEQ + c * 64;
    float lb0, lb1;
    {
      const f32x2 l0 = *(const f32x2*)(p.lower_bounds + hh * 128 + 2 * kp), l1 = *(const f32x2*)(p.lower_bounds + 1024 + hh * 128 + 2 * kp);
      lb0 = fast_rcp(1.f + fast_exp(l1[0] - l0[0])); lb1 = fast_rcp(1.f + fast_exp(l1[1] - l0[1]));
    }
    const f32x2 lbv = {lb0, lb1}, olb = {1.f - lb0, 1.f - lb1};
    f32x2 Ev[8], Iv[8], Kv[8];
    {
      f32x2 P = {1.f, 1.f}, Q = {1.f, 1.f};
#pragma unroll
      for (int j = 0; j < 8; ++j) {
        const float x0 = __builtin_amdgcn_fmed3f(bf_lo(R.rf[j]), -30.f, 30.f), x1 = __builtin_amdgcn_fmed3f(bf_hi(R.rf[j]), -30.f, 30.f);
        const f32x2 e = {__builtin_amdgcn_exp2f(x0 * -1.4426950408889634f), __builtin_amdgcn_exp2f(x1 * -1.4426950408889634f)};
        const f32x2 a1 = e + 1.f, a2 = lbv * e + 1.f, pr = a1 * a2;
        const f32x2 w = {fast_rcp(pr[0]), fast_rcp(pr[1])};
        const f32x2 r = w * a2;
        Kv[j] = olb * e * r;
        P = P * (a2 * r); Q = Q * (a1 * a1 * w);
        Ev[j] = P; Iv[j] = Q;
      }
      segp[seg * 64 + kp] = (f32x4){P[0], P[1], Q[0], Q[1]};
    }
    __syncthreads();
    {
      f32x2 pre = {1.f, 1.f}, pin = {1.f, 1.f}, tot = {1.f, 1.f};
#pragma unroll
      for (int s2 = 0; s2 < 8; ++s2) {
        const f32x4 v = segp[s2 * 64 + kp];
        const f32x2 vp = {v[0], v[1]}, vq = {v[2], v[3]};
        if (s2 < seg) { pre = pre * vp; pin = pin * vq; }
        tot = tot * vp;
      }
      f32x2 ko[8];
#pragma unroll
      for (int j = 0; j < 8; ++j) {
        const f32x2 Ea = pre * Ev[j], ia = pin * Iv[j];
        const f32x2 qv = {bf_lo(R.rq[j]), bf_hi(R.rq[j])};
        const f32x2 qd2 = qv * Ea, ki = Kv[j] * ia;
        ko[j] = ki * tot;
        const unsigned qd = pk_bf16(qd2[0], qd2[1]);
        *(unsigned*)(QD + (8 * seg + j) * 136 + 2 * kp) = qd;
        if (p.st_a) *(unsigned*)(proj + PB_RQ + (tok0 + 8 * seg + j) * 1024 + hh * 128 + 2 * kp) = qd;
        *(unsigned*)(KI + (8 * seg + j) * 136 + 2 * kp) = pk_bf16(ki[0], ki[1]);
      }
      *(bf16x8*)(KoT + (2 * kp) * 72 + 8 * seg) = pack8(ko[0][0], ko[1][0], ko[2][0], ko[3][0], ko[4][0], ko[5][0], ko[6][0], ko[7][0]);
      *(bf16x8*)(KoT + (2 * kp + 1) * 72 + 8 * seg) = pack8(ko[0][1], ko[1][1], ko[2][1], ko[3][1], ko[4][1], ko[5][1], ko[6][1], ko[7][1]);
      if (seg == 0 && p.st_a) { *(f32x2*)(DL + (size_t)u * 128 + 2 * kp) = tot; }
    }
    if (u + (int)gridDim.x < 4096) hgrn_chunk_load(R, proj, u + gridDim.x, seg, kp);
    __syncthreads();
    {
      const int ti = wave >> 1;
#pragma unroll
      for (int uu = 0; uu < 2; ++uu) {
        const int si = 2 * (wave & 1) + uu;
        f32x4 acc = {0.f, 0.f, 0.f, 0.f};
        if (si <= ti) {
#pragma unroll
          for (int ks = 0; ks < 4; ++ks) {
            const bf16x8 a = *(const bf16x8*)(QD + (16 * ti + c16) * 136 + 32 * ks + 8 * q4);
            const bf16x8 bb = *(const bf16x8*)(KI + (16 * si + c16) * 136 + 32 * ks + 8 * q4);
            acc = MFMA16(a, bb, acc);
          }
        }
#pragma unroll
        for (int j = 0; j < 4; ++j) {
          const int t = 16 * ti + 4 * q4 + j, s = 16 * si + c16;
          const float v = (s <= t) ? acc[j] : 0.f;
          Am[t * 72 + s] = (bf16_t)(pk_bf16(v, 0.f) & 0xffffu);
        }
      }
    }
    __syncthreads();
    {
#pragma unroll
      for (int i = 0; i < 2; ++i) {
        const int idx = tid + 512 * i, k = idx >> 3, t8 = (idx & 7) * 8;
        const u32x4 w = *(const u32x4*)(KoT + k * 72 + t8);
        if (p.st_a) *(u32x4*)(proj + PB_RF + (tok0 + (k >> 1)) * 1024 + hh * 128 + (k & 1) * 64 + t8) = w;
      }
      const int t = tid >> 3, s8 = (tid & 7) * 8;
      const u32x4 w = *(const u32x4*)(Am + t * 72 + s8);
      if (p.st_a) *(u32x4*)(Hb + ((size_t)u * 64 + t) * 64 + s8) = w;
    }
  }
  __syncthreads();
}

struct ScanRegs { u32x4 qd[2]; u32x4 ko[2]; u32x4 am; unsigned rv[8]; };
DI void hgrn_scan_load(ScanRegs& R, const Params& p, int b, int hh, int c, int tid) {
  const bf16_t* proj = (const bf16_t*)(p.ws + WS_PROJ);
  const bf16_t* Hb = (const bf16_t*)(p.ws + WS_H);
  const int lane = tid & 63, wave = tid >> 6;
  const size_t tok0 = (size_t)b * SEQ + c * 64;
  const size_t u = (size_t)(b * 32 + c) * 8 + hh;
#pragma unroll
  for (int i = 0; i < 2; ++i) {
    const int idx = tid + 512 * i;
    R.qd[i] = __builtin_nontemporal_load((const u32x4*)(proj + PB_RQ + (tok0 + (idx >> 4)) * 1024 + hh * 128 + (idx & 15) * 8));
    const int k = idx >> 3, t8 = (idx & 7) * 8;
    R.ko[i] = __builtin_nontemporal_load((const u32x4*)(proj + PB_RF + (tok0 + (k >> 1)) * 1024 + hh * 128 + (k & 1) * 64 + t8));
  }
  R.am = __builtin_nontemporal_load((const u32x4*)(Hb + (u * 64 + (tid >> 3)) * 64 + (tid & 7) * 8));
#pragma unroll
  for (int j = 0; j < 8; ++j) R.rv[j] = __builtin_nontemporal_load((const unsigned*)(proj + PB_RI + (tok0 + 8 * wave + j) * 1024 + hh * 128 + 2 * lane));
}
DI void hgrn_scan_unit(const Params& p, char* smem, int unit) {
  const int hh = unit & 7, b = unit >> 3;
  bf16_t* proj = (bf16_t*)(p.ws + WS_PROJ);
  bf16_t* QD = (bf16_t*)smem;
  bf16_t* KoT = (bf16_t*)(smem + 17408);
  bf16_t* VT = (bf16_t*)(smem + 35840);
  bf16_t* Am = (bf16_t*)(smem + 54272);
  float* dla = (float*)(smem + 97792);
  float* Ob = (float*)(smem + 64000);
  const int tid = opaque_tid(), lane = tid & 63, wave = tid >> 6;
  const int c16 = lane & 15, q4 = lane >> 4;
  const int ft = tid >> 3, fv = (tid & 7) * 16;
  const int vcol = 16 * wave + c16;
  f32x4 S[8];
#pragma unroll
  for (int i = 0; i < 8; ++i) S[i] = (f32x4){0.f, 0.f, 0.f, 0.f};
  ScanRegs R0, R1;
  hgrn_scan_load(R0, p, b, hh, 0, tid);
  hgrn_scan_load(R1, p, b, hh, 1, tid);
  {
    const float* DL = (const float*)(p.ws + WS_DL);
#pragma unroll
    for (int i = 0; i < 2; ++i) { const int idx = tid + 512 * i, c = idx >> 5, k4 = (idx & 31) * 4; *(f32x4*)(dla + c * 128 + k4) = *(const f32x4*)(DL + ((size_t)(b * 32 + c) * 8 + hh) * 128 + k4); }
  }
  auto body = [&](const int c, ScanRegs& C) __attribute__((always_inline)) {
    const size_t tok0 = (size_t)b * SEQ + c * 64;
#pragma unroll
    for (int i = 0; i < 2; ++i) {
      const int idx = tid + 512 * i;
      *(u32x4*)(QD + (idx >> 4) * 136 + (idx & 15) * 8) = C.qd[i];
      *(u32x4*)(KoT + (idx >> 3) * 72 + (idx & 7) * 8) = C.ko[i];
    }
    *(u32x4*)(Am + (tid >> 3) * 72 + (tid & 7) * 8) = C.am;
    {
      u32x4 wl, wh;
#pragma unroll
      for (int i = 0; i < 4; ++i) { wl[i] = (C.rv[2 * i] & 0xffffu) | (C.rv[2 * i + 1] << 16); wh[i] = (C.rv[2 * i] >> 16) | (C.rv[2 * i + 1] & 0xffff0000u); }
      *(u32x4*)(VT + (2 * lane) * 72 + 8 * wave) = wl;
      *(u32x4*)(VT + (2 * lane + 1) * 72 + 8 * wave) = wh;
    }
    if (c + 2 < 32) hgrn_scan_load(C, p, b, hh, c + 2, tid);
    const float* dl = dla + c * 128;
    u32x4 rg[2];
    __syncthreads();
    {
      bf16x8 bv[2];
#pragma unroll
      for (int ks = 0; ks < 2; ++ks) bv[ks] = *(const bf16x8*)(VT + vcol * 72 + 32 * ks + 8 * q4);
#pragma unroll
      for (int th = 0; th < 2; ++th) {
        f32x4 o[2];
#pragma unroll
        for (int i = 0; i < 2; ++i) o[i] = (f32x4){0.f, 0.f, 0.f, 0.f};
#pragma unroll
        for (int kq = 0; kq < 4; ++kq) {
          const bf16x8 sf = pack8(S[2 * kq][0], S[2 * kq][1], S[2 * kq][2], S[2 * kq][3], S[2 * kq + 1][0], S[2 * kq + 1][1], S[2 * kq + 1][2], S[2 * kq + 1][3]);
#pragma unroll
          for (int t2 = 0; t2 < 2; ++t2) {
            const int ti = 2 * th + t2;
            const bf16_t* ap = QD + (16 * ti + c16) * 136 + 32 * kq + 4 * q4;
            const u32x2 lo = *(const u32x2*)ap, hi = *(const u32x2*)(ap + 16);
            const u32x4 av = {lo[0], lo[1], hi[0], hi[1]};
            o[t2] = MFMA16(__builtin_bit_cast(bf16x8, av), sf, o[t2]);
          }
        }
#pragma unroll
        for (int t2 = 0; t2 < 2; ++t2)
#pragma unroll
          for (int ks = 0; ks < 2; ++ks) {
            const bf16x8 a = *(const bf16x8*)(Am + (16 * (2 * th + t2) + c16) * 72 + 32 * ks + 8 * q4);
            o[t2] = MFMA16(a, bv[ks], o[t2]);
          }
#pragma unroll
        for (int t2 = 0; t2 < 2; ++t2)
#pragma unroll
          for (int j = 0; j < 4; ++j) Ob[(16 * (2 * th + t2) + 4 * q4 + j) * 132 + vcol] = o[t2][j];
        __builtin_amdgcn_sched_barrier(0);
      }
      {
        const bf16_t* gq = proj + PB_RG + (tok0 + ft) * 1024 + hh * 128 + fv;
        rg[0] = __builtin_nontemporal_load((const u32x4*)gq); rg[1] = __builtin_nontemporal_load((const u32x4*)(gq + 8));
      }
#pragma unroll
      for (int kt = 0; kt < 8; ++kt) {
        const f32x4 d = *(const f32x4*)(dl + 16 * kt + 4 * q4);
        S[kt] = S[kt] * d;
#pragma unroll
        for (int ks = 0; ks < 2; ++ks) {
          const bf16x8 a = *(const bf16x8*)(KoT + (16 * kt + c16) * 72 + 32 * ks + 8 * q4);
          S[kt] = MFMA16(a, bv[ks], S[kt]);
        }
        if (kt & 1) __builtin_amdgcn_sched_barrier(0);
      }
    }
    __syncthreads();
    {
      f32x4 ov[4]; float ss = 0.f;
#pragma unroll
      for (int i = 0; i < 4; ++i) { ov[i] = *(const f32x4*)(Ob + ft * 132 + fv + 4 * i); ss += ov[i][0] * ov[i][0] + ov[i][1] * ov[i][1] + ov[i][2] * ov[i][2] + ov[i][3] * ov[i][3]; }
      ss += __shfl_xor(ss, 1); ss += __shfl_xor(ss, 2); ss += __shfl_xor(ss, 4);
      const float rstd = rsqrtf(ss * (1.0f / 128.0f) + EPS);
      float y[16];
#pragma unroll
      for (int i = 0; i < 4; ++i) {
        const f32x4 w = *(const f32x4*)(p.rec_norm_w + fv + 4 * i);
        const unsigned ga = (i < 2) ? rg[0][2 * i] : rg[1][2 * (i - 2)], gb = (i < 2) ? rg[0][2 * i + 1] : rg[1][2 * (i - 2) + 1];
        y[4 * i + 0] = ov[i][0] * rstd * w[0] * bf_lo(ga);
        y[4 * i + 1] = ov[i][1] * rstd * w[1] * bf_hi(ga);
        y[4 * i + 2] = ov[i][2] * rstd * w[2] * bf_lo(gb);
        y[4 * i + 3] = ov[i][3] * rstd * w[3] * bf_hi(gb);
      }
      bf16_t* gp = proj + PB_RG + (tok0 + ft) * 1024 + hh * 128 + fv;
      if (p.st_m) {
      *(bf16x8*)gp = pack8(y[0], y[1], y[2], y[3], y[4], y[5], y[6], y[7]);
      *(bf16x8*)(gp + 8) = pack8(y[8], y[9], y[10], y[11], y[12], y[13], y[14], y[15]);
      }
    }
  };
#pragma unroll 1
  for (int c = 0; c < 32; c += 2) { body(c, R0); body(c + 1, R1); }
  __syncthreads();
}

DI void phase_mix(const Params& p, char* smem) {
  int* s_item = (int*)(smem + 131072);
  unsigned* ctr = (unsigned*)(p.ws + WS_CTRL) + CW_WORK;
  while (true) {
    if (threadIdx.x == 0) *s_item = (int)atomicAdd(ctr, 1u);
    __syncthreads();
    const int item = *s_item;
    __syncthreads();
    if (item >= 128 + 1024) break;
    if (item < 128) hgrn_scan_unit(p, smem, item); else attn_unit(p, smem, item - 128);
  }
}

DI void phase_gemm1(const Params& p, char* smem) {
  EpiProj e{(bf16_t*)(p.ws + WS_PROJ)};
  gemm_phase<D_MODEL, (1 << 30), 0, NTOK, IN_W, D_MODEL>((LAS unsigned char*)smem, (const bf16_t*)(p.ws + WS_H), (const bf16_t*)(p.ws + WS_WTIN), e);
}
DI void phase_gemm2(const Params& p, char* smem) {
  EpiOut e{p.out, p.x, (const float*)(p.ws + WS_MOD)};
  gemm_phase<1024, 16, (int)(PB_RG - PB_AG) - 1024, NTOK, D_MODEL, D_MIX>((LAS unsigned char*)smem, (const bf16_t*)(p.ws + WS_PROJ) + PB_AG, (const bf16_t*)(p.ws + WS_WTOUT), e);
}

extern __shared__ __attribute__((aligned(16))) char dyn_smem[];

#if ONE_LAUNCH
__global__ void __launch_bounds__(NTHREADS, 2) hymba_fwd(Params p) {
  cg::grid_group grid = cg::this_grid();
  volatile LAS unsigned* st = (volatile LAS unsigned*)((LAS unsigned char*)dyn_smem + 131072 + 16);
  if (threadIdx.x == 0) { st[0] = 0u; st[1] = 0u; }
  __syncthreads();
  const XcdBarrier xb = xcd_barrier_post((unsigned*)(p.ws + WS_XBAR), st);
  phase_prep(p, dyn_smem);
  phase_norm(p, dyn_smem);
  if (p.ws == nullptr) grid.sync();
  xcd_barrier(xb);
  phase_gemm1(p, dyn_smem);
  xcd_barrier(xb);
  phase_hgrn_chunk(p, dyn_smem);
  xcd_barrier(xb);
  phase_mix(p, dyn_smem);
  xcd_barrier(xb);
  phase_gemm2(p, dyn_smem);
}
#else
__global__ void __launch_bounds__(NTHREADS, 2) k_prep(Params p) { phase_prep(p, dyn_smem); }
__global__ void __launch_bounds__(NTHREADS, 2) k_norm(Params p) { phase_norm(p, dyn_smem); }
__global__ void __launch_bounds__(NTHREADS, 2) k_gemm1(Params p) { phase_gemm1(p, dyn_smem); }
__global__ void __launch_bounds__(NTHREADS, 2) k_hgrna(Params p) { phase_hgrn_chunk(p, dyn_smem); }
__global__ void __launch_bounds__(NTHREADS, 2) k_mix(Params p) { phase_mix(p, dyn_smem); }
__global__ void __launch_bounds__(NTHREADS, 2) k_gemm2(Params p) { phase_gemm2(p, dyn_smem); }
#endif

extern "C" void kernel_launch(void* const* d_in, const int* in_sizes, int n_in, void* d_out, int out_size, void* d_ws, size_t ws_size, hipStream_t stream) {
  static int grid = 0;
  if (grid == 0) {
    if (n_in != 13 || ws_size < WS_END) { fprintf(stderr, "kernel_launch: unexpected n_in %d or workspace %zu < %zu\n", n_in, ws_size, (size_t)WS_END); grid = -1; return; }
    int dev = 0, cus = 0, per_cu = 0;
    hipGetDevice(&dev);
    hipDeviceGetAttribute(&cus, hipDeviceAttributeMultiprocessorCount, dev);
#if ONE_LAUNCH
    if (hipFuncSetAttribute((const void*)hymba_fwd, hipFuncAttributeMaxDynamicSharedMemorySize, LDS_BYTES) != hipSuccess) { fprintf(stderr, "hipFuncSetAttribute failed\n"); grid = -1; return; }
    hipOccupancyMaxActiveBlocksPerMultiprocessor(&per_cu, (const void*)hymba_fwd, NTHREADS, LDS_BYTES);
    if (per_cu < 1) { fprintf(stderr, "occupancy query says %d blocks per CU\n", per_cu); per_cu = 1; }
    grid = cus * per_cu;
#else
    hipFuncSetAttribute((const void*)k_prep, hipFuncAttributeMaxDynamicSharedMemorySize, LDS_BYTES);
    hipFuncSetAttribute((const void*)k_gemm1, hipFuncAttributeMaxDynamicSharedMemorySize, LDS_BYTES);
    hipFuncSetAttribute((const void*)k_mix, hipFuncAttributeMaxDynamicSharedMemorySize, LDS_BYTES);
    hipFuncSetAttribute((const void*)k_hgrna, hipFuncAttributeMaxDynamicSharedMemorySize, LDS_BYTES);
    hipFuncSetAttribute((const void*)k_gemm2, hipFuncAttributeMaxDynamicSharedMemorySize, LDS_BYTES);
    (void)per_cu;
    grid = cus;
#endif
    (void)hipGetLastError();
  }
  if (grid < 0) return;
  (void)hipMemsetAsync((char*)d_ws + WS_CTRL, 0, 16384, stream);
  Params p{};
  p.x = (const float*)d_in[0]; p.c = (const float*)d_in[1]; p.pos = (const int*)d_in[2]; p.norm_w = (const float*)d_in[3];
  p.w_ada = (const float*)d_in[4]; p.b_ada = (const float*)d_in[5]; p.w_in = (const float*)d_in[6]; p.q_norm_w = (const float*)d_in[7];
  p.k_norm_w = (const float*)d_in[8]; p.sinks = (const float*)d_in[9]; p.rec_norm_w = (const float*)d_in[10];
  p.lower_bounds = (const float*)d_in[11]; p.w_out = (const float*)d_in[12]; p.out = (float*)d_out; p.ws = (char*)d_ws; p.st_a = 1; p.st_m = 1;
#if ONE_LAUNCH
  void* args[] = {&p};
  hipError_t e = hipLaunchCooperativeKernel((const void*)hymba_fwd, dim3(grid), dim3(NTHREADS), args, LDS_BYTES, stream);
  if (e != hipSuccess) fprintf(stderr, "cooperative launch failed: %s (grid %d)\n", hipGetErrorString(e), grid);
#else
  for (int r = 0; r < REP_PREP; ++r) hipLaunchKernelGGL(k_prep, dim3(grid), dim3(NTHREADS), LDS_BYTES, stream, p);
  for (int r = 0; r < REP_NORM; ++r) hipLaunchKernelGGL(k_norm, dim3(grid), dim3(NTHREADS), 16384, stream, p);
  for (int r = 0; r < REP_G1; ++r) hipLaunchKernelGGL(k_gemm1, dim3(grid), dim3(NTHREADS), LDS_BYTES, stream, p);
  for (int r = 0; r < REP_A; ++r) { p.st_a = (r == REP_A - 1); hipLaunchKernelGGL(k_hgrna, dim3(grid), dim3(NTHREADS), LDS_BYTES, stream, p); }
  for (int r = 0; r < REP_M; ++r) { p.st_m = (r == REP_M - 1); (void)hipMemsetAsync((char*)d_ws + WS_CTRL, 0, 16384, stream); hipLaunchKernelGGL(k_mix, dim3(grid), dim3(NTHREADS), LDS_BYTES, stream, p); }
  for (int r = 0; r < REP_G2; ++r) hipLaunchKernelGGL(k_gemm2, dim3(grid), dim3(NTHREADS), LDS_BYTES, stream, p);
#endif
}
```

```cpp
#include <hip/hip_runtime.h>
#include <hip/hip_cooperative_groups.h>
#include <cstdio>
#include <cstdint>
namespace cg = cooperative_groups;

#ifndef ONE_LAUNCH
#define ONE_LAUNCH 1
#endif

#define REP_PREP 1
#define REP_NORM 1
#define REP_G1 1
#define REP_G2 1
#define REP_A 1
#define REP_M 1
#define DI __device__ __forceinline__
typedef unsigned short bf16_t;
typedef short bf16x8 __attribute__((ext_vector_type(8)));
typedef float f32x4 __attribute__((ext_vector_type(4)));
typedef float f32x2 __attribute__((ext_vector_type(2)));
typedef float f32x16 __attribute__((ext_vector_type(16)));
typedef unsigned u32x4 __attribute__((ext_vector_type(4)));
typedef unsigned u32x2 __attribute__((ext_vector_type(2)));
typedef short s16x4 __attribute__((ext_vector_type(4)));
typedef __bf16 bf16x2_t __attribute__((ext_vector_type(2)));

constexpr int D_MODEL = 1024, BATCH = 16, SEQ = 2048, NTOK = BATCH * SEQ, IN_W = 6656, D_MIX = 2048;
constexpr int OFF_AQ = 0, OFF_AK = 1024, OFF_AV = 1280, OFF_AG = 1536, OFF_RQ = 2560, OFF_RF = 3584, OFF_RI = 4608, OFF_RG = 5632;
constexpr size_t PB_AQ = 0, PB_AK = PB_AQ + (size_t)NTOK * 1024, PB_AV = PB_AK + (size_t)NTOK * 256, PB_AG = PB_AV + (size_t)NTOK * 256,
                 PB_RQ = PB_AG + (size_t)NTOK * 1024, PB_RF = PB_RQ + (size_t)NTOK * 1024, PB_RI = PB_RF + (size_t)NTOK * 1024, PB_RG = PB_RI + (size_t)NTOK * 1024;
constexpr float EPS = 1e-6f;
constexpr int NTHREADS = 512;
constexpr int LDS_BYTES = 131072 + 256;

constexpr size_t MiB = 1024 * 1024;
constexpr size_t WS_CTRL = 0, WS_XBAR = 2048, WS_MOD = 16384, WS_ROPE = 1 * MiB, WS_WTIN = 9 * MiB, WS_WTOUT = 22 * MiB, WS_H = 26 * MiB, WS_PROJ = 90 * MiB, WS_DL = 506 * MiB,
                 WS_END = WS_DL + 2 * MiB;

struct Params {
  const float* x; const float* c; const int* pos; const float* norm_w; const float* w_ada; const float* b_ada;
  const float* w_in; const float* q_norm_w; const float* k_norm_w; const float* sinks; const float* rec_norm_w;
  const float* lower_bounds; const float* w_out; float* out; char* ws; int st_a; int st_m;
};

DI int opaque_tid() { int t = threadIdx.x; asm volatile("" : "+v"(t)); return t; }
DI unsigned pk_bf16(float lo, float hi) { f32x2 v = {lo, hi}; bf16x2_t b = __builtin_convertvector(v, bf16x2_t); return __builtin_bit_cast(unsigned, b); }
DI float bf_lo(unsigned u) { return __uint_as_float(u << 16); }
DI float bf_hi(unsigned u) { return __uint_as_float(u & 0xffff0000u); }
DI bf16x8 pack8(float a0, float a1, float a2, float a3, float a4, float a5, float a6, float a7) {
  u32x4 w = {pk_bf16(a0, a1), pk_bf16(a2, a3), pk_bf16(a4, a5), pk_bf16(a6, a7)}; return __builtin_bit_cast(bf16x8, w);
}
DI float fast_exp(float x) { return __builtin_amdgcn_exp2f(x * 1.4426950408889634f); }
DI float fast_rcp(float x) { return __builtin_amdgcn_rcpf(x); }
DI float silu(float x) { return x * fast_rcp(1.f + fast_exp(-x)); }
#define MFMA16(a, b, c) __builtin_amdgcn_mfma_f32_16x16x32_bf16((a), (b), (c), 0, 0, 0)
#define MFMA32(a, b, c) __builtin_amdgcn_mfma_f32_32x32x16_bf16((a), (b), (c), 0, 0, 0)

constexpr int CW_WORK = 0, CW_BAR1 = 64, CW_BAR2 = 128, CW_MOD = 192, CW_NORM = 320, CW_TR = 384;
#define XB_TMO      128
#define XB_XCNT(j)  (256  + 64 * (j))
#define XB_XSUB(j)  (1280 + 64 * (j))
#define XB_XGEN(j)  (2304 + 64 * (j))
#define XB_TOP      3328
#define XB_TOPGEN   3392
#define XCD_BAR_WORDS 3456
#define XB_SPIN_CAP (1u << 22)
#define LAS __attribute__((address_space(3)))
DI unsigned xb_ld(unsigned* p) { return __hip_atomic_load(p, __ATOMIC_RELAXED, __HIP_MEMORY_SCOPE_AGENT); }
DI unsigned xb_add(unsigned* p, unsigned v) { return __hip_atomic_fetch_add(p, v, __ATOMIC_RELAXED, __HIP_MEMORY_SCOPE_AGENT); }
DI unsigned xb_xcc_id() { return (unsigned)__builtin_amdgcn_s_getreg((3 << 11) | 20) & 0xFu; }
#define XB_SPIN(cond, bar) do { unsigned _sp = 0; while (cond) { __builtin_amdgcn_s_sleep(1); \
    if ((++_sp & 255u) == 0u) { if (xb_ld(&(bar)[XB_TMO])) break; if (_sp > XB_SPIN_CAP) { atomicAdd(&(bar)[XB_TMO], 1u); break; } } } } while (0)
struct XcdBarrier { unsigned* bar; unsigned x; volatile LAS unsigned* st; };
DI XcdBarrier xcd_barrier_post(unsigned* bar, volatile LAS unsigned* st) {
  XcdBarrier b; b.bar = bar; b.x = xb_xcc_id(); b.st = st;
  if (threadIdx.x == 0) (void)xb_add(&bar[XB_XCNT(b.x)], 1u);
  return b;
}
DI void xcd_barrier_complete(unsigned* bar, unsigned x, unsigned& nloc, unsigned& nx) {
  const unsigned G = gridDim.x;
  unsigned sum, cnt, mine, sp = 0u;
  for (;;) {
    sum = 0u; cnt = 0u; mine = 0u;
#pragma unroll
    for (unsigned j = 0; j < 16; ++j) { const unsigned c = xb_ld(&bar[XB_XCNT(j)]); sum += c; cnt += (c > 0u) ? 1u : 0u; mine = (j == x) ? c : mine; }
    if (sum == G) break;
    __builtin_amdgcn_s_sleep(1);
    if ((++sp & 255u) == 0u) { if (xb_ld(&bar[XB_TMO])) break; if (sp > XB_SPIN_CAP) { atomicAdd(&bar[XB_TMO], 1u); break; } }
  }
  nloc = mine > 0u ? mine : 1u; nx = cnt > 0u ? cnt : 1u;
}
DI void xcd_barrier(const XcdBarrier& b) {
  asm volatile("s_waitcnt vmcnt(0)" ::: "memory");
  __syncthreads();
  if (threadIdx.x == 0) {
    unsigned* bar = b.bar;
    __builtin_amdgcn_s_waitcnt(0);
    unsigned nloc = b.st[0], nx = b.st[1];
    if (nloc == 0u) { xcd_barrier_complete(bar, b.x, nloc, nx); b.st[0] = nloc; b.st[1] = nx; }
    const unsigned old = xb_add(&bar[XB_XSUB(b.x)], 1u);
    const unsigned gen = old / nloc;
    if (old + 1u == (gen + 1u) * nloc) {
      __builtin_amdgcn_fence(__ATOMIC_RELEASE, "agent");
      asm volatile("s_waitcnt vmcnt(0)" ::: "memory");
      const unsigned og = xb_add(&bar[XB_TOP], 1u);
      const unsigned tg = og / nx;
      if (og + 1u == (tg + 1u) * nx) xb_add(&bar[XB_TOPGEN], 1u);
      else XB_SPIN(xb_ld(&bar[XB_TOPGEN]) == tg, bar);
      __builtin_amdgcn_fence(__ATOMIC_ACQUIRE, "agent");
      xb_add(&bar[XB_XGEN(b.x)], 1u);
      asm volatile("s_waitcnt vmcnt(0)" ::: "memory");
    } else {
      XB_SPIN(xb_ld(&bar[XB_XGEN(b.x)]) == gen, bar);
      __builtin_amdgcn_fence(__ATOMIC_ACQUIRE, "agent");
      asm volatile("s_waitcnt vmcnt(0)" ::: "memory");
    }
  }
  __syncthreads();
}

DI void transpose_tile4(const float* __restrict__ W, int ldw, bf16_t* __restrict__ Wt, int ldt, int k0, int n0, float* tile, int tid) {
  f32x4 v[8];
#pragma unroll
  for (int pass = 0; pass < 8; ++pass) {
    const int r = (tid >> 4) + 32 * pass, c4 = (tid & 15) * 4;
    v[pass] = __builtin_nontemporal_load((const f32x4*)(W + (size_t)(k0 + r) * ldw + n0 + c4));
  }
#pragma unroll
  for (int pass = 0; pass < 8; ++pass) {
    const int r = (tid >> 4) + 32 * pass, c4 = (tid & 15) * 4;
    tile[r * 65 + c4 + 0] = v[pass][0]; tile[r * 65 + c4 + 1] = v[pass][1]; tile[r * 65 + c4 + 2] = v[pass][2]; tile[r * 65 + c4 + 3] = v[pass][3];
  }
  __syncthreads();
#pragma unroll
  for (int pass = 0; pass < 4; ++pass) {
    const int idx = tid + 512 * pass, nl = idx >> 5, kseg = (idx & 31) * 8;
    float x[8];
#pragma unroll
    for (int j = 0; j < 8; ++j) x[j] = tile[(kseg + j) * 65 + nl];
    const int c = nl & 31, rho = 16 * ((c >> 2) & 1) + 4 * (c >> 3) + (c & 3), nrow = n0 + (nl & 32) + rho;
    u32x4 w = {pk_bf16(x[0], x[1]), pk_bf16(x[2], x[3]), pk_bf16(x[4], x[5]), pk_bf16(x[6], x[7])};
    *(u32x4*)(Wt + (size_t)nrow * ldt + k0 + kseg) = w;
  }
  __syncthreads();
}

DI void phase_prep(const Params& p, char* smem) {
  const int tid = opaque_tid();
  float* rope = (float*)(p.ws + WS_ROPE);
  for (int i = blockIdx.x * NTHREADS + tid; i < NTOK * 32; i += gridDim.x * NTHREADS) {
    const int tok = i >> 5, f = i & 31;
    const float inv = exp2f(-(float)f * (13.287712379549449f / 32.0f));
    const float ang = (float)p.pos[tok] * inv;
    double t = (double)ang * 0.15915494309189535; t -= rint(t);
    const float r = (float)t;
    rope[(size_t)tok * 64 + f] = __builtin_amdgcn_cosf(r);
    rope[(size_t)tok * 64 + 32 + f] = __builtin_amdgcn_sinf(r);
  }
  float* mod = (float*)(p.ws + WS_MOD);
  bf16_t* wtin = (bf16_t*)(p.ws + WS_WTIN);
  bf16_t* wtout = (bf16_t*)(p.ws + WS_WTOUT);
  constexpr int J_MOD = 192, J_WIN = 4 * 104, J_WOUT = 8 * 16;
  for (int job = blockIdx.x; job < J_MOD; job += gridDim.x) {
      float* cact = (float*)smem;
      float* red = (float*)(smem + 65536);
      for (int i = tid; i < 16 * 256; i += NTHREADS) { const int b = i >> 8, k = (job / 48) * 256 + (i & 255); const float v = p.c[b * 1024 + k]; cact[b * 1024 + k] = silu(v); }
      __syncthreads();
      const int n = tid & 63, ks = tid >> 6, n0 = (job % 48) * 64, ksp = job / 48;
      float acc[16];
#pragma unroll
      for (int b = 0; b < 16; ++b) acc[b] = 0.f;
#pragma unroll 1
      for (int k = ksp * 256 + ks * 32; k < ksp * 256 + ks * 32 + 32; k += 16) {
        float w[16];
#pragma unroll
        for (int u = 0; u < 16; ++u) w[u] = __builtin_nontemporal_load(p.w_ada + (size_t)(k + u) * 3072 + n0 + n);
#pragma unroll
        for (int u = 0; u < 16; ++u)
#pragma unroll
          for (int b = 0; b < 16; ++b) acc[b] += cact[b * 1024 + k + u] * w[u];
      }
#pragma unroll
      for (int b = 0; b < 16; ++b) red[(ks * 16 + b) * 64 + n] = acc[b];
      __syncthreads();
      for (int o = tid; o < 1024; o += NTHREADS) {
        const int b = o >> 6, nn = o & 63; float sacc = (ksp == 0) ? p.b_ada[n0 + nn] : 0.f;
#pragma unroll
        for (int k2 = 0; k2 < 8; ++k2) sacc += red[(k2 * 16 + b) * 64 + nn];
        mod[(ksp * 16 + b) * 3072 + n0 + nn] = sacc;
      }
      asm volatile("s_waitcnt vmcnt(0)" ::: "memory");
      __syncthreads();
      if (tid == 0) __hip_atomic_fetch_add((unsigned*)(p.ws + WS_CTRL) + CW_MOD, 1u, __ATOMIC_RELEASE, __HIP_MEMORY_SCOPE_AGENT);
  }
}
DI void prep_transpose_job(const Params& p, char* smem, int j, int tid) {
  constexpr int J_WIN = 4 * 104;
  bf16_t* wtin = (bf16_t*)(p.ws + WS_WTIN);
  bf16_t* wtout = (bf16_t*)(p.ws + WS_WTOUT);
  if (j < J_WIN) { const int kt = j & 3, nt = j >> 2; transpose_tile4(p.w_in, IN_W, wtin, D_MODEL, kt * 256, nt * 64, (float*)smem, tid); }
  else { const int j2 = j - J_WIN, kt = j2 & 7, nt = j2 >> 3; transpose_tile4(p.w_out, D_MODEL, wtout, D_MIX, kt * 256, nt * 64, (float*)smem, tid); }
}

DI void phase_norm(const Params& p, char* smem) {
  const int tid = opaque_tid(), lane = tid & 63, wave = tid >> 6;
  const float* mod = (const float*)(p.ws + WS_MOD);
  bf16_t* H = (bf16_t*)(p.ws + WS_H);
  float* sc1 = (float*)(smem + 69632);
  float* shv = (float*)(smem + 69632 + 4096);
  int* s_item = (int*)(smem + 131072);
  unsigned* nctr = (unsigned*)(p.ws + WS_CTRL) + CW_NORM;
  unsigned* tctr = (unsigned*)(p.ws + WS_CTRL) + CW_TR;
  int bprev = -1;
  bool tr_left = true, nm_left = true, mod_ok = false;
  for (int step = 0; tr_left || nm_left; ++step) {
    const bool do_tr = tr_left && ((step % 3) == 0 || !nm_left);
    if (tid == 0) *s_item = do_tr ? (int)atomicAdd(tctr, 1u) : (int)atomicAdd(nctr, 1u);
    __syncthreads();
    const int g = *s_item;
    __syncthreads();
    if (do_tr) {
      if (g >= 4 * 104 + 8 * 16) tr_left = false; else prep_transpose_job(p, smem, g, tid);
      continue;
    }
    if (g >= NTOK / 64) { nm_left = false; continue; }
    if (!mod_ok) {
      if (tid == 0) { const unsigned* mc = (const unsigned*)(p.ws + WS_CTRL) + CW_MOD; while (__hip_atomic_load(mc, __ATOMIC_ACQUIRE, __HIP_MEMORY_SCOPE_AGENT) < 192u) __builtin_amdgcn_s_sleep(1); }
      __syncthreads();
      mod_ok = true;
    }
    const int b = g >> 5;
    if (b != bprev) {
      for (int col = tid; col < 1024; col += NTHREADS) {
        float sh = 0.f, sc = 0.f;
#pragma unroll
        for (int k2 = 0; k2 < 4; ++k2) { sh += mod[(k2 * 16 + b) * 3072 + col]; sc += mod[(k2 * 16 + b) * 3072 + 1024 + col]; }
        sc1[col] = p.norm_w[col] * (1.f + sc); shv[col] = sh;
      }
      bprev = b;
      __syncthreads();
    }
#pragma unroll 1
    for (int it = 0; it < 4; ++it) {
      const int row0 = g * 64 + wave * 8 + it * 2;
      f32x4 v[2][4]; float ss[2] = {0.f, 0.f};
#pragma unroll
      for (int rr = 0; rr < 2; ++rr) {
        const f32x4* xr = (const f32x4*)(p.x + (size_t)(row0 + rr) * D_MODEL);
#pragma unroll
        for (int i = 0; i < 4; ++i) v[rr][i] = __builtin_nontemporal_load(xr + lane + 64 * i);
      }
#pragma unroll
      for (int rr = 0; rr < 2; ++rr) {
#pragma unroll
        for (int i = 0; i < 4; ++i) ss[rr] += v[rr][i][0] * v[rr][i][0] + v[rr][i][1] * v[rr][i][1] + v[rr][i][2] * v[rr][i][2] + v[rr][i][3] * v[rr][i][3];
#pragma unroll
        for (int o = 32; o >= 1; o >>= 1) ss[rr] += __shfl_xor(ss[rr], o);
        ss[rr] = rsqrtf(ss[rr] * (1.0f / D_MODEL) + EPS);
      }
#pragma unroll
      for (int i = 0; i < 4; ++i) {
        const int col = (lane + 64 * i) * 4;
        const f32x4 a = *(const f32x4*)(sc1 + col), sh = *(const f32x4*)(shv + col);
#pragma unroll
        for (int rr = 0; rr < 2; ++rr) {
          float h[4];
#pragma unroll
          for (int j = 0; j < 4; ++j) h[j] = v[rr][i][j] * ss[rr] * a[j] + sh[j];
          u32x2 w = {pk_bf16(h[0], h[1]), pk_bf16(h[2], h[3])};
          *(u32x2*)(H + (size_t)(row0 + rr) * D_MODEL + col) = w;
        }
      }
    }
  }
}

constexpr int BM = 256, BK = 64, HALF = 128, NXCD = 8, WGM = 8, HT = HALF * BK;
DI int lds_byte(int r, int c) { const int st = (r >> 4) * 2 + (c >> 5), rr = r & 15, cc = c & 31, ob = rr * 64 + cc * 2; return st * 1024 + (ob ^ (((ob >> 9) & 1) << 5)); }
DI void stage_rc(int b, int& R, int& C) { const int st = b / 1024, sb = b % 1024, swz = sb ^ (((sb >> 9) & 1) << 5); R = (st >> 1) * 16 + swz / 64; C = (st & 1) * 32 + (swz % 64) / 2; }

struct EpiProj {
  bf16_t* O;
  DI void operator()(const f32x4 (&acc)[2][2][4][2], int brow, int bcol, int wr, int wc, int fr, int fq) const {
    const bool gate_tile = (bcol >= OFF_AG && bcol < OFF_AG + 1024) || (bcol >= OFF_RG);
    size_t sbase; int sld, scol;
    if (bcol < OFF_AK) { sbase = PB_AQ; sld = 1024; scol = bcol - OFF_AQ; }
    else if (bcol < OFF_AV) { sbase = PB_AK; sld = 256; scol = bcol - OFF_AK; }
    else if (bcol < OFF_AG) { sbase = PB_AV; sld = 256; scol = bcol - OFF_AV; }
    else if (bcol < OFF_RQ) { sbase = PB_AG; sld = 1024; scol = bcol - OFF_AG; }
    else if (bcol < OFF_RF) { sbase = PB_RQ; sld = 1024; scol = bcol - OFF_RQ; }
    else if (bcol < OFF_RI) { sbase = PB_RF; sld = 1024; scol = bcol - OFF_RF; }
    else if (bcol < OFF_RG) { sbase = PB_RI; sld = 1024; scol = bcol - OFF_RI; }
    else { sbase = PB_RG; sld = 1024; scol = bcol - OFF_RG; }
#pragma unroll
    for (int ai = 0; ai < 2; ++ai)
#pragma unroll
      for (int m = 0; m < 4; ++m) {
        const int row = brow + ai * HALF + wr * 64 + m * 16 + fr;
        bf16_t* rp = O + sbase + (size_t)row * sld + scol + wc * 32 + 8 * fq;
#pragma unroll
        for (int bj = 0; bj < 2; ++bj) {
          f32x4 a0 = acc[ai][bj][m][0], a1 = acc[ai][bj][m][1];
          if (gate_tile) {
#pragma unroll
            for (int j = 0; j < 4; ++j) { a0[j] = silu(a0[j]); a1[j] = silu(a1[j]); }
          }
          u32x4 w = {pk_bf16(a0[0], a0[1]), pk_bf16(a0[2], a0[3]), pk_bf16(a1[0], a1[1]), pk_bf16(a1[2], a1[3])};
          __builtin_nontemporal_store(w, (u32x4*)(rp + bj * HALF));
        }
      }
  }
};
struct EpiOut {
  float* O; const float* X; const float* mod;
  DI void operator()(const f32x4 (&acc)[2][2][4][2], int brow, int bcol, int wr, int wc, int fr, int fq) const {
    const int b = brow >> 11;
    f32x4 g[2][2];
    {
      f32x4 gp[2][4][2];
#pragma unroll
      for (int bj = 0; bj < 2; ++bj)
#pragma unroll
        for (int k2 = 0; k2 < 4; ++k2) {
          const float* gq = mod + (k2 * 16 + b) * 3072 + 2048 + bcol + bj * HALF + wc * 32 + 8 * fq;
          gp[bj][k2][0] = *(const f32x4*)gq; gp[bj][k2][1] = *(const f32x4*)(gq + 4);
        }
#pragma unroll
      for (int bj = 0; bj < 2; ++bj) { g[bj][0] = (gp[bj][0][0] + gp[bj][1][0]) + (gp[bj][2][0] + gp[bj][3][0]); g[bj][1] = (gp[bj][0][1] + gp[bj][1][1]) + (gp[bj][2][1] + gp[bj][3][1]); }
    }
    f32x4 xb[2][4][2];
    auto ldb = [&](int q, f32x4 (&x)[4][2]) __attribute__((always_inline)) {
      const int bj = q >> 1, ai = q & 1, col = bcol + bj * HALF + wc * 32 + 8 * fq;
#pragma unroll
      for (int m = 0; m < 4; ++m) {
        const size_t o = (size_t)(brow + ai * HALF + wr * 64 + m * 16 + fr) * D_MODEL + col;
        x[m][0] = *(const f32x4*)(X + o); x[m][1] = *(const f32x4*)(X + o + 4);
      }
    };
    ldb(0, xb[0]);
#pragma unroll
    for (int q = 0; q < 4; ++q) {
      if (q + 1 < 4) ldb(q + 1, xb[(q + 1) & 1]);
      const int bj = q >> 1, ai = q & 1, col = bcol + bj * HALF + wc * 32 + 8 * fq;
#pragma unroll
      for (int m = 0; m < 4; ++m) {
        const size_t o = (size_t)(brow + ai * HALF + wr * 64 + m * 16 + fr) * D_MODEL + col;
        *(f32x4*)(O + o) = xb[q & 1][m][0] + g[bj][0] * acc[ai][bj][m][0];
        *(f32x4*)(O + o + 4) = xb[q & 1][m][1] + g[bj][1] * acc[ai][bj][m][1];
      }
    }
  }
};

template <int lda, int split_kt, int gap, int M, int N, int K, class Epi>
DI void gemm_phase(LAS unsigned char* lds, const bf16_t* __restrict__ A, const bf16_t* __restrict__ Bt, const Epi& epi) {
#define SA(b, h) (((b) * 2 + (h)) * (HT * 2))
#define SB(b, h) ((4 + (b) * 2 + (h)) * (HT * 2))
#define STAGE_A(P, br, kt) do { const char* _g = (const char*)(A + (size_t)(br) * lda + (kt) * BK + ((kt) >= split_kt ? gap : 0)); \
    _Pragma("unroll") for (int _i = 0; _i < 2; ++_i) { \
      __builtin_amdgcn_global_load_lds((const unsigned*)(_g + aoff[_i]), (LAS unsigned*)(lds + (P) + ldsw + _i * 8192), 16, 0, 0); } } while (0)
#define STAGE_B(P, br, kt) do { const char* _g = (const char*)(Bt + (size_t)(br) * K + (kt) * BK); \
    _Pragma("unroll") for (int _i = 0; _i < 2; ++_i) { \
      __builtin_amdgcn_global_load_lds((const unsigned*)(_g + boff[_i]), (LAS unsigned*)(lds + (P) + ldsw + _i * 8192), 16, 0, 0); } } while (0)
#define LDA(dst, b, h) _Pragma("unroll") for (int m = 0; m < 4; ++m) _Pragma("unroll") for (int k = 0; k < 2; ++k) \
    dst[m][k] = *(const LAS bf16x8*)(lds + SA(b, h) + ra + m * 2048 + k * 1024)
#define LDB(dst, b, h) _Pragma("unroll") for (int n = 0; n < 2; ++n) _Pragma("unroll") for (int k = 0; k < 2; ++k) \
    dst[n][k] = *(const LAS bf16x8*)(lds + SB(b, h) + rb + n * 2048 + k * 1024)
#define MMA(ai, bj, At, Bf) do { __builtin_amdgcn_s_setprio(1); \
    _Pragma("unroll") for (int m = 0; m < 4; ++m) _Pragma("unroll") for (int n = 0; n < 2; ++n) _Pragma("unroll") for (int k = 0; k < 2; ++k) \
      acc[ai][bj][m][n] = __builtin_amdgcn_mfma_f32_16x16x32_bf16(Bf[n][k], At[m][k], acc[ai][bj][m][n], 0, 0, 0); \
    __builtin_amdgcn_s_setprio(0); } while (0)
#define WAIT_V(n) asm volatile("s_waitcnt vmcnt(" #n ")" ::: "memory")
#define WAIT_L(n) asm volatile("s_waitcnt lgkmcnt(" #n ")" ::: "memory")
#define BAR __builtin_amdgcn_s_barrier()
#define SCHED __builtin_amdgcn_sched_barrier(0)
  const int nM = M / BM, nN = N / BM, nwg = nM * nN;
  const int gtid = opaque_tid();
  const int wid = __builtin_amdgcn_readfirstlane(gtid >> 6), lane = gtid & 63, wr = wid >> 2, wc = wid & 3, fr = lane & 15, fq = lane >> 4;
  constexpr int nt = K / BK;
  const unsigned ldsw = (unsigned)wid * 1024u;
  const int ra = lds_byte(wr * 64 + fr, fq * 8), rb = lds_byte(wc * 32 + fr, fq * 8);
  unsigned aoff[2], boff[2];
#pragma unroll
  for (int i = 0; i < 2; ++i) { int r_, c_; stage_rc(gtid * 16 + i * 8192, r_, c_); aoff[i] = (unsigned)(r_ * lda + c_) * 2u; boff[i] = (unsigned)(r_ * K + c_) * 2u; }
  auto decode = [&](int L, int& brow_, int& bcol_) __attribute__((always_inline)) {
    int wgid = L;
    { const int q = nwg / NXCD, r = nwg % NXCD, xcd = wgid % NXCD, off = wgid / NXCD; wgid = (xcd < r ? xcd * (q + 1) : r * (q + 1) + (xcd - r) * q) + off; }
    const int nig = WGM * nN, gid = wgid / nig, fm = gid * WGM, gsz = min(nM - fm, WGM);
    const int pm = fm + ((wgid % nig) % gsz), pn = (wgid % nig) / gsz; brow_ = pm * BM; bcol_ = pn * BM;
  };
  int L = blockIdx.x;
  if (L < nwg) {
    int brow, bcol; decode(L, brow, bcol);
    f32x4 acc[2][2][4][2];
#pragma unroll
    for (int a = 0; a < 2; ++a)
#pragma unroll
      for (int b = 0; b < 2; ++b)
#pragma unroll
        for (int m = 0; m < 4; ++m)
#pragma unroll
          for (int n = 0; n < 2; ++n) acc[a][b][m][n] = (f32x4){0.f, 0.f, 0.f, 0.f};
    bf16x8 At[4][2], B0[2][2], B1[2][2];
    STAGE_B(SB(0, 0), bcol, 0); STAGE_A(SA(0, 0), brow, 0);
    STAGE_B(SB(0, 1), bcol + HALF, 0); STAGE_A(SA(0, 1), brow + HALF, 0);
    if (wr == 1) BAR;
    WAIT_V(4); BAR;
    STAGE_B(SB(1, 0), bcol, 1); STAGE_A(SA(1, 0), brow, 1); STAGE_B(SB(1, 1), bcol + HALF, 1);
    WAIT_V(6); BAR;
#pragma unroll 1
    for (;;) {
      const int Ln = L + gridDim.x;
      int nrow = brow, ncol = bcol;
      if (Ln < nwg) decode(Ln, nrow, ncol);
#pragma unroll 1
      for (int t = 0; t < nt; t += 2) {
        const bool last = (t == nt - 2);
        const int r2 = last ? nrow : brow, c2 = last ? ncol : bcol, k2 = last ? 0 : t + 2, k3 = last ? 1 : t + 3;
        LDB(B0, 0, 0); SCHED; LDA(At, 0, 0); STAGE_A(SA(1, 1), brow + HALF, t + 1);
        WAIT_L(8); BAR; WAIT_L(0); MMA(0, 0, At, B0); BAR; SCHED;
        LDB(B1, 0, 1); STAGE_B(SB(0, 0), c2, k2);
        BAR; WAIT_L(0); MMA(0, 1, At, B1); BAR;
        LDA(At, 0, 1); STAGE_A(SA(0, 0), r2, k2);
        BAR; WAIT_L(0); MMA(1, 0, At, B0); BAR; SCHED;
        STAGE_B(SB(0, 1), c2 + HALF, k2);
        WAIT_V(6); BAR; MMA(1, 1, At, B1); BAR;
        LDB(B0, 1, 0); SCHED; LDA(At, 1, 0); STAGE_A(SA(0, 1), r2 + HALF, k2);
        WAIT_L(8); BAR; WAIT_L(0); MMA(0, 0, At, B0); BAR; SCHED;
        LDB(B1, 1, 1); STAGE_B(SB(1, 0), c2, k3);
        BAR; WAIT_L(0); MMA(0, 1, At, B1); BAR;
        LDA(At, 1, 1); STAGE_A(SA(1, 0), r2, k3);
        BAR; WAIT_L(0); MMA(1, 0, At, B0); BAR; SCHED;
        STAGE_B(SB(1, 1), c2 + HALF, k3);
        WAIT_V(6); BAR; MMA(1, 1, At, B1); BAR;
      }
      epi(acc, brow, bcol, wr, wc, fr, fq);
#pragma unroll
      for (int a = 0; a < 2; ++a)
#pragma unroll
        for (int b = 0; b < 2; ++b)
#pragma unroll
          for (int m = 0; m < 4; ++m)
#pragma unroll
            for (int n = 0; n < 2; ++n) acc[a][b][m][n] = (f32x4){0.f, 0.f, 0.f, 0.f};
      if (Ln >= nwg) break;
      L = Ln; brow = nrow; bcol = ncol;
    }
    WAIT_V(0);
    if (wr == 0) BAR;
  }
  __syncthreads();
#undef SA
#undef SB
}

DI void attn_unit(const Params& p, char* smem, int unit) {
  const int kvh = unit & 3, nb = (unit >> 2) & 15, b = unit >> 6;
  bf16_t* proj = (bf16_t*)(p.ws + WS_PROJ);
  const float* rope = (const float*)(p.ws + WS_ROPE);
  bf16_t* Ks = (bf16_t*)smem;
  bf16_t* Vr = (bf16_t*)(smem + 36864);
  const int tid = opaque_tid(), lane = tid & 63, wave = tid >> 6;
  {
    const int key = tid >> 1, half = tid & 1;
    const int tokl = nb * 128 - 128 + key;
    u32x4 o0 = {0, 0, 0, 0}, o1 = o0, o2 = o0, o3 = o0;
    u32x4 v0 = o0, v1 = o0, v2 = o0, v3 = o0;
    if (tokl >= 0) {
      const size_t tok = (size_t)b * SEQ + tokl;
      const bf16_t* kp = proj + PB_AK + tok * 256 + kvh * 64 + 16 * half;
      const u32x4 r0 = *(const u32x4*)kp, r1 = *(const u32x4*)(kp + 8), r2 = *(const u32x4*)(kp + 32), r3 = *(const u32x4*)(kp + 40);
      const bf16_t* vp = proj + PB_AV + tok * 256 + kvh * 64 + 32 * half;
      v0 = *(const u32x4*)vp; v1 = *(const u32x4*)(vp + 8); v2 = *(const u32x4*)(vp + 16); v3 = *(const u32x4*)(vp + 24);
      float x1[16], x2[16];
#pragma unroll
      for (int i = 0; i < 4; ++i) { x1[2 * i] = bf_lo(r0[i]); x1[2 * i + 1] = bf_hi(r0[i]); x1[8 + 2 * i] = bf_lo(r1[i]); x1[8 + 2 * i + 1] = bf_hi(r1[i]);
                                    x2[2 * i] = bf_lo(r2[i]); x2[2 * i + 1] = bf_hi(r2[i]); x2[8 + 2 * i] = bf_lo(r3[i]); x2[8 + 2 * i + 1] = bf_hi(r3[i]); }
      float ss = 0.f;
#pragma unroll
      for (int j = 0; j < 16; ++j) ss += x1[j] * x1[j] + x2[j] * x2[j];
      ss += __shfl_xor(ss, 1);
      const float rstd = rsqrtf(ss * (1.0f / 64.0f) + EPS);
      const float* cs = rope + tok * 64 + 16 * half;
      const float* kw = p.k_norm_w + 16 * half;
      float y1[16], y2[16];
#pragma unroll
      for (int j = 0; j < 16; ++j) {
        const float a1 = x1[j] * rstd * kw[j], a2 = x2[j] * rstd * kw[32 + j], c = cs[j], s = cs[32 + j];
        y1[j] = a1 * c - a2 * s; y2[j] = a2 * c + a1 * s;
      }
      o0 = (u32x4){pk_bf16(y1[0], y1[1]), pk_bf16(y1[2], y1[3]), pk_bf16(y1[4], y1[5]), pk_bf16(y1[6], y1[7])};
      o1 = (u32x4){pk_bf16(y1[8], y1[9]), pk_bf16(y1[10], y1[11]), pk_bf16(y1[12], y1[13]), pk_bf16(y1[14], y1[15])};
      o2 = (u32x4){pk_bf16(y2[0], y2[1]), pk_bf16(y2[2], y2[3]), pk_bf16(y2[4], y2[5]), pk_bf16(y2[6], y2[7])};
      o3 = (u32x4){pk_bf16(y2[8], y2[9]), pk_bf16(y2[10], y2[11]), pk_bf16(y2[12], y2[13]), pk_bf16(y2[14], y2[15])};
    }
    bf16_t* kd = Ks + key * 72 + 16 * half;
    *(u32x4*)kd = o0; *(u32x4*)(kd + 8) = o1; *(u32x4*)(kd + 32) = o2; *(u32x4*)(kd + 40) = o3;
    bf16_t* vd = Vr + key * 96 + 32 * half;
    *(u32x4*)vd = v0; *(u32x4*)(vd + 8) = v1; *(u32x4*)(vd + 16) = v2; *(u32x4*)(vd + 24) = v3;
  }
  __syncthreads();
  const int r = lane & 31, h = lane >> 5;
  const bf16_t* vtb = Vr + (((lane >> 5) * 4 + ((lane & 15) >> 2)) * 96 + 16 * ((lane >> 4) & 1) + 4 * (lane & 3));
  constexpr float LOG2E = 1.4426950408889634f;
#pragma unroll 1
  for (int it = 0; it < 2; ++it) {
    const int item = wave * 2 + it, g = item >> 2, qs = item & 3;
    const int head = kvh * 4 + g;
    const size_t tok = (size_t)b * SEQ + nb * 128 + qs * 32 + r;
    bf16x8 qf[4];
    u32x4 gr[4];
    bf16_t* gbase = proj + PB_AG + ((size_t)b * SEQ + nb * 128 + qs * 32 + (lane >> 3)) * 1024 + head * 64 + (lane & 7) * 8;
#pragma unroll
    for (int i = 0; i < 4; ++i) gr[i] = *(const u32x4*)(gbase + (size_t)(8 * i) * 1024);
    {
      const u32x4* qp = (const u32x4*)(proj + PB_AQ + tok * 1024 + head * 64 + 8 * h);
      float xq[4][8]; float ss = 0.f;
#pragma unroll
      for (int s = 0; s < 4; ++s) { const u32x4 rr = qp[2 * s];
#pragma unroll
        for (int i = 0; i < 4; ++i) { xq[s][2 * i] = bf_lo(rr[i]); xq[s][2 * i + 1] = bf_hi(rr[i]); } }
#pragma unroll
      for (int s = 0; s < 4; ++s)
#pragma unroll
        for (int j = 0; j < 8; ++j) ss += xq[s][j] * xq[s][j];
      ss += __shfl_xor(ss, 32);
      const float rstd = rsqrtf(ss * (1.0f / 64.0f) + EPS) * (0.125f * LOG2E);
      const float* cs = rope + tok * 64 + 8 * h;
      const float* qw = p.q_norm_w + 8 * h;
#pragma unroll
      for (int s = 0; s < 2; ++s) {
        float ya[8], yb[8];
#pragma unroll
        for (int j = 0; j < 8; ++j) {
          const float a1 = xq[s][j] * rstd * qw[16 * s + j], a2 = xq[s + 2][j] * rstd * qw[32 + 16 * s + j], c = cs[16 * s + j], sn = cs[32 + 16 * s + j];
          ya[j] = a1 * c - a2 * sn; yb[j] = a2 * c + a1 * sn;
        }
        qf[s] = pack8(ya[0], ya[1], ya[2], ya[3], ya[4], ya[5], ya[6], ya[7]);
        qf[s + 2] = pack8(yb[0], yb[1], yb[2], yb[3], yb[4], yb[5], yb[6], yb[7]);
      }
    }
    f32x16 sacc[5];
#pragma unroll
    for (int kt = 0; kt < 5; ++kt) {
#pragma unroll
      for (int i = 0; i < 16; ++i) sacc[kt][i] = 0.f;
#pragma unroll
      for (int s = 0; s < 4; ++s) {
        const bf16x8 a = *(const bf16x8*)(Ks + (qs * 32 + kt * 32 + r) * 72 + 16 * s + 8 * h);
        sacc[kt] = MFMA32(a, qf[s], sacc[kt]);
      }
    }
    const float sinkv = p.sinks[head] * LOG2E;
    float m = -INFINITY;
#pragma unroll
    for (int kt = 0; kt < 5; ++kt) {
      const bool tile_ok = (nb > 0) || (qs * 32 + kt * 32 >= 128);
#pragma unroll
      for (int i = 0; i < 16; ++i) {
        const int cr = (i & 3) + 8 * (i >> 2) + 4 * h;
        bool ok = tile_ok;
        if (kt == 0) ok = ok && (cr > r);
        if (kt == 4) ok = ok && (cr <= r);
        const float v = ok ? sacc[kt][i] : -INFINITY;
        sacc[kt][i] = v; m = fmaxf(m, v);
      }
    }
    m = fmaxf(m, __shfl_xor(m, 32)); m = fmaxf(m, sinkv);
    float l = 0.f;
#pragma unroll
    for (int kt = 0; kt < 5; ++kt)
#pragma unroll
      for (int i = 0; i < 16; ++i) { const float pv = __builtin_amdgcn_exp2f(sacc[kt][i] - m); sacc[kt][i] = pv; l += pv; }
    l += __shfl_xor(l, 32); l += __builtin_amdgcn_exp2f(sinkv - m);
    f32x16 oacc[2];
#pragma unroll
    for (int i = 0; i < 16; ++i) { oacc[0][i] = 0.f; oacc[1][i] = 0.f; }
#pragma unroll
    for (int kt = 0; kt < 5; ++kt)
#pragma unroll
      for (int s = 0; s < 2; ++s) {
        const bf16x8 pb = pack8(sacc[kt][8 * s], sacc[kt][8 * s + 1], sacc[kt][8 * s + 2], sacc[kt][8 * s + 3], sacc[kt][8 * s + 4], sacc[kt][8 * s + 5], sacc[kt][8 * s + 6], sacc[kt][8 * s + 7]);
#pragma unroll
        for (int ht = 0; ht < 2; ++ht) {
          const bf16_t* vp = vtb + (qs * 32 + kt * 32 + 16 * s) * 96 + ht * 32;
          const s16x4 lo = __builtin_amdgcn_ds_read_tr16_b64_v4i16((LAS s16x4*)vp), hi = __builtin_amdgcn_ds_read_tr16_b64_v4i16((LAS s16x4*)(vp + 8 * 96));
          const bf16x8 av = __builtin_shufflevector(lo, hi, 0, 1, 2, 3, 4, 5, 6, 7);
          oacc[ht] = MFMA32(av, pb, oacc[ht]);
        }
      }
    const float inv = fast_rcp(l);
    bf16_t* Os = (bf16_t*)(smem + 86016) + wave * (32 * 72);
#pragma unroll
    for (int ht = 0; ht < 2; ++ht)
#pragma unroll
      for (int g4 = 0; g4 < 4; ++g4) {
        const u32x2 w = {pk_bf16(oacc[ht][4 * g4] * inv, oacc[ht][4 * g4 + 1] * inv), pk_bf16(oacc[ht][4 * g4 + 2] * inv, oacc[ht][4 * g4 + 3] * inv)};
        *(u32x2*)(Os + r * 72 + ht * 32 + 8 * g4 + 4 * h) = w;
      }
    __builtin_amdgcn_wave_barrier();
    asm volatile("s_waitcnt lgkmcnt(0)" ::: "memory");
#pragma unroll
    for (int i = 0; i < 4; ++i) {
      const u32x4 ov = *(const u32x4*)(Os + ((lane >> 3) + 8 * i) * 72 + (lane & 7) * 8);
      const u32x4 gv = gr[i];
      u32x4 w;
#pragma unroll
      for (int j = 0; j < 4; ++j) w[j] = pk_bf16(bf_lo(ov[j]) * bf_lo(gv[j]), bf_hi(ov[j]) * bf_hi(gv[j]));
      if (p.st_m) *(u32x4*)(gbase + (size_t)(8 * i) * 1024) = w;
    }
    __builtin_amdgcn_wave_barrier();
  }
  __syncthreads();
}

struct HgrnRegs { unsigned rq[8], rf[8]; };
DI void hgrn_chunk_load(HgrnRegs& R, const bf16_t* proj, int u, int seg, int kp) {
  const int hh = u & 7, c = (u >> 3) & 31, b = u >> 8;
  const size_t tok0 = (size_t)b * SEQ + c * 64;
#pragma unroll
  for (int j = 0; j < 8; ++j) {
    const bf16_t* base = proj + (tok0 + 8 * seg + j) * 1024 + hh * 128 + 2 * kp;
    R.rq[j] = __builtin_nontemporal_load((const unsigned*)(base + PB_RQ)); R.rf[j] = __builtin_nontemporal_load((const unsigned*)(base + PB_RF));
  }
}
DI void phase_hgrn_chunk(const Params& p, char* smem) {
  bf16_t* proj = (bf16_t*)(p.ws + WS_PROJ);
  bf16_t* Hb = (bf16_t*)(p.ws + WS_H);
  float* DL = (float*)(p.ws + WS_DL);
  bf16_t* QD = (bf16_t*)smem;
  bf16_t* KI = (bf16_t*)(smem + 17408);
  bf16_t* KoT = (bf16_t*)(smem + 34816);
  bf16_t* VT = (bf16_t*)(smem + 53248);
  bf16_t* Am = (bf16_t*)(smem + 71680);
  f32x4* segp = (f32x4*)(smem + 80896);
  float* Ob = (float*)(smem + 89600);
  const int tid = opaque_tid(), lane = tid & 63, wave = tid >> 6;
  const int kp = lane, seg = wave;
  const int c16 = lane & 15, q4 = lane >> 4;
  const int ft = tid >> 3, fv = (tid & 7) * 16;
  HgrnRegs R;
  if ((int)blockIdx.x < 4096) hgrn_chunk_load(R, proj, blockIdx.x, seg, kp);
#pragma unroll 1
  for (int u = blockIdx.x; u < 4096; u += gridDim.x) {
    const int hh = u & 7, c = (u >> 3) & 31, b = u >> 8;
    const size_t tok0 = (size_t)b * SEQ + c * 64;
    float lb0, lb1;
    {
      const f32x2 l0 = *(const f32x2*)(p.lower_bounds + hh * 128 + 2 * kp), l1 = *(const f32x2*)(p.lower_bounds + 1024 + hh * 128 + 2 * kp);
      lb0 = fast_rcp(1.f + fast_exp(l1[0] - l0[0])); lb1 = fast_rcp(1.f + fast_exp(l1[1] - l0[1]));
    }
    const f32x2 lbv = {lb0, lb1}, olb = {1.f - lb0, 1.f - lb1};
    f32x2 Ev[8], Iv[8], Kv[8];
    {
      f32x2 P = {1.f, 1.f}, Q = {1.f, 1.f};
#pragma unroll
      for (int j = 0; j < 8; ++j) {
        const float x0 = __builtin_amdgcn_fmed3f(bf_lo(R.rf[j]), -30.f, 30.f), x1 = __builtin_amdgcn_fmed3f(bf_hi(R.rf[j]), -30.f, 30.f);
        const f32x2 e = {__builtin_amdgcn_exp2f(x0 * -1.4426950408889634f), __builtin_amdgcn_exp2f(x1 * -1.4426950408889634f)};
        const f32x2 a1 = e + 1.f, a2 = lbv * e + 1.f, pr = a1 * a2;
        const f32x2 w = {fast_rcp(pr[0]), fast_rcp(pr[1])};
        const f32x2 r = w * a2;
        Kv[j] = olb * e * r;
        P = P * (a2 * r); Q = Q * (a1 * a1 * w);
        Ev[j] = P; Iv[j] = Q;
      }
      segp[seg * 64 + kp] = (f32x4){P[0], P[1], Q[0], Q[1]};
    }
    __syncthreads();
    {
      f32x2 pre = {1.f, 1.f}, pin = {1.f, 1.f}, tot = {1.f, 1.f};
#pragma unroll
      for (int s2 = 0; s2 < 8; ++s2) {
        const f32x4 v = segp[s2 * 64 + kp];
        const f32x2 vp = {v[0], v[1]}, vq = {v[2], v[3]};
        if (s2 < seg) { pre = pre * vp; pin = pin * vq; }
        tot = tot * vp;
      }
      f32x2 ko[8];
#pragma unroll
      for (int j = 0; j < 8; ++j) {
        const f32x2 Ea = pre * Ev[j], ia = pin * Iv[j];
        const f32x2 qv = {bf_lo(R.rq[j]), bf_hi(R.rq[j])};
        const f32x2 qd2 = qv * Ea, ki = Kv[j] * ia;
        ko[j] = ki * tot;
        const unsigned qd = pk_bf16(qd2[0], qd2[1]);
        *(unsigned*)(QD + (8 * seg + j) * 136 + 2 * kp) = qd;
        if (p.st_a) *(unsigned*)(proj + PB_RQ + (tok0 + 8 * seg + j) * 1024 + hh * 128 + 2 * kp) = qd;
        *(unsigned*)(KI + (8 * seg + j) * 136 + 2 * kp) = pk_bf16(ki[0], ki[1]);
      }
      *(bf16x8*)(KoT + (2 * kp) * 72 + 8 * seg) = pack8(ko[0][0], ko[1][0], ko[2][0], ko[3][0], ko[4][0], ko[5][0], ko[6][0], ko[7][0]);
      *(bf16x8*)(KoT + (2 * kp + 1) * 72 + 8 * seg) = pack8(ko[0][1], ko[1][1], ko[2][1], ko[3][1], ko[4][1], ko[5][1], ko[6][1], ko[7][1]);
      if (seg == 0 && p.st_a) { *(f32x2*)(DL + (size_t)u * 128 + 2 * kp) = tot; }
    }
    if (u + (int)gridDim.x < 4096) hgrn_chunk_load(R, proj, u + gridDim.x, seg, kp);
    __syncthreads();
    {
      const int ti = wave >> 1;
#pragma unroll
      for (int uu = 0; uu < 2; ++uu) {
        const int si = 2 * (wave & 1) + uu;
        f32x4 acc = {0.f, 0.f, 0.f, 0.f};
        if (si <= ti) {
#pragma unroll
          for (int ks = 0; ks < 4; ++ks) {
            const bf16x8 a = *(const bf16x8*)(QD + (16 * ti + c16) * 136 + 32 * ks + 8 * q4);
            const bf16x8 bb = *(const bf16x8*)(KI + (16 * si + c16) * 136 + 32 * ks + 8 * q4);
            acc = MFMA16(a, bb, acc);
          }
        }
#pragma unroll
        for (int j = 0; j < 4; ++j) {
          const int t = 16 * ti + 4 * q4 + j, s = 16 * si + c16;
          const float v = (s <= t) ? acc[j] : 0.f;
          Am[t * 72 + s] = (bf16_t)(pk_bf16(v, 0.f) & 0xffffu);
        }
      }
    }
    __syncthreads();
    {
#pragma unroll
      for (int i = 0; i < 2; ++i) {
        const int idx = tid + 512 * i, k = idx >> 3, t8 = (idx & 7) * 8;
        const u32x4 w = *(const u32x4*)(KoT + k * 72 + t8);
        if (p.st_a) *(u32x4*)(proj + PB_RF + (tok0 + (k >> 1)) * 1024 + hh * 128 + (k & 1) * 64 + t8) = w;
      }
      const int t = tid >> 3, s8 = (tid & 7) * 8;
      const u32x4 w = *(const u32x4*)(Am + t * 72 + s8);
      if (p.st_a) *(u32x4*)(Hb + ((size_t)u * 64 + t) * 64 + s8) = w;
    }
  }
  __syncthreads();
}

struct ScanRegs { u32x4 qd[2]; u32x4 ko[2]; u32x4 am; unsigned rv[8]; };
DI void hgrn_scan_load(ScanRegs& R, const Params& p, int b, int hh, int c, int tid) {
  const bf16_t* proj = (const bf16_t*)(p.ws + WS_PROJ);
  const bf16_t* Hb = (const bf16_t*)(p.ws + WS_H);
  const int lane = tid & 63, wave = tid >> 6;
  const size_t tok0 = (size_t)b * SEQ + c * 64;
  const size_t u = (size_t)(b * 32 + c) * 8 + hh;
#pragma unroll
  for (int i = 0; i < 2; ++i) {
    const int idx = tid + 512 * i;
    R.qd[i] = __builtin_nontemporal_load((const u32x4*)(proj + PB_RQ + (tok0 + (idx >> 4)) * 1024 + hh * 128 + (idx & 15) * 8));
    const int k = idx >> 3, t8 = (idx & 7) * 8;
    R.ko[i] = __builtin_nontemporal_load((const u32x4*)(proj + PB_RF + (tok0 + (k >> 1)) * 1024 + hh * 128 + (k & 1) * 64 + t8));
  }
  R.am = __builtin_nontemporal_load((const u32x4*)(Hb + (u * 64 + (tid >> 3)) * 64 + (tid & 7) * 8));
#pragma unroll
  for (int j = 0; j < 8; ++j) R.rv[j] = __builtin_nontemporal_load((const unsigned*)(proj + PB_RI + (tok0 + 8 * wave + j) * 1024 + hh * 128 + 2 * lane));
}
DI void hgrn_scan_unit(const Params& p, char* smem, int unit) {
  const int hh = unit & 7, b = unit >> 3;
  bf16_t* proj = (bf16_t*)(p.ws + WS_PROJ);
  bf16_t* QD = (bf16_t*)smem;
  bf16_t* KoT = (bf16_t*)(smem + 17408);
  bf16_t* VT = (bf16_t*)(smem + 35840);
  bf16_t* Am = (bf16_t*)(smem + 54272);
  float* dla = (float*)(smem + 97792);
  float* Ob = (float*)(smem + 64000);
  const int tid = opaque_tid(), lane = tid & 63, wave = tid >> 6;
  const int c16 = lane & 15, q4 = lane >> 4;
  const int ft = tid >> 3, fv = (tid & 7) * 16;
  const int vcol = 16 * wave + c16;
  f32x4 S[8];
#pragma unroll
  for (int i = 0; i < 8; ++i) S[i] = (f32x4){0.f, 0.f, 0.f, 0.f};
  ScanRegs R0, R1;
  hgrn_scan_load(R0, p, b, hh, 0, tid);
  hgrn_scan_load(R1, p, b, hh, 1, tid);
  {
    const float* DL = (const float*)(p.ws + WS_DL);
#pragma unroll
    for (int i = 0; i < 2; ++i) { const int idx = tid + 512 * i, c = idx >> 5, k4 = (idx & 31) * 4; *(f32x4*)(dla + c * 128 + k4) = *(const f32x4*)(DL + ((size_t)(b * 32 + c) * 8 + hh) * 128 + k4); }
  }
  auto body = [&](const int c, ScanRegs& C) __attribute__((always_inline)) {
    const size_t tok0 = (size_t)b * SEQ + c * 64;
#pragma unroll
    for (int i = 0; i < 2; ++i) {
      const int idx = tid + 512 * i;
      *(u32x4*)(QD + (idx >> 4) * 136 + (idx & 15) * 8) = C.qd[i];
      *(u32x4*)(KoT + (idx >> 3) * 72 + (idx & 7) * 8) = C.ko[i];
    }
    *(u32x4*)(Am + (tid >> 3) * 72 + (tid & 7) * 8) = C.am;
    {
      u32x4 wl, wh;
#pragma unroll
      for (int i = 0; i < 4; ++i) { wl[i] = (C.rv[2 * i] & 0xffffu) | (C.rv[2 * i + 1] << 16); wh[i] = (C.rv[2 * i] >> 16) | (C.rv[2 * i + 1] & 0xffff0000u); }
      *(u32x4*)(VT + (2 * lane) * 72 + 8 * wave) = wl;
      *(u32x4*)(VT + (2 * lane + 1) * 72 + 8 * wave) = wh;
    }
    if (c + 2 < 32) hgrn_scan_load(C, p, b, hh, c + 2, tid);
    const float* dl = dla + c * 128;
    u32x4 rg[2];
    __syncthreads();
    {
      bf16x8 bv[2];
#pragma unroll
      for (int ks = 0; ks < 2; ++ks) bv[ks] = *(const bf16x8*)(VT + vcol * 72 + 32 * ks + 8 * q4);
#pragma unroll
      for (int th = 0; th < 2; ++th) {
        f32x4 o[2];
#pragma unroll
        for (int i = 0; i < 2; ++i) o[i] = (f32x4){0.f, 0.f, 0.f, 0.f};
#pragma unroll
        for (int kq = 0; kq < 4; ++kq) {
          const bf16x8 sf = pack8(S[2 * kq][0], S[2 * kq][1], S[2 * kq][2], S[2 * kq][3], S[2 * kq + 1][0], S[2 * kq + 1][1], S[2 * kq + 1][2], S[2 * kq + 1][3]);
#pragma unroll
          for (int t2 = 0; t2 < 2; ++t2) {
            const int ti = 2 * th + t2;
            const bf16x8 av = *(const bf16x8*)(QD + (16 * ti + c16) * 136 + 32 * kq + 8 * q4);
            o[t2] = MFMA16(av, sf, o[t2]);
          }
        }
#pragma unroll
        for (int t2 = 0; t2 < 2; ++t2)
#pragma unroll
          for (int ks = 0; ks < 2; ++ks) {
            const bf16x8 a = *(const bf16x8*)(Am + (16 * (2 * th + t2) + c16) * 72 + 32 * ks + 8 * q4);
            o[t2] = MFMA16(a, bv[ks], o[t2]);
          }
#pragma unroll
        for (int t2 = 0; t2 < 2; ++t2)
#pragma unroll
          for (int j = 0; j < 4; ++j) Ob[(16 * (2 * th + t2) + 4 * q4 + j) * 132 + vcol] = o[t2][j];
        __builtin_amdgcn_sched_barrier(0);
      }
      {
        const bf16_t* gq = proj + PB_RG + (tok0 + ft) * 1024 + hh * 128 + fv;
        rg[0] = __builtin_nontemporal_load((const u32x4*)gq); rg[1] = __builtin_nontemporal_load((const u32x4*)(gq + 8));
      }
#pragma unroll
      for (int kt = 0; kt < 8; ++kt) {
        const f32x4 d = *(const f32x4*)(dl + 32 * (kt >> 1) + 8 * q4 + 4 * (kt & 1));
        S[kt] = S[kt] * d;
#pragma unroll
        for (int ks = 0; ks < 2; ++ks) {
          const bf16x8 a = *(const bf16x8*)(KoT + (32 * (kt >> 1) + 8 * (c16 >> 2) + 4 * (kt & 1) + (c16 & 3)) * 72 + 32 * ks + 8 * q4);
          S[kt] = MFMA16(a, bv[ks], S[kt]);
        }
        if (kt & 1) __builtin_amdgcn_sched_barrier(0);
      }
    }
    __syncthreads();
    {
      f32x4 ov[4]; float ss = 0.f;
#pragma unroll
      for (int i = 0; i < 4; ++i) { ov[i] = *(const f32x4*)(Ob + ft * 132 + fv + 4 * i); ss += ov[i][0] * ov[i][0] + ov[i][1] * ov[i][1] + ov[i][2] * ov[i][2] + ov[i][3] * ov[i][3]; }
      ss += __shfl_xor(ss, 1); ss += __shfl_xor(ss, 2); ss += __shfl_xor(ss, 4);
      const float rstd = rsqrtf(ss * (1.0f / 128.0f) + EPS);
      float y[16];
#pragma unroll
      for (int i = 0; i < 4; ++i) {
        const f32x4 w = *(const f32x4*)(p.rec_norm_w + fv + 4 * i);
        const unsigned ga = (i < 2) ? rg[0][2 * i] : rg[1][2 * (i - 2)], gb = (i < 2) ? rg[0][2 * i + 1] : rg[1][2 * (i - 2) + 1];
        y[4 * i + 0] = ov[i][0] * rstd * w[0] * bf_lo(ga);
        y[4 * i + 1] = ov[i][1] * rstd * w[1] * bf_hi(ga);
        y[4 * i + 2] = ov[i][2] * rstd * w[2] * bf_lo(gb);
        y[4 * i + 3] = ov[i][3] * rstd * w[3] * bf_hi(gb);
      }
      bf16_t* gp = proj + PB_RG + (tok0 + ft) * 1024 + hh * 128 + fv;
      if (p.st_m) {
      *(bf16x8*)gp = pack8(y[0], y[1], y[2], y[3], y[4], y[5], y[6], y[7]);
      *(bf16x8*)(gp + 8) = pack8(y[8], y[9], y[10], y[11], y[12], y[13], y[14], y[15]);
      }
    }
  };
#pragma unroll 1
  for (int c = 0; c < 32; c += 2) { body(c, R0); body(c + 1, R1); }
  __syncthreads();
}

DI void phase_mix(const Params& p, char* smem) {
  int* s_item = (int*)(smem + 131072);
  unsigned* ctr = (unsigned*)(p.ws + WS_CTRL) + CW_WORK;
  while (true) {
    if (threadIdx.x == 0) *s_item = (int)atomicAdd(ctr, 1u);
    __syncthreads();
    const int item = *s_item;
    __syncthreads();
    if (item >= 128 + 1024) break;
    if (item < 128) hgrn_scan_unit(p, smem, item); else attn_unit(p, smem, item - 128);
  }
}

DI void phase_gemm1(const Params& p, char* smem) {
  EpiProj e{(bf16_t*)(p.ws + WS_PROJ)};
  gemm_phase<D_MODEL, (1 << 30), 0, NTOK, IN_W, D_MODEL>((LAS unsigned char*)smem, (const bf16_t*)(p.ws + WS_H), (const bf16_t*)(p.ws + WS_WTIN), e);
}
DI void phase_gemm2(const Params& p, char* smem) {
  EpiOut e{p.out, p.x, (const float*)(p.ws + WS_MOD)};
  gemm_phase<1024, 16, (int)(PB_RG - PB_AG) - 1024, NTOK, D_MODEL, D_MIX>((LAS unsigned char*)smem, (const bf16_t*)(p.ws + WS_PROJ) + PB_AG, (const bf16_t*)(p.ws + WS_WTOUT), e);
}

extern __shared__ __attribute__((aligned(16))) char dyn_smem[];

#if ONE_LAUNCH
__global__ void __launch_bounds__(NTHREADS, 2) hymba_fwd(Params p) {
  cg::grid_group grid = cg::this_grid();
  volatile LAS unsigned* st = (volatile LAS unsigned*)((LAS unsigned char*)dyn_smem + 131072 + 16);
  if (threadIdx.x == 0) { st[0] = 0u; st[1] = 0u; }
  __syncthreads();
  const XcdBarrier xb = xcd_barrier_post((unsigned*)(p.ws + WS_XBAR), st);
  phase_prep(p, dyn_smem);
  phase_norm(p, dyn_smem);
  if (p.ws == nullptr) grid.sync();
  xcd_barrier(xb);
  phase_gemm1(p, dyn_smem);
  xcd_barrier(xb);
  phase_hgrn_chunk(p, dyn_smem);
  xcd_barrier(xb);
  phase_mix(p, dyn_smem);
  xcd_barrier(xb);
  phase_gemm2(p, dyn_smem);
}
#else
__global__ void __launch_bounds__(NTHREADS, 2) k_prep(Params p) { phase_prep(p, dyn_smem); }
__global__ void __launch_bounds__(NTHREADS, 2) k_norm(Params p) { phase_norm(p, dyn_smem); }
__global__ void __launch_bounds__(NTHREADS, 2) k_gemm1(Params p) { phase_gemm1(p, dyn_smem); }
__global__ void __launch_bounds__(NTHREADS, 2) k_hgrna(Params p) { phase_hgrn_chunk(p, dyn_smem); }
__global__ void __launch_bounds__(NTHREADS, 2) k_mix(Params p) { phase_mix(p, dyn_smem); }
__global__ void __launch_bounds__(NTHREADS, 2) k_gemm2(Params p) { phase_gemm2(p, dyn_smem); }
#endif

extern "C" void kernel_launch(void* const* d_in, const int* in_sizes, int n_in, void* d_out, int out_size, void* d_ws, size_t ws_size, hipStream_t stream) {
  static int grid = 0;
  if (grid == 0) {
    if (n_in != 13 || ws_size < WS_END) { fprintf(stderr, "kernel_launch: unexpected n_in %d or workspace %zu < %zu\n", n_in, ws_size, (size_t)WS_END); grid = -1; return; }
    int dev = 0, cus = 0, per_cu = 0;
    hipGetDevice(&dev);
    hipDeviceGetAttribute(&cus, hipDeviceAttributeMultiprocessorCount, dev);
#if ONE_LAUNCH
    if (hipFuncSetAttribute((const void*)hymba_fwd, hipFuncAttributeMaxDynamicSharedMemorySize, LDS_BYTES) != hipSuccess) { fprintf(stderr, "hipFuncSetAttribute failed\n"); grid = -1; return; }
    hipOccupancyMaxActiveBlocksPerMultiprocessor(&per_cu, (const void*)hymba_fwd, NTHREADS, LDS_BYTES);
    if (per_cu < 1) { fprintf(stderr, "occupancy query says %d blocks per CU\n", per_cu); per_cu = 1; }
    grid = cus * per_cu;
#else
    hipFuncSetAttribute((const void*)k_prep, hipFuncAttributeMaxDynamicSharedMemorySize, LDS_BYTES);
    hipFuncSetAttribute((const void*)k_gemm1, hipFuncAttributeMaxDynamicSharedMemorySize, LDS_BYTES);
    hipFuncSetAttribute((const void*)k_mix, hipFuncAttributeMaxDynamicSharedMemorySize, LDS_BYTES);
    hipFuncSetAttribute((const void*)k_hgrna, hipFuncAttributeMaxDynamicSharedMemorySize, LDS_BYTES);
    hipFuncSetAttribute((const void*)k_gemm2, hipFuncAttributeMaxDynamicSharedMemorySize, LDS_BYTES);
    (void)per_cu;
    grid = cus;
#endif
    (void)hipGetLastError();
  }
  if (grid < 0) return;
  (void)hipMemsetAsync((char*)d_ws + WS_CTRL, 0, 16384, stream);
  Params p{};
  p.x = (const float*)d_in[0]; p.c = (const float*)d_in[1]; p.pos = (const int*)d_in[2]; p.norm_w = (const float*)d_in[3];
  p.w_ada = (const float*)d_in[4]; p.b_ada = (const float*)d_in[5]; p.w_in = (const float*)d_in[6]; p.q_norm_w = (const float*)d_in[7];
  p.k_norm_w = (const float*)d_in[8]; p.sinks = (const float*)d_in[9]; p.rec_norm_w = (const float*)d_in[10];
  p.lower_bounds = (const float*)d_in[11]; p.w_out = (const float*)d_in[12]; p.out = (float*)d_out; p.ws = (char*)d_ws; p.st_a = 1; p.st_m = 1;
#if ONE_LAUNCH
  void* args[] = {&p};
  hipError_t e = hipLaunchCooperativeKernel((const void*)hymba_fwd, dim3(grid), dim3(NTHREADS), args, LDS_BYTES, stream);
  if (e != hipSuccess) fprintf(stderr, "cooperative launch failed: %s (grid %d)\n", hipGetErrorString(e), grid);
#else
  for (int r = 0; r < REP_PREP; ++r) hipLaunchKernelGGL(k_prep, dim3(grid), dim3(NTHREADS), LDS_BYTES, stream, p);
  for (int r = 0; r < REP_NORM; ++r) hipLaunchKernelGGL(k_norm, dim3(grid), dim3(NTHREADS), 16384, stream, p);
  for (int r = 0; r < REP_G1; ++r) hipLaunchKernelGGL(k_gemm1, dim3(grid), dim3(NTHREADS), LDS_BYTES, stream, p);
  for (int r = 0; r < REP_A; ++r) { p.st_a = (r == REP_A - 1); hipLaunchKernelGGL(k_hgrna, dim3(grid), dim3(NTHREADS), LDS_BYTES, stream, p); }
  for (int r = 0; r < REP_M; ++r) { p.st_m = (r == REP_M - 1); (void)hipMemsetAsync((char*)d_ws + WS_CTRL, 0, 16384, stream); hipLaunchKernelGGL(k_mix, dim3(grid), dim3(NTHREADS), LDS_BYTES, stream, p); }
  for (int r = 0; r < REP_G2; ++r) hipLaunchKernelGGL(k_gemm2, dim3(grid), dim3(NTHREADS), LDS_BYTES, stream, p);
#endif
}
```
